# Optimizing an MI355X kernel written in HIP

```python
import math
import numpy as np
import jax
import jax.numpy as jnp
from jax import lax

D_MODEL = 1024
BATCH = 4
SEQ = 4096
DEPTH = 2

HEAD_DIM = 64
ROT_DIM = HEAD_DIM // 4
ROPE_THETA = 500000.0
RMS_EPS = 1e-6
MASK_VALUE = -1e30

A_HEADS = 4
A_VDIM = 2 * HEAD_DIM
A_QBLOCK = 128
A_WIDTH = A_HEADS * A_VDIM

B_PATTERNS = ((128, 1), (512, 4), (2048, 16))
B_GROUPS = 3
B_HEADS = 4
B_BAND = 64
B_WIDTH = B_HEADS * HEAD_DIM

GRID_W = 64
C_HEADS = 4
NA_KH = 8
NA_KW = 16
NA_QB = 16
NA_KSPAN = 2 * NA_KW
C_WIDTH = C_HEADS * HEAD_DIM

N_BRANCHES = 3
BR_WIDTH = A_WIDTH + B_WIDTH + C_WIDTH
A_QK_COLS = A_HEADS * 2 * HEAD_DIM
B_COLS = B_GROUPS * B_HEADS * HEAD_DIM
IN_SPLITS = (A_QK_COLS, A_QK_COLS, A_WIDTH, B_COLS, B_COLS, B_COLS, C_WIDTH, C_WIDTH, C_WIDTH, BR_WIDTH, N_BRANCHES * D_MODEL)
IN_COLS = 2 * A_QK_COLS + A_WIDTH + 3 * B_COLS + 3 * C_WIDTH + BR_WIDTH + N_BRANCHES * D_MODEL

kernel_name = 'hybrid_gated_mixer_encoder'


def rms_norm(x, gain):
    xf = x.astype(jnp.float32)
    y = xf * lax.rsqrt(jnp.mean(xf * xf, axis=-1, keepdims=True) + RMS_EPS)
    return (y * gain.astype(jnp.float32)).astype(x.dtype)


def rope_tables(positions):
    inv = np.float32(ROPE_THETA) ** (-np.arange(0, ROT_DIM, 2, dtype=np.float32) / np.float32(ROT_DIM))
    ang = positions.astype(jnp.float32)[..., None] * jnp.asarray(inv, dtype=jnp.float32)
    return jnp.cos(ang), jnp.sin(ang)


def apply_partial_rope(t, cos, sin):
    shp = cos.shape[:2] + (1,) * (t.ndim - 3) + cos.shape[-1:]
    cos = cos.reshape(shp).astype(t.dtype)
    sin = sin.reshape(shp).astype(t.dtype)
    half = ROT_DIM // 2
    t1, t2, rest = t[..., :half], t[..., half:ROT_DIM], t[..., ROT_DIM:]
    return jnp.concatenate([t1 * cos - t2 * sin, t2 * cos + t1 * sin, rest], axis=-1)


def split_cols(t, sizes):
    idx, acc = [], 0
    for s in sizes[:-1]:
        acc += s
        idx.append(acc)
    return jnp.split(t, idx, axis=-1)


def diff_attention(q, k, v, lam, lambda_init, subln_gain):
    bn, s_len = q.shape[:2]
    nq = s_len // A_QBLOCK
    scale = HEAD_DIM ** -0.5
    qb = jnp.moveaxis(q.reshape(bn, nq, A_QBLOCK, A_HEADS, 2, HEAD_DIM), 1, 0)

    def one_block(qi):
        s = jnp.einsum('bqhcd,bkhcd->bhcqk', qi, k).astype(jnp.float32) * scale
        p = jax.nn.softmax(s, axis=-1)
        a = (p[:, :, 0] - lam * p[:, :, 1]).astype(v.dtype)
        return jnp.einsum('bhqk,bkhe->bqhe', a, v)

    o = lax.map(one_block, qb)
    o = jnp.moveaxis(o, 0, 1).reshape(bn, s_len, A_HEADS, A_VDIM)
    o = rms_norm(o, subln_gain) * (1.0 - lambda_init)
    return o.reshape(bn, s_len, A_WIDTH)


def dilated_group(q, k, v, dilation, radius):
    bn, s_len, h, dh = q.shape
    L = s_len // dilation

    def to_sub(t):
        return jnp.moveaxis(t.reshape(bn, L, dilation, h, dh), 2, 1)

    qs, ks, vs = to_sub(q), to_sub(k), to_sub(v)
    nb = -(-L // B_BAND)
    lp = nb * B_BAND
    qb = jnp.pad(qs, ((0, 0), (0, 0), (0, lp - L), (0, 0), (0, 0))).reshape(bn, dilation, nb, B_BAND, h, dh)
    pad_kv = ((0, 0), (0, 0), (B_BAND, lp - L + B_BAND), (0, 0), (0, 0))
    kp = jnp.pad(ks, pad_kv).reshape(bn, dilation, nb + 2, B_BAND, h, dh)
    vp = jnp.pad(vs, pad_kv).reshape(bn, dilation, nb + 2, B_BAND, h, dh)
    kw = jnp.concatenate([kp[:, :, :-2], kp[:, :, 1:-1], kp[:, :, 2:]], axis=3)
    vw = jnp.concatenate([vp[:, :, :-2], vp[:, :, 1:-1], vp[:, :, 2:]], axis=3)
    s = jnp.einsum('bmnqhd,bmnkhd->bmnhqk', qb, kw).astype(jnp.float32) * (HEAD_DIM ** -0.5)
    qi = np.arange(nb)[:, None, None] * B_BAND + np.arange(B_BAND)[None, :, None]
    kj = np.arange(nb)[:, None, None] * B_BAND + np.arange(3 * B_BAND)[None, None, :] - B_BAND
    valid = (np.abs(kj - qi) <= radius) & (kj >= 0) & (kj < L)
    s = jnp.where(valid[None, None, :, None], s, MASK_VALUE)
    m = jnp.max(s, axis=-1, keepdims=True)
    e = jnp.exp(s - m)
    den = jnp.sum(e, axis=-1, keepdims=True)
    o = jnp.einsum('bmnhqk,bmnkhd->bmnqhd', (e / den).astype(v.dtype), vw)
    lse = jnp.moveaxis((m + jnp.log(den))[..., 0], 3, 4)
    o = o.reshape(bn, dilation, lp, h, dh)[:, :, :L]
    o = jnp.moveaxis(o, 1, 2).reshape(bn, s_len, h, dh)
    lse = lse.reshape(bn, dilation, lp, h)[:, :, :L]
    lse = jnp.moveaxis(lse, 1, 2).reshape(bn, s_len, h)
    return o, lse


def dilated_mixture(q, k, v):
    outs, lses = [], []
    for g, (window, dilation) in enumerate(B_PATTERNS):
        o, lse = dilated_group(q[:, :, g], k[:, :, g], v[:, :, g], dilation, (window // 2) // dilation)
        outs.append(o)
        lses.append(lse)
    alpha = jax.nn.softmax(jnp.stack(lses, axis=0), axis=0)
    o = jnp.einsum('gbsh,gbshd->bshd', alpha.astype(outs[0].dtype), jnp.stack(outs, axis=0))
    bn, s_len = q.shape[:2]
    return o.reshape(bn, s_len, B_WIDTH)


def neighborhood_attention(q, k, v, rpb):
    bn, s_len, h, dh = q.shape
    rows = s_len // GRID_W
    kh = min(NA_KH, rows)
    ncb = GRID_W // NA_QB
    r_idx = np.arange(rows)
    row_start = np.clip(r_idx - kh // 2, 0, rows - kh)
    row_idx = row_start[:, None] + np.arange(kh)[None, :]
    blk_start = np.clip(np.arange(ncb) * NA_QB - NA_KW // 2, 0, GRID_W - NA_KSPAN)
    col_idx = blk_start[:, None] + np.arange(NA_KSPAN)[None, :]
    qcol = np.arange(ncb)[:, None] * NA_QB + np.arange(NA_QB)[None, :]
    col_start = np.clip(qcol - NA_KW // 2, 0, GRID_W - NA_KW)
    col_valid = (col_idx[:, None, :] >= col_start[..., None]) & (col_idx[:, None, :] < col_start[..., None] + NA_KW)
    mask = np.broadcast_to(col_valid[:, :, None, :], (ncb, NA_QB, kh, NA_KSPAN)).reshape(ncb, NA_QB, kh * NA_KSPAN)

    def gather_kv(t):
        g = t.reshape(bn, rows, GRID_W, h, dh)[:, row_idx]
        g = g[:, :, :, col_idx]
        g = jnp.moveaxis(g, 3, 2)
        return g.reshape(bn, rows, ncb, kh * NA_KSPAN, h, dh)

    kg, vg = gather_kv(k), gather_kv(v)
    qb = q.reshape(bn, rows, ncb, NA_QB, h, dh)
    s = jnp.einsum('brnqhd,brnkhd->brnhqk', qb, kg).astype(jnp.float32) * (HEAD_DIM ** -0.5)
    dr_i = row_idx - r_idx[:, None] + (NA_KH - 1)
    dc_i = np.clip(col_idx[:, None, :] - qcol[..., None] + (NA_KW - 1), 0, 2 * NA_KW - 2)
    bias = rpb[:, dr_i[:, None, None, :, None], dc_i[None, :, :, None, :]]
    bias = jnp.transpose(bias, (1, 2, 0, 3, 4, 5)).reshape(rows, ncb, h, NA_QB, kh * NA_KSPAN)
    s = jnp.where(mask[None, None, :, None], s + bias.astype(jnp.float32), MASK_VALUE)
    p = jax.nn.softmax(s, axis=-1).astype(v.dtype)
    o = jnp.einsum('brnhqk,brnkhd->brnqhd', p, vg)
    return o.reshape(bn, s_len, C_WIDTH)


def hybrid_layer(x, c_act, cos, sin, layer, norm_gain, w_ada, b_ada, w_in, diff_lambda, diff_subln_gain, na_rpb, w_branch, w_out):
    bn, s_len, _ = x.shape
    shift, scale, gate = jnp.split(c_act @ w_ada + b_ada, 3, axis=-1)
    h = rms_norm(x, norm_gain) * (1.0 + scale[:, None]) + shift[:, None]
    proj = h @ w_in
    a_q, a_k, a_v, b_q, b_k, b_v, c_q, c_k, c_v, z, g = split_cols(proj, IN_SPLITS)

    a_q = apply_partial_rope(a_q.reshape(bn, s_len, A_HEADS, 2, HEAD_DIM), cos, sin)
    a_k = apply_partial_rope(a_k.reshape(bn, s_len, A_HEADS, 2, HEAD_DIM), cos, sin)
    a_v = a_v.reshape(bn, s_len, A_HEADS, A_VDIM)
    lambda_init = 0.8 - 0.6 * math.exp(-0.3 * layer)
    lq1, lk1, lq2, lk2 = diff_lambda.astype(jnp.float32)
    lam = jnp.exp(jnp.sum(lq1 * lk1)) - jnp.exp(jnp.sum(lq2 * lk2)) + lambda_init
    y_a = diff_attention(a_q, a_k, a_v, lam, lambda_init, diff_subln_gain)

    b_q = apply_partial_rope(b_q.reshape(bn, s_len, B_GROUPS, B_HEADS, HEAD_DIM), cos, sin)
    b_k = apply_partial_rope(b_k.reshape(bn, s_len, B_GROUPS, B_HEADS, HEAD_DIM), cos, sin)
    b_v = b_v.reshape(bn, s_len, B_GROUPS, B_HEADS, HEAD_DIM)
    y_b = dilated_mixture(b_q, b_k, b_v)

    y_c = neighborhood_attention(c_q.reshape(bn, s_len, C_HEADS, HEAD_DIM), c_k.reshape(bn, s_len, C_HEADS, HEAD_DIM), c_v.reshape(bn, s_len, C_HEADS, HEAD_DIM), na_rpb)

    y = jnp.concatenate([y_a, y_b, y_c], axis=-1) * jax.nn.silu(z)
    gates = jax.nn.sigmoid(g.reshape(bn, s_len, N_BRANCHES, D_MODEL))
    bounds = ((0, A_WIDTH), (A_WIDTH, A_WIDTH + B_WIDTH), (A_WIDTH + B_WIDTH, BR_WIDTH))
    merged = gates[:, :, 0] * (y[..., bounds[0][0]:bounds[0][1]] @ w_branch[bounds[0][0]:bounds[0][1]])
    merged = merged + gates[:, :, 1] * (y[..., bounds[1][0]:bounds[1][1]] @ w_branch[bounds[1][0]:bounds[1][1]])
    merged = merged + gates[:, :, 2] * (y[..., bounds[2][0]:bounds[2][1]] @ w_branch[bounds[2][0]:bounds[2][1]])
    out = merged @ w_out
    return x + gate[:, None] * out


def setup_inputs(seed: int = 0) -> dict:
    key = jax.random.key(seed)
    ks = jax.random.split(key, 13)
    f32 = jnp.float32
    nrm = jax.random.normal
    x = nrm(ks[0], (BATCH, SEQ, D_MODEL), f32)
    c = nrm(ks[1], (BATCH, D_MODEL), f32)
    offs = jax.random.randint(ks[2], (BATCH, 1), 0, 1024, dtype=jnp.int32)
    positions = jnp.arange(SEQ, dtype=jnp.int32)[None, :] + offs
    norm_gain = 1.0 + 0.05 * nrm(ks[3], (DEPTH, D_MODEL), f32)
    w_ada = (0.5 * D_MODEL ** -0.5) * nrm(ks[4], (DEPTH, D_MODEL, 3 * D_MODEL), f32)
    b_ada = 0.01 * nrm(ks[5], (DEPTH, 3 * D_MODEL), f32)
    w_in = (D_MODEL ** -0.5) * nrm(ks[6], (DEPTH, D_MODEL, IN_COLS), f32)
    diff_lambda = 0.1 * nrm(ks[7], (DEPTH, 4, HEAD_DIM), f32)
    diff_subln_gain = 1.0 + 0.05 * nrm(ks[8], (DEPTH, A_VDIM), f32)
    na_rpb = 0.2 * nrm(ks[9], (DEPTH, C_HEADS, 2 * NA_KH - 1, 2 * NA_KW - 1), f32)
    br_scale = jnp.concatenate([jnp.full((A_WIDTH,), A_WIDTH ** -0.5, f32), jnp.full((B_WIDTH,), B_WIDTH ** -0.5, f32), jnp.full((C_WIDTH,), C_WIDTH ** -0.5, f32)])
    w_branch = nrm(ks[10], (DEPTH, BR_WIDTH, D_MODEL), f32) * br_scale[None, :, None]
    w_out = (D_MODEL ** -0.5) * nrm(ks[11], (DEPTH, D_MODEL, D_MODEL), f32)
    final_gain = 1.0 + 0.05 * nrm(ks[12], (D_MODEL,), f32)
    return {'x': x, 'c': c, 'positions': positions, 'norm_gain': norm_gain, 'w_ada': w_ada, 'b_ada': b_ada, 'w_in': w_in, 'diff_lambda': diff_lambda, 'diff_subln_gain': diff_subln_gain, 'na_rpb': na_rpb, 'w_branch': w_branch, 'w_out': w_out, 'final_gain': final_gain}


def reference(x, c, positions, norm_gain, w_ada, b_ada, w_in, diff_lambda, diff_subln_gain, na_rpb, w_branch, w_out, final_gain):
    cos, sin = rope_tables(positions)
    c_act = jax.nn.silu(c)
    for layer in range(DEPTH):
        x = hybrid_layer(x, c_act, cos, sin, layer, norm_gain[layer], w_ada[layer], b_ada[layer], w_in[layer], diff_lambda[layer], diff_subln_gain[layer], na_rpb[layer], w_branch[layer], w_out[layer])
    return rms_norm(x, final_gain)
```

```cpp
#include <hip/hip_runtime.h>
#include <hip/hip_cooperative_groups.h>
#include <cstdio>
#include <cstdint>
namespace cg = cooperative_groups;

#ifndef MK_MULTI
#define MK_MULTI 0
#endif

typedef unsigned short bf16_t;
typedef short bf16x8 __attribute__((ext_vector_type(8)));
typedef short s16x4 __attribute__((ext_vector_type(4)));
typedef float f32x4 __attribute__((ext_vector_type(4)));
typedef float f32x2 __attribute__((ext_vector_type(2)));
typedef float f32x16 __attribute__((ext_vector_type(16)));
typedef unsigned u32x4 __attribute__((ext_vector_type(4)));
typedef unsigned u32x2 __attribute__((ext_vector_type(2)));
#define DEV __device__ __forceinline__

constexpr int T = 16384, SEQ = 4096, DM = 1024, NB = 4;
constexpr int IN_COLS = 8704;
constexpr float RMS_EPS = 1e-6f;
constexpr float SCALE = 0.125f;

constexpr size_t SZ_T1024 = (size_t)T * 1024 * 2;
constexpr size_t OFF_AQK = 0;
constexpr size_t OFF_AV = OFF_AQK + SZ_T1024;
constexpr size_t OFF_BK = OFF_AV + (size_t)T * 512 * 2;
constexpr size_t OFF_BV = OFF_BK + (size_t)T * 768 * 2;
constexpr size_t OFF_C = OFF_BV + (size_t)T * 768 * 2;
constexpr size_t OFF_BQ = OFF_C + (size_t)T * 768 * 2;
constexpr size_t OFF_Z = OFF_BQ + (size_t)T * 768 * 2;
constexpr size_t OFF_H = OFF_Z + SZ_T1024;
constexpr size_t OFF_Y = OFF_H + SZ_T1024;
constexpr size_t OFF_WIN = OFF_Y + SZ_T1024;
constexpr size_t OFF_WBR = OFF_WIN + (size_t)IN_COLS * 1024 * 2;
constexpr size_t OFF_WOUT = OFF_WBR + (size_t)2 * 1024 * 1024 * 2;
constexpr size_t OFF_LSE = OFF_WOUT + (size_t)2 * 1024 * 1024 * 2;
constexpr size_t OFF_ROPE = OFF_LSE + (size_t)3 * T * 4 * 4;
constexpr size_t OFF_MOD = OFF_ROPE + (size_t)T * 8 * 8;
constexpr size_t OFF_LAM = OFF_MOD + (size_t)2 * 4 * 3072 * 4;
constexpr size_t WS_NEED = OFF_LAM + 256;
constexpr size_t OFF_G = OFF_AQK;

constexpr int LDS_BYTES = 131072 + 4096;

struct Params {
  const float* x; const float* c; const int* pos; const float* norm_gain; const float* w_ada; const float* b_ada; const float* w_in;
  const float* diff_lambda; const float* subln; const float* rpb; const float* w_branch; const float* w_out; const float* final_gain;
  float* out; char* ws;
};

extern __shared__ __attribute__((aligned(16))) char smem[];

DEV unsigned cvtpk(float lo, float hi) { unsigned r; asm volatile("v_cvt_pk_bf16_f32 %0, %1, %2" : "=v"(r) : "v"(lo), "v"(hi)); return r; }
DEV float bflo(unsigned w) { return __uint_as_float(w << 16); }
DEV float bfhi(unsigned w) { return __uint_as_float(w & 0xffff0000u); }
DEV float bf2f(bf16_t v) { return __uint_as_float(((unsigned)v) << 16); }
DEV float sigmoidf(float x) { return 1.0f / (1.0f + __expf(-x)); }
DEV float siluf(float x) { return x / (1.0f + __expf(-x)); }
DEV int perm32(int rho) { const int n = rho >> 4, i = rho & 15; return 8 * (i >> 2) + 4 * n + (i & 3); }
DEV int ltid() { int t = threadIdx.x; asm volatile("" : "+v"(t)); return t; }
DEV int lbid() { int t = blockIdx.x; asm volatile("" : "+s"(t)); return t; }
DEV int crow(int r, int hi) { return (r & 3) + 8 * (r >> 2) + 4 * hi; }

DEV int win_src_col(int j) {
  const int c = (j & ~31) + perm32(j & 31);
  int orig; bool rope;
  if (c < 1024) { orig = c; rope = true; }
  else if (c < 1536) { orig = c; rope = false; }
  else if (c < 2304) { orig = 2304 + (c - 1536); rope = true; }
  else if (c < 3072) { orig = 3072 + (c - 2304); rope = false; }
  else if (c < 3840) { orig = 3840 + (c - 3072); rope = false; }
  else if (c < 4608) { orig = 1536 + (c - 3840); rope = true; }
  else { orig = c; rope = false; }
  if (rope) { int p = orig & 63; if (p < 16) { const int i = p >> 1; p = (p & 1) ? i + 8 : i; orig = (orig & ~63) + p; } }
  return orig;
}

template <int WIN>
DEV void cvt_tile(const float* __restrict__ src, int ld_src, bf16_t* __restrict__ dst, int j0, int k0) {
  float* l = (float*)smem;
  const int tid = ltid();
  int o0;
  if (WIN) o0 = win_src_col(j0) & ~63; else o0 = j0;
#pragma unroll
  for (int i = 0; i < 2; ++i) {
    const int idx = tid + i * 512; const int kr = idx >> 4, c4 = (idx & 15) * 4;
    const f32x4 v = *(const f32x4*)(src + (size_t)(k0 + kr) * ld_src + o0 + c4);
    l[kr * 65 + c4 + 0] = v[0]; l[kr * 65 + c4 + 1] = v[1]; l[kr * 65 + c4 + 2] = v[2]; l[kr * 65 + c4 + 3] = v[3];
  }
  __syncthreads();
  const int jj = tid >> 3, kc = (tid & 7) * 8, j = j0 + jj;
  int oc;
  if (WIN) oc = win_src_col(j) - o0; else oc = ((j & ~31) + perm32(j & 31)) - o0;
  u32x4 w;
  w[0] = cvtpk(l[(kc + 0) * 65 + oc], l[(kc + 1) * 65 + oc]);
  w[1] = cvtpk(l[(kc + 2) * 65 + oc], l[(kc + 3) * 65 + oc]);
  w[2] = cvtpk(l[(kc + 4) * 65 + oc], l[(kc + 5) * 65 + oc]);
  w[3] = cvtpk(l[(kc + 6) * 65 + oc], l[(kc + 7) * 65 + oc]);
  *(u32x4*)(dst + (size_t)j * 1024 + k0 + kc) = w;
  __syncthreads();
}

DEV void cvt_win_layer(const Params& p, int layer) {
  const float* src = p.w_in + (size_t)layer * 1024 * IN_COLS;
  bf16_t* dst = (bf16_t*)(p.ws + OFF_WIN);
  for (int t = blockIdx.x; t < 16 * 136; t += gridDim.x) { const int kt = t & 15, nt = t >> 4; cvt_tile<1>(src, IN_COLS, dst, nt * 64, kt * 64); }
}

DEV void phase0(const Params& p) {
  const int tid = ltid();
  cvt_win_layer(p, 0);
  for (int t = blockIdx.x; t < 1024; t += gridDim.x) {
    const int mat = t >> 8, tt = t & 255, kt = tt & 15, nt = tt >> 4, l = mat & 1;
    const float* src = (mat < 2 ? p.w_branch : p.w_out) + (size_t)l * 1024 * 1024;
    bf16_t* dst = (bf16_t*)(p.ws + (mat < 2 ? OFF_WBR : OFF_WOUT)) + (size_t)l * 1024 * 1024;
    cvt_tile<0>(src, 1024, dst, nt * 64, kt * 64);
  }
  float* mod = (float*)(p.ws + OFF_MOD);
  for (int it = blockIdx.x; it < 96; it += gridDim.x) {
    const int l = it / 48, j0 = (it % 48) * 64, w = tid >> 6, lane = tid & 63;
    const float* wa = p.w_ada + (size_t)l * 1024 * 3072 + j0 + lane;
    float a0 = 0.f, a1 = 0.f, a2 = 0.f, a3 = 0.f;
    for (int k = w * 128; k < w * 128 + 128; ++k) {
      const float wv = wa[(size_t)k * 3072];
      a0 += siluf(p.c[k]) * wv; a1 += siluf(p.c[1024 + k]) * wv; a2 += siluf(p.c[2048 + k]) * wv; a3 += siluf(p.c[3072 + k]) * wv;
    }
    float* l4 = (float*)smem;
    l4[(w * 4 + 0) * 64 + lane] = a0; l4[(w * 4 + 1) * 64 + lane] = a1; l4[(w * 4 + 2) * 64 + lane] = a2; l4[(w * 4 + 3) * 64 + lane] = a3;
    __syncthreads();
    if (tid < 256) {
      const int b = tid >> 6; float s = 0.f;
      for (int ww = 0; ww < 8; ++ww) s += l4[(ww * 4 + b) * 64 + lane];
      mod[((size_t)l * 4 + b) * 3072 + j0 + lane] = s + p.b_ada[l * 3072 + j0 + lane];
    }
    __syncthreads();
  }
  f32x2* rope = (f32x2*)(p.ws + OFF_ROPE);
  for (int i = blockIdx.x * 512 + tid; i < T * 8; i += gridDim.x * 512) {
    const int tok = i >> 3, fi = i & 7;
    float inv;
    switch (fi) { case 0: inv = 1.0f; break; case 1: inv = 0.1939227432012558f; break; case 2: inv = 0.03760603070259094f; break; case 3: inv = 0.007292664609849453f; break;
                  case 4: inv = 0.0014142135623842478f; break; case 5: inv = 0.00027424818836152554f; break; case 6: inv = 5.318296098266728e-05f; break; default: inv = 1.0313386155758053e-05f; break; }
    const float angf = (float)p.pos[tok] * inv;
    const double a = (double)angf;
    const double q = rint(a * 0.63661977236758134308);
    double r = fma(-q, 1.57079632679489655800, a); r = fma(-q, 6.12323399573676603587e-17, r);
    const int n = ((int)q) & 3;
    const double r2 = r * r;
    const double sn = r + r * r2 * (-1.0 / 6 + r2 * (1.0 / 120 + r2 * (-1.0 / 5040 + r2 * (1.0 / 362880 - r2 * (1.0 / 39916800)))));
    const double cs = 1.0 + r2 * (-0.5 + r2 * (1.0 / 24 + r2 * (-1.0 / 720 + r2 * (1.0 / 40320 + r2 * (-1.0 / 3628800 + r2 * (1.0 / 479001600))))));
    double co, si;
    if (n == 0) { co = cs; si = sn; } else if (n == 1) { co = -sn; si = cs; } else if (n == 2) { co = -cs; si = -sn; } else { co = sn; si = -cs; }
    rope[i] = (f32x2){(float)co, (float)si};
  }
  if (blockIdx.x == 0 && tid < 2) {
    const float* dl = p.diff_lambda + tid * 256;
    float s1 = 0.f, s2 = 0.f;
    for (int i = 0; i < 64; ++i) { s1 += dl[i] * dl[64 + i]; s2 += dl[128 + i] * dl[192 + i]; }
    const float li = 0.8f - 0.6f * expf(-0.3f * (float)tid);
    ((float*)(p.ws + OFF_LAM))[tid] = expf(s1) - expf(s2) + li;
  }
}

DEV void phase_norm(const Params& p, int layer, const float* __restrict__ xin) {
  const int tid_ = ltid(); const int wid = tid_ >> 6, lane = tid_ & 63;
  const float* mod = (const float*)(p.ws + OFF_MOD) + (size_t)layer * 4 * 3072;
  const float* gain = p.norm_gain + layer * 1024;
  bf16_t* H = (bf16_t*)(p.ws + OFF_H);
  for (int row = blockIdx.x * 8 + wid; row < T; row += gridDim.x * 8) {
    const int b = row >> 12;
    const float* xr = xin + (size_t)row * 1024;
    f32x4 v[4]; float ss = 0.f;
#pragma unroll
    for (int i = 0; i < 4; ++i) { v[i] = *(const f32x4*)(xr + i * 256 + lane * 4); ss += v[i][0] * v[i][0] + v[i][1] * v[i][1] + v[i][2] * v[i][2] + v[i][3] * v[i][3]; }
#pragma unroll
    for (int o = 32; o > 0; o >>= 1) ss += __shfl_xor(ss, o);
    const float rstd = rsqrtf(ss * (1.0f / 1024.0f) + RMS_EPS);
#pragma unroll
    for (int i = 0; i < 4; ++i) {
      const int c = i * 256 + lane * 4;
      const f32x4 g = *(const f32x4*)(gain + c), sh = *(const f32x4*)(mod + b * 3072 + c), sc = *(const f32x4*)(mod + b * 3072 + 1024 + c);
      float h0 = v[i][0] * rstd * g[0] * (1.f + sc[0]) + sh[0], h1 = v[i][1] * rstd * g[1] * (1.f + sc[1]) + sh[1];
      float h2 = v[i][2] * rstd * g[2] * (1.f + sc[2]) + sh[2], h3 = v[i][3] * rstd * g[3] * (1.f + sc[3]) + sh[3];
      u32x2 w; w[0] = cvtpk(h0, h1); w[1] = cvtpk(h2, h3);
      *(u32x2*)(H + (size_t)row * 1024 + c) = w;
    }
  }
}

DEV void phase_final(const Params& p) {
  const int tid_ = ltid(); const int wid = tid_ >> 6, lane = tid_ & 63;
  for (int row = blockIdx.x * 8 + wid; row < T; row += gridDim.x * 8) {
    float* xr = p.out + (size_t)row * 1024;
    f32x4 v[4]; float ss = 0.f;
#pragma unroll
    for (int i = 0; i < 4; ++i) { v[i] = *(const f32x4*)(xr + i * 256 + lane * 4); ss += v[i][0] * v[i][0] + v[i][1] * v[i][1] + v[i][2] * v[i][2] + v[i][3] * v[i][3]; }
#pragma unroll
    for (int o = 32; o > 0; o >>= 1) ss += __shfl_xor(ss, o);
    const float rstd = rsqrtf(ss * (1.0f / 1024.0f) + RMS_EPS);
#pragma unroll
    for (int i = 0; i < 4; ++i) {
      const int c = i * 256 + lane * 4;
      const f32x4 g = *(const f32x4*)(p.final_gain + c);
      f32x4 o; o[0] = v[i][0] * rstd * g[0]; o[1] = v[i][1] * rstd * g[1]; o[2] = v[i][2] * rstd * g[2]; o[3] = v[i][3] * rstd * g[3];
      *(f32x4*)(xr + c) = o;
    }
  }
}

constexpr int HALF = 128, BK = 64, HT = HALF * BK;
DEV int lds_byte(int r, int c) { const int st = (r >> 4) * 2 + (c >> 5), rr = r & 15, cc = c & 31, ob = rr * 64 + cc * 2; return st * 1024 + (ob ^ (((ob >> 9) & 1) << 5)); }
DEV void stage_rc(int b, int& R, int& C) { const int st = b / 1024, sb = b % 1024, swz = sb ^ (((sb >> 9) & 1) << 5); R = (st >> 1) * 16 + swz / 64; C = (st & 1) * 32 + (swz % 64) / 2; }

DEV bool gemm_next(int i, int nM, int nN, int& pm, int& pn) {
  const int nwg = nM * nN; const long L = (long)i * gridDim.x + blockIdx.x; if (L >= nwg) return false;
  int wgid = (int)L; { const int q = nwg / 8, r = nwg % 8, xcd = wgid % 8, off = wgid / 8; wgid = (xcd < r ? xcd * (q + 1) : r * (q + 1) + (xcd - r) * q) + off; }
  const int nig = 8 * nN, gid = wgid / nig, fm = gid * 8, gsz = (nM - fm) < 8 ? (nM - fm) : 8;
  pm = fm + ((wgid % nig) % gsz); pn = (wgid % nig) / gsz; return true;
}

struct GUnit { const char* a; const char* b; int nt, pm, pn, s; };
typedef __attribute__((address_space(3))) unsigned char LDSC;
template <class Next, class Epi>
DEV void gemm_stream(Next&& next, Epi&& epi) {
  LDSC* lds = (LDSC*)smem;
  const int tid = ltid(), wid = __builtin_amdgcn_readfirstlane(tid >> 6), lane = tid & 63, wr = wid >> 2, wc = wid & 3, fr = lane & 15, fq = lane >> 4;
  unsigned voff[2];
#pragma unroll
  for (int i = 0; i < 2; ++i) { int R, C; stage_rc(tid * 16 + i * 8192, R, C); voff[i] = (unsigned)(R * 1024 + C) * 2u; }
  constexpr size_t kstep = 128, hstep = (size_t)128 * 1024 * 2;
  constexpr int HTB = 128 * 64 * 2;
  const unsigned ldsw = (unsigned)wid * 1024u;
  const int aoff = lds_byte(wr * 64 + fr, fq * 8), boff = lds_byte(wc * 32 + fr, fq * 8);
#define G_SA(b, h) (((b) * 2 + (h)) * HTB)
#define G_SB(b, h) ((4 + (b) * 2 + (h)) * HTB)
#define G_STAGE(bufoff, gbase) do { _Pragma("unroll") for (int _i = 0; _i < 2; ++_i) \
    __builtin_amdgcn_global_load_lds((const unsigned*)((const char*)(gbase) + voff[_i]), (__attribute__((address_space(3))) unsigned*)(lds + (bufoff) + ldsw + _i * 8192), 16, 0, 0); } while (0)
#define G_LDA(dst, b, h) do { _Pragma("unroll") for (int m = 0; m < 4; ++m) _Pragma("unroll") for (int k = 0; k < 2; ++k) dst[m][k] = *(const __attribute__((address_space(3))) bf16x8*)(lds + G_SA(b, h) + aoff + m * 2048 + k * 1024); } while (0)
#define G_LDB(dst, b, h) do { _Pragma("unroll") for (int n = 0; n < 2; ++n) _Pragma("unroll") for (int k = 0; k < 2; ++k) dst[n][k] = *(const __attribute__((address_space(3))) bf16x8*)(lds + G_SB(b, h) + boff + n * 2048 + k * 1024); } while (0)
#define G_MMA(ai, bj, At, Bf) do { __builtin_amdgcn_s_setprio(1); _Pragma("unroll") for (int m = 0; m < 4; ++m) _Pragma("unroll") for (int n = 0; n < 2; ++n) _Pragma("unroll") for (int k = 0; k < 2; ++k) \
    acc[ai][bj][m][n] = __builtin_amdgcn_mfma_f32_16x16x32_bf16(Bf[n][k], At[m][k], acc[ai][bj][m][n], 0, 0, 0); __builtin_amdgcn_s_setprio(0); } while (0)
#define G_WAIT_V(n) asm volatile("s_waitcnt vmcnt(" #n ")" ::: "memory")
#define G_WAIT_L(n) asm volatile("s_waitcnt lgkmcnt(" #n ")" ::: "memory")
#define G_BAR __builtin_amdgcn_s_barrier()
#define G_SCHED __builtin_amdgcn_sched_barrier(0)
  GUnit cur, nxt; int ui = 0;
  if (!next(0, cur)) return;
  f32x4 acc[2][2][4][2];
#pragma unroll
  for (int a = 0; a < 2; ++a)
#pragma unroll
    for (int b = 0; b < 2; ++b)
#pragma unroll
      for (int m = 0; m < 4; ++m)
#pragma unroll
        for (int n = 0; n < 2; ++n) acc[a][b][m][n] = (f32x4){0.f, 0.f, 0.f, 0.f};
  bf16x8 At[4][2], B0[2][2], B1[2][2];
  const char* cA = cur.a; const char* cB = cur.b;
  G_STAGE(G_SB(0, 0), cB); G_STAGE(G_SA(0, 0), cA); G_STAGE(G_SB(0, 1), cB + hstep); G_STAGE(G_SA(0, 1), cA + hstep);
  if (wr == 1) G_BAR;
  G_WAIT_V(4); G_BAR;
  G_STAGE(G_SB(1, 0), cB + kstep); G_STAGE(G_SA(1, 0), cA + kstep); G_STAGE(G_SB(1, 1), cB + hstep + kstep);
  G_WAIT_V(6); G_BAR;
  for (;;) {
    const bool has_next = next(ui + 1, nxt);
    const char* nA = has_next ? nxt.a : cA; const char* nB = has_next ? nxt.b : cB;
    const int nt = cur.nt;
    for (int t = 0; t < nt; t += 2) {
      const bool last = (t == nt - 2);
      const char* a1 = cA + (size_t)(t + 1) * kstep;
      const char* a2 = last ? nA : cA + (size_t)(t + 2) * kstep; const char* b2 = last ? nB : cB + (size_t)(t + 2) * kstep;
      const char* a3 = a2 + kstep; const char* b3 = b2 + kstep;
      G_LDB(B0, 0, 0); G_SCHED; G_LDA(At, 0, 0); G_STAGE(G_SA(1, 1), a1 + hstep);
      G_WAIT_L(8); G_BAR; G_WAIT_L(0); G_MMA(0, 0, At, B0); G_BAR; G_SCHED;
      G_LDB(B1, 0, 1); G_STAGE(G_SB(0, 0), b2);
      G_BAR; G_WAIT_L(0); G_MMA(0, 1, At, B1); G_BAR;
      G_LDA(At, 0, 1); G_STAGE(G_SA(0, 0), a2);
      G_BAR; G_WAIT_L(0); G_MMA(1, 0, At, B0); G_BAR; G_SCHED;
      G_STAGE(G_SB(0, 1), b2 + hstep);
      G_WAIT_V(6); G_BAR; G_MMA(1, 1, At, B1); G_BAR;
      G_LDB(B0, 1, 0); G_SCHED; G_LDA(At, 1, 0); G_STAGE(G_SA(0, 1), a2 + hstep);
      G_WAIT_L(8); G_BAR; G_WAIT_L(0); G_MMA(0, 0, At, B0); G_BAR; G_SCHED;
      G_LDB(B1, 1, 1); G_STAGE(G_SB(1, 0), b3);
      G_BAR; G_WAIT_L(0); G_MMA(0, 1, At, B1); G_BAR;
      G_LDA(At, 1, 1); G_STAGE(G_SA(1, 0), a3);
      G_BAR; G_WAIT_L(0); G_MMA(1, 0, At, B0); G_BAR; G_SCHED;
      G_STAGE(G_SB(1, 1), b3 + hstep);
      G_WAIT_V(6); G_BAR; G_MMA(1, 1, At, B1); G_BAR;
    }
    epi(acc, cur, wr, wc, fr, fq);
    if (!has_next) break;
#pragma unroll
    for (int a = 0; a < 2; ++a)
#pragma unroll
      for (int b = 0; b < 2; ++b)
#pragma unroll
        for (int m = 0; m < 4; ++m)
#pragma unroll
          for (int n = 0; n < 2; ++n) acc[a][b][m][n] = (f32x4){0.f, 0.f, 0.f, 0.f};
    cur = nxt; cA = nA; cB = nB; ++ui;
  }
  G_WAIT_V(0);
  if (wr == 0) G_BAR;
  G_BAR;
#undef G_SA
#undef G_SB
#undef G_STAGE
#undef G_LDA
#undef G_LDB
#undef G_MMA
}

DEV void phase_inproj(const Params& p) {
  const char* H = p.ws + OFF_H;
  const char* W = p.ws + OFF_WIN;
  const f32x4* rope = (const f32x4*)(p.ws + OFF_ROPE);
  char* ws = p.ws;
  __syncthreads();
  gemm_stream([&](int i, GUnit& u) -> bool {
      int pm, pn; if (!gemm_next(i, 64, 22, pm, pn)) return false;
      u.a = H + (size_t)pm * 256 * 2048; u.b = W + (size_t)pn * 256 * 2048; u.nt = 16; u.pm = pm; u.pn = pn; u.s = 0; return true; },
    [&](f32x4 (&acc)[2][2][4][2], const GUnit& u, int wr, int wc, int fr, int fq) {
      const int c0 = u.pn * 256;
      size_t base; int ld, lc; bool rp;
      if (c0 < 1024) { base = OFF_AQK; ld = 1024; lc = c0; rp = true; }
      else if (c0 < 1536) { base = OFF_AV; ld = 512; lc = c0 - 1024; rp = false; }
      else if (c0 < 2304) { base = OFF_BK; ld = 768; lc = c0 - 1536; rp = true; }
      else if (c0 < 3072) { base = OFF_BV; ld = 768; lc = c0 - 2304; rp = false; }
      else if (c0 < 3840) { base = OFF_C; ld = 768; lc = c0 - 3072; rp = false; }
      else if (c0 < 4608) { base = OFF_BQ; ld = 768; lc = c0 - 3840; rp = true; }
      else { base = OFF_Z; ld = 1024; lc = c0 - 4608; rp = false; }
      bf16_t* dst = (bf16_t*)(ws + base);
      const bool dorope = rp && ((wc & 1) == 0) && (fq < 2);
#pragma unroll
      for (int ai = 0; ai < 2; ++ai)
#pragma unroll
        for (int m = 0; m < 4; ++m) {
          const int row = u.pm * 256 + ai * 128 + wr * 64 + m * 16 + fr;
          f32x4 cs0 = {1.f, 0.f, 1.f, 0.f}, cs1 = {1.f, 0.f, 1.f, 0.f};
          if (dorope) { cs0 = rope[(size_t)row * 4 + fq * 2]; cs1 = rope[(size_t)row * 4 + fq * 2 + 1]; }
#pragma unroll
          for (int bj = 0; bj < 2; ++bj) {
            f32x4 v0 = acc[ai][bj][m][0], v1 = acc[ai][bj][m][1];
            if (dorope) {
              f32x4 a, b;
              a[0] = v0[0] * cs0[0] - v0[1] * cs0[1]; a[1] = v0[1] * cs0[0] + v0[0] * cs0[1];
              a[2] = v0[2] * cs0[2] - v0[3] * cs0[3]; a[3] = v0[3] * cs0[2] + v0[2] * cs0[3];
              b[0] = v1[0] * cs1[0] - v1[1] * cs1[1]; b[1] = v1[1] * cs1[0] + v1[0] * cs1[1];
              b[2] = v1[2] * cs1[2] - v1[3] * cs1[3]; b[3] = v1[3] * cs1[2] + v1[2] * cs1[3];
              v0 = a; v1 = b;
            }
            u32x4 w; w[0] = cvtpk(v0[0], v0[1]); w[1] = cvtpk(v0[2], v0[3]); w[2] = cvtpk(v1[0], v1[1]); w[3] = cvtpk(v1[2], v1[3]);
            *(u32x4*)(dst + (size_t)row * ld + lc + bj * 128 + wc * 32 + fq * 8) = w;
          }
        }
    });
}

DEV void phase_gates(const Params& p) {
  {
    const bf16_t* OB = (const bf16_t*)(p.ws + OFF_BQ);
    const float* LSE = (const float*)(p.ws + OFF_LSE);
    const bf16_t* Z = (const bf16_t*)(p.ws + OFF_Z);
    bf16_t* Y = (bf16_t*)(p.ws + OFF_Y);
    for (int i = blockIdx.x * 512 + ltid(); i < T * 32; i += gridDim.x * 512) {
      const int tok = i >> 5, hs = (i >> 3) & 3, dc = (i & 7) * 8;
      const float l0 = LSE[((size_t)0 * T + tok) * 4 + hs], l1 = LSE[((size_t)1 * T + tok) * 4 + hs], l2 = LSE[((size_t)2 * T + tok) * 4 + hs];
      const float mx = fmaxf(l0, fmaxf(l1, l2));
      float e0 = __expf(l0 - mx), e1 = __expf(l1 - mx), e2 = __expf(l2 - mx);
      const float inv = 1.0f / (e0 + e1 + e2); e0 *= inv; e1 *= inv; e2 *= inv;
      const u32x4 a = *(const u32x4*)(OB + (size_t)tok * 768 + 0 * 256 + hs * 64 + dc);
      const u32x4 b = *(const u32x4*)(OB + (size_t)tok * 768 + 1 * 256 + hs * 64 + dc);
      const u32x4 c = *(const u32x4*)(OB + (size_t)tok * 768 + 2 * 256 + hs * 64 + dc);
      const u32x4 z = *(const u32x4*)(Z + (size_t)tok * 1024 + 512 + hs * 64 + dc);
      u32x4 w;
#pragma unroll
      for (int k = 0; k < 4; ++k) {
        const float lo = (e0 * bflo(a[k]) + e1 * bflo(b[k]) + e2 * bflo(c[k])) * siluf(bflo(z[k]));
        const float hi = (e0 * bfhi(a[k]) + e1 * bfhi(b[k]) + e2 * bfhi(c[k])) * siluf(bfhi(z[k]));
        w[k] = cvtpk(lo, hi);
      }
      *(u32x4*)(Y + (size_t)tok * 1024 + 512 + hs * 64 + dc) = w;
    }
  }
  const char* H = p.ws + OFF_H;
  const char* W = p.ws + OFF_WIN + (size_t)5632 * 2048;
  bf16_t* G = (bf16_t*)(p.ws + OFF_G);
  __syncthreads();
  gemm_stream([&](int i, GUnit& u) -> bool {
      int pm, pn; if (!gemm_next(i, 64, 12, pm, pn)) return false;
      u.a = H + (size_t)pm * 256 * 2048; u.b = W + (size_t)pn * 256 * 2048; u.nt = 16; u.pm = pm; u.pn = pn; u.s = 0; return true; },
    [&](f32x4 (&acc)[2][2][4][2], const GUnit& u, int wr, int wc, int fr, int fq) {
#pragma unroll
      for (int ai = 0; ai < 2; ++ai)
#pragma unroll
        for (int m = 0; m < 4; ++m) {
          const int row = u.pm * 256 + ai * 128 + wr * 64 + m * 16 + fr;
#pragma unroll
          for (int bj = 0; bj < 2; ++bj) {
            const f32x4 v0 = acc[ai][bj][m][0], v1 = acc[ai][bj][m][1];
            u32x4 w; w[0] = cvtpk(sigmoidf(v0[0]), sigmoidf(v0[1])); w[1] = cvtpk(sigmoidf(v0[2]), sigmoidf(v0[3]));
            w[2] = cvtpk(sigmoidf(v1[0]), sigmoidf(v1[1])); w[3] = cvtpk(sigmoidf(v1[2]), sigmoidf(v1[3]));
            *(u32x4*)(G + (size_t)row * 3072 + u.pn * 256 + bj * 128 + wc * 32 + fq * 8) = w;
          }
        }
    });
}

DEV void phase_merge(const Params& p, int layer) {
  const char* Y = p.ws + OFF_Y;
  const char* W = p.ws + OFF_WBR + (size_t)layer * 1024 * 2048;
  const bf16_t* G = (const bf16_t*)(p.ws + OFF_G);
  bf16_t* M = (bf16_t*)(p.ws + OFF_H);
  __syncthreads();
  gemm_stream([&](int i, GUnit& u) -> bool {
      const int uu = i / 3, s = i - uu * 3;
      int pm, pn; if (!gemm_next(uu, 64, 4, pm, pn)) return false;
      const int koff = (s == 0) ? 0 : (s == 1 ? 512 : 768);
      u.a = Y + (size_t)pm * 256 * 2048 + koff * 2; u.b = W + (size_t)pn * 256 * 2048 + koff * 2; u.nt = (s == 0) ? 8 : 4; u.pm = pm; u.pn = pn; u.s = s; return true; },
    [&](f32x4 (&acc)[2][2][4][2], const GUnit& u, int wr, int wc, int fr, int fq) {
      const int s = u.s;
#pragma unroll
      for (int ai = 0; ai < 2; ++ai)
#pragma unroll
        for (int m = 0; m < 4; ++m) {
          const int row = u.pm * 256 + ai * 128 + wr * 64 + m * 16 + fr;
#pragma unroll
          for (int bj = 0; bj < 2; ++bj) {
            const int col = u.pn * 256 + bj * 128 + wc * 32 + fq * 8;
            const u32x4 g = *(const u32x4*)(G + (size_t)row * 3072 + s * 1024 + col);
            u32x4 old = {0u, 0u, 0u, 0u};
            if (s > 0) old = *(const u32x4*)(M + (size_t)row * 1024 + col);
            const f32x4 v0 = acc[ai][bj][m][0], v1 = acc[ai][bj][m][1];
            u32x4 w;
            w[0] = cvtpk(bflo(old[0]) + bflo(g[0]) * v0[0], bfhi(old[0]) + bfhi(g[0]) * v0[1]);
            w[1] = cvtpk(bflo(old[1]) + bflo(g[1]) * v0[2], bfhi(old[1]) + bfhi(g[1]) * v0[3]);
            w[2] = cvtpk(bflo(old[2]) + bflo(g[2]) * v1[0], bfhi(old[2]) + bfhi(g[2]) * v1[1]);
            w[3] = cvtpk(bflo(old[3]) + bflo(g[3]) * v1[2], bfhi(old[3]) + bfhi(g[3]) * v1[3]);
            *(u32x4*)(M + (size_t)row * 1024 + col) = w;
          }
        }
    });
}

DEV void phase_out(const Params& p, int layer, const float* __restrict__ xin) {
  const char* M = p.ws + OFF_H;
  const char* W = p.ws + OFF_WOUT + (size_t)layer * 1024 * 2048;
  const float* mod = (const float*)(p.ws + OFF_MOD) + (size_t)layer * 4 * 3072 + 2048;
  float* out = p.out;
  __syncthreads();
  gemm_stream([&](int i, GUnit& u) -> bool {
      int pm, pn; if (!gemm_next(i, 64, 4, pm, pn)) return false;
      u.a = M + (size_t)pm * 256 * 2048; u.b = W + (size_t)pn * 256 * 2048; u.nt = 16; u.pm = pm; u.pn = pn; u.s = 0; return true; },
    [&](f32x4 (&acc)[2][2][4][2], const GUnit& u, int wr, int wc, int fr, int fq) {
      const int b = u.pm >> 4;
#pragma unroll
      for (int bj = 0; bj < 2; ++bj) {
        const int col = u.pn * 256 + bj * 128 + wc * 32 + fq * 8;
        const f32x4 g0 = *(const f32x4*)(mod + b * 3072 + col), g1 = *(const f32x4*)(mod + b * 3072 + col + 4);
#pragma unroll
        for (int ai = 0; ai < 2; ++ai)
#pragma unroll
          for (int m = 0; m < 4; ++m) {
            const int row = u.pm * 256 + ai * 128 + wr * 64 + m * 16 + fr;
            const f32x4 x0 = *(const f32x4*)(xin + (size_t)row * 1024 + col), x1 = *(const f32x4*)(xin + (size_t)row * 1024 + col + 4);
            *(f32x4*)(out + (size_t)row * 1024 + col) = x0 + g0 * acc[ai][bj][m][0];
            *(f32x4*)(out + (size_t)row * 1024 + col + 4) = x1 + g1 * acc[ai][bj][m][1];
          }
      }
    });
  __syncthreads();
  if (layer == 0) cvt_win_layer(p, 1);
}

#define KSWZ_A(row, colB) ((row) * 256 + ((colB) ^ (((row) & 7) << 4)))
#define KSWZ_S(row, colB) ((row) * 128 + ((colB) ^ ((((row) >> 1) & 7) << 4)))
template <int DV> DEV int v_st(int k, int c) { const int kk = (k & ~0xC) | ((k & 4) << 1) | ((k & 8) >> 1); return ((kk >> 3) * (DV / 32) + (c >> 5)) * 512 + ((kk & 7) * 32 + (c & 31)) * 2; }
DEV int v_rd_base(int lane) { return ((lane & 3) << 3) | (((lane >> 2) & 3) << 6) | (((lane >> 4) & 1) << 5) | (((lane >> 5) & 1) << 8); }
template <int OFF> DEV s16x4 tr_read(int vb) { s16x4 r; asm volatile("ds_read_b64_tr_b16 %0, %1 offset:%2" : "=&v"(r) : "v"(vb), "i"(OFF) : "memory"); return r; }
template <int DV, int D0> DEV void pv_one(f32x16& od, int vb, bf16x8 pa0, bf16x8 pa1, bf16x8 pa2, bf16x8 pa3) {
  constexpr int KS = (DV / 32) * 1024, HF = (DV / 32) * 512;
  const s16x4 l0 = tr_read<D0 * 512 + 0 * KS>(vb), h0 = tr_read<D0 * 512 + 0 * KS + HF>(vb), l1 = tr_read<D0 * 512 + 1 * KS>(vb), h1 = tr_read<D0 * 512 + 1 * KS + HF>(vb);
  const s16x4 l2 = tr_read<D0 * 512 + 2 * KS>(vb), h2 = tr_read<D0 * 512 + 2 * KS + HF>(vb), l3 = tr_read<D0 * 512 + 3 * KS>(vb), h3 = tr_read<D0 * 512 + 3 * KS + HF>(vb);
  asm volatile("s_waitcnt lgkmcnt(0)" ::: "memory"); __builtin_amdgcn_sched_barrier(0);
#define PK(L, H) (bf16x8){L[0], L[1], L[2], L[3], H[0], H[1], H[2], H[3]}
  od = __builtin_amdgcn_mfma_f32_32x32x16_bf16(pa0, PK(l0, h0), od, 0, 0, 0);
  od = __builtin_amdgcn_mfma_f32_32x32x16_bf16(pa1, PK(l1, h1), od, 0, 0, 0);
  od = __builtin_amdgcn_mfma_f32_32x32x16_bf16(pa2, PK(l2, h2), od, 0, 0, 0);
  od = __builtin_amdgcn_mfma_f32_32x32x16_bf16(pa3, PK(l3, h3), od, 0, 0, 0);
#undef PK
}

template <int MODE>
DEV void attn_unit(const Params& p, int layer, int u) {
  constexpr int DV = (MODE == 0) ? 128 : 64, ND = DV / 32;
  constexpr int TB = (MODE == 0) ? 16384 : 8192;
  constexpr float C = SCALE * 1.4426950408889634f;
  constexpr float THRRAW = 8.0f / SCALE;
  const int tid = ltid(), wid = tid >> 6, lane = tid & 63, r32 = lane & 31, hi = lane >> 5;
  char* V_lds = smem; char* K_lds = smem + 2 * TB;
  float* wsc = (float*)(smem + 131072) + wid * 64; float* li_l = wsc; float* al_l = wsc + 32;
  float* rpb_l = (float*)(smem + 131072 + 2048);

  int b = 0, h = 0, NT = 0, tfirst = 0;
  int g = 0, rr = 1, mres = 0, blk = 0, Lsub = 0;
  int r0 = 0, row_lo = 0, qrow = 0, qcol = 0, rs = 0, cs = 0;
  const bf16_t *Qp, *Kb, *Vb; int ldkv;
  int qtok;
  int coff = 0;
  if (MODE == 0) {
    const int pair = ((u & 7) << 1) | (u >> 8), qb = (u >> 3) & 31; b = pair >> 2; h = pair & 3;
    const int g4 = wid >> 1, cm = wid & 1; coff = cm * 64;
    qtok = b * SEQ + qb * 128 + g4 * 32 + r32;
    Qp = (const bf16_t*)(p.ws + OFF_AQK) + (size_t)qtok * 1024 + h * 128 + cm * 64;
    Kb = (const bf16_t*)(p.ws + OFF_AQK) + 512 + h * 128; Vb = (const bf16_t*)(p.ws + OFF_AV) + h * 128; ldkv = 0;
    NT = 64; tfirst = 0;
  } else if (MODE == 1) {
    b = u / 192; int rem = u % 192; h = rem / 48; rem %= 48; g = rem / 16; const int uu = rem % 16;
    rr = (g == 0) ? 1 : (g == 1 ? 4 : 16); Lsub = SEQ / rr; mres = uu % rr; blk = uu / rr;
    const int qn = blk * 256 + wid * 32 + r32;
    qtok = b * SEQ + qn * rr + mres;
    Qp = (const bf16_t*)(p.ws + OFF_BQ) + (size_t)qtok * 768 + g * 256 + h * 64;
    Kb = (const bf16_t*)(p.ws + OFF_BK) + g * 256 + h * 64; Vb = (const bf16_t*)(p.ws + OFF_BV) + g * 256 + h * 64; ldkv = 768;
    tfirst = (blk == 0) ? 1 : 0; int tl = (Lsub - (blk * 256 - 64)) / 64 - 1; if (tl > 5) tl = 5; NT = tl + 1;
  } else {
    b = u >> 6; h = (u >> 4) & 3; r0 = (u & 15) * 4;
    qrow = r0 + (wid >> 1); qcol = (wid & 1) * 32 + r32;
    qtok = b * SEQ + qrow * 64 + qcol;
    Qp = (const bf16_t*)(p.ws + OFF_C) + (size_t)qtok * 768 + h * 64;
    Kb = (const bf16_t*)(p.ws + OFF_C) + 256 + h * 64; Vb = (const bf16_t*)(p.ws + OFF_C) + 512 + h * 64; ldkv = 768;
    row_lo = r0 - 4; if (row_lo < 0) row_lo = 0; if (row_lo > 56) row_lo = 56;
    int rl3 = r0 + 3 - 4; if (rl3 < 0) rl3 = 0; if (rl3 > 56) rl3 = 56;
    NT = rl3 + 8 - row_lo; tfirst = 0;
    rs = qrow - 4; if (rs < 0) rs = 0; if (rs > 56) rs = 56;
    cs = qcol - 8; if (cs < 0) cs = 0; if (cs > 48) cs = 48;
    const float* rp = p.rpb + ((size_t)layer * 4 + h) * 465;
    if (tid < 465) rpb_l[tid] = rp[tid] * (1.0f / SCALE);
  }
  (void)ldkv;

  bf16x8 qr[4];
#pragma unroll
  for (int d0 = 0; d0 < 4; ++d0) qr[d0] = *(const bf16x8*)(Qp + d0 * 16 + hi * 8);

  bf16x8 st0, st1, st2, st3;
  auto key_tok = [&](int t, int i) -> int {
    if (MODE == 0) return b * SEQ + t * 64 + i;
    if (MODE == 1) return b * SEQ + (blk * 256 - 64 + 64 * t + i) * rr + mres;
    return b * SEQ + (row_lo + t) * 64 + i;
  };
  auto sload = [&](int t) {
    if (MODE == 0) {
      const int sr = tid >> 4, sc = (tid & 15) * 8;
      const size_t k0 = (size_t)key_tok(t, sr), k1 = (size_t)key_tok(t, 32 + sr);
      st0 = *(const bf16x8*)(Vb + k0 * 512 + sc); st1 = *(const bf16x8*)(Vb + k1 * 512 + sc);
      st2 = *(const bf16x8*)(Kb + k0 * 1024 + sc); st3 = *(const bf16x8*)(Kb + k1 * 1024 + sc);
    } else {
      const int sr = tid >> 3, sc = (tid & 7) * 8;
      const size_t k0 = (size_t)key_tok(t, sr);
      st0 = *(const bf16x8*)(Vb + k0 * 768 + sc); st2 = *(const bf16x8*)(Kb + k0 * 768 + sc);
    }
  };
  auto swrite = [&](int buf) {
    if (MODE == 0) {
      const int sr = tid >> 4, sc = (tid & 15) * 8;
      *(bf16x8*)(V_lds + buf * TB + v_st<128>(sr, sc)) = st0; *(bf16x8*)(V_lds + buf * TB + v_st<128>(32 + sr, sc)) = st1;
      *(bf16x8*)(K_lds + buf * TB + KSWZ_A(sr, sc * 2)) = st2; *(bf16x8*)(K_lds + buf * TB + KSWZ_A(32 + sr, sc * 2)) = st3;
    } else {
      const int sr = tid >> 3, sc = (tid & 7) * 8;
      *(bf16x8*)(V_lds + buf * TB + v_st<64>(sr, sc)) = st0;
      *(bf16x8*)(K_lds + buf * TB + KSWZ_S(sr, sc * 2)) = st2;
    }
  };

  float m_reg = -1e30f, l_reg = 0.f;
  f32x16 o[ND];
#pragma unroll
  for (int d = 0; d < ND; ++d) o[d] = f32x16{};
  const int vb0 = (int)(uintptr_t)V_lds + v_rd_base(lane);

  sload(tfirst); swrite(0);
  __syncthreads();
  for (int t = tfirst, it = 0; t < NT; ++t, ++it) {
    const int buf = it & 1;
    const bool more = (t + 1 < NT);
    if (more) sload(t + 1);
    bool active = true;
    if (MODE == 1) { const int tn0 = blk * 256 - 64 + 64 * t, qa = blk * 256 + wid * 32; active = (tn0 + 63 >= qa - 64) && (tn0 <= qa + 31 + 64); }
    if (MODE == 2) { const int kr = row_lo + t; active = (kr >= rs) && (kr < rs + 8); }
    if (active) {
      f32x16 p0 = f32x16{}, p1 = f32x16{};
      const char* Kt = K_lds + buf * TB;
#pragma unroll
      for (int d0 = 0; d0 < 4; ++d0) {
        const int cb = (coff + d0 * 16 + hi * 8) * 2;
        bf16x8 b0, b1;
        if (MODE == 0) { b0 = *(const bf16x8*)(Kt + KSWZ_A(r32, cb)); b1 = *(const bf16x8*)(Kt + KSWZ_A(32 + r32, cb)); }
        else { b0 = *(const bf16x8*)(Kt + KSWZ_S(r32, cb)); b1 = *(const bf16x8*)(Kt + KSWZ_S(32 + r32, cb)); }
        p0 = __builtin_amdgcn_mfma_f32_32x32x16_bf16(b0, qr[d0], p0, 0, 0, 0);
        p1 = __builtin_amdgcn_mfma_f32_32x32x16_bf16(b1, qr[d0], p1, 0, 0, 0);
      }
      if (MODE == 1) {
        const int tn0 = blk * 256 - 64 + 64 * t, qn = blk * 256 + wid * 32 + r32;
#pragma unroll
        for (int r = 0; r < 16; ++r) {
          const int d0k = tn0 + crow(r, hi) - qn, d1k = d0k + 32;
          if (d0k > 64 || d0k < -64) p0[r] = -INFINITY;
          if (d1k > 64 || d1k < -64) p1[r] = -INFINITY;
        }
      }
      if (MODE == 2) {
        const int kr = row_lo + t; const int rb = (kr - qrow + 7) * 31;
#pragma unroll
        for (int r = 0; r < 16; ++r) {
          const int kc0 = crow(r, hi), kc1 = kc0 + 32;
          int dc0 = kc0 - qcol + 15, dc1 = kc1 - qcol + 15;
          dc0 = dc0 < 0 ? 0 : (dc0 > 30 ? 30 : dc0); dc1 = dc1 < 0 ? 0 : (dc1 > 30 ? 30 : dc1);
          const float b0 = rpb_l[rb + dc0], b1 = rpb_l[rb + dc1];
          p0[r] = (kc0 >= cs && kc0 < cs + 16) ? p0[r] + b0 : -INFINITY;
          p1[r] = (kc1 >= cs && kc1 < cs + 16) ? p1[r] + b1 : -INFINITY;
        }
      }
      float pmax = p0[0];
#pragma unroll
      for (int r = 1; r < 16; ++r) pmax = fmaxf(pmax, p0[r]);
#pragma unroll
      for (int r = 0; r < 16; ++r) pmax = fmaxf(pmax, p1[r]);
      { auto sw = __builtin_amdgcn_permlane32_swap(__float_as_uint(pmax), __float_as_uint(pmax), false, false);
        pmax = fmaxf(__uint_as_float(sw[0]), __uint_as_float(sw[1])); }
      float mn, alpha;
      if (__all(pmax - m_reg <= THRRAW)) { mn = m_reg; alpha = 1.f; }
      else { mn = fmaxf(m_reg, pmax); alpha = __builtin_amdgcn_exp2f((m_reg - mn) * C); m_reg = mn; }
      const float mnC = -mn * C;
      float ps = 0.f;
#pragma unroll
      for (int r = 0; r < 16; ++r) { p0[r] = __builtin_amdgcn_exp2f(fmaf(p0[r], C, mnC)); ps += p0[r]; }
#pragma unroll
      for (int r = 0; r < 16; ++r) { p1[r] = __builtin_amdgcn_exp2f(fmaf(p1[r], C, mnC)); ps += p1[r]; }
      { auto sw = __builtin_amdgcn_permlane32_swap(__float_as_uint(ps), __float_as_uint(ps), false, false);
        ps = __uint_as_float(sw[0]) + __uint_as_float(sw[1]); }
      l_reg = l_reg * alpha + ps;
      bf16x8 pa0, pa1, pa2, pa3;
#define PK4(P, BASE, OUT) do { unsigned a0 = cvtpk(P[BASE + 0], P[BASE + 1]), a1 = cvtpk(P[BASE + 2], P[BASE + 3]); \
    unsigned b0_ = cvtpk(P[BASE + 4], P[BASE + 5]), b1_ = cvtpk(P[BASE + 6], P[BASE + 7]); \
    auto r0_ = __builtin_amdgcn_permlane32_swap(a0, b0_, false, false); auto r1_ = __builtin_amdgcn_permlane32_swap(a1, b1_, false, false); \
    u32x4 w_ = {r0_[0], r1_[0], r0_[1], r1_[1]}; OUT = *reinterpret_cast<bf16x8*>(&w_); } while (0)
      PK4(p0, 0, pa0); PK4(p0, 8, pa1); PK4(p1, 0, pa2); PK4(p1, 8, pa3);
#undef PK4
      if (__any(alpha < 1.f)) {
        if (hi == 0) al_l[r32] = alpha;
        asm volatile("s_waitcnt lgkmcnt(0)" ::: "memory");
        float af[16];
#pragma unroll
        for (int r = 0; r < 16; ++r) af[r] = al_l[crow(r, hi)];
#pragma unroll
        for (int d = 0; d < ND; ++d)
#pragma unroll
          for (int r = 0; r < 16; ++r) o[d][r] *= af[r];
      }
      const int vb = vb0 + buf * TB;
      pv_one<DV, 0>(o[0], vb, pa0, pa1, pa2, pa3);
      pv_one<DV, 1>(o[1], vb, pa0, pa1, pa2, pa3);
      if (DV == 128) { pv_one<DV, 2>(o[ND - 2], vb, pa0, pa1, pa2, pa3); pv_one<DV, 3>(o[ND - 1], vb, pa0, pa1, pa2, pa3); }
    }
    if (more) swrite(buf ^ 1);
    __syncthreads();
  }

  if (hi == 0) li_l[r32] = l_reg;
  asm volatile("s_waitcnt lgkmcnt(0)" ::: "memory");
  float rli[16];
#pragma unroll
  for (int r = 0; r < 16; ++r) rli[r] = 1.0f / li_l[crow(r, hi)];
  const int qtok0 = __shfl(qtok, 0);
  if (MODE == 0) {
    const int g4 = wid >> 1, cm = wid & 1;
    float* X = (float*)smem + g4 * 4096;
    const float lam = ((const float*)(p.ws + OFF_LAM))[layer];
    if (cm == 1) {
#pragma unroll
      for (int d = 0; d < ND; ++d)
#pragma unroll
        for (int r = 0; r < 16; ++r) X[crow(r, hi) * 128 + d * 32 + r32] = -lam * o[d][r] * rli[r];
    }
    __syncthreads();
    if (cm == 0) {
      float ss[16];
#pragma unroll
      for (int r = 0; r < 16; ++r) ss[r] = 0.f;
#pragma unroll
      for (int d = 0; d < ND; ++d)
#pragma unroll
        for (int r = 0; r < 16; ++r) { const float dv = o[d][r] * rli[r] + X[crow(r, hi) * 128 + d * 32 + r32]; o[d][r] = dv; ss[r] += dv * dv; }
#pragma unroll
      for (int r = 0; r < 16; ++r) {
        float s = ss[r];
        s += __shfl_xor(s, 1); s += __shfl_xor(s, 2); s += __shfl_xor(s, 4); s += __shfl_xor(s, 8); s += __shfl_xor(s, 16);
        const float li = 0.8f - 0.6f * __expf(-0.3f * (float)layer);
        ss[r] = rsqrtf(s * (1.0f / 128.0f) + RMS_EPS) * (1.0f - li);
      }
      const bf16_t* Z = (const bf16_t*)(p.ws + OFF_Z); bf16_t* Y = (bf16_t*)(p.ws + OFF_Y);
#pragma unroll
      for (int d = 0; d < ND; ++d) {
        const float gn = p.subln[layer * 128 + d * 32 + r32];
#pragma unroll
        for (int r = 0; r < 16; ++r) {
          const size_t idx = (size_t)(qtok0 + crow(r, hi)) * 1024 + h * 128 + d * 32 + r32;
          const float y = o[d][r] * ss[r] * gn * siluf(bf2f(Z[idx]));
          Y[idx] = (bf16_t)(cvtpk(y, y) & 0xffffu);
        }
      }
    }
  } else if (MODE == 1) {
    bf16_t* OB = (bf16_t*)(p.ws + OFF_BQ);
    float* LSE = (float*)(p.ws + OFF_LSE);
    const int tokw = b * SEQ + (blk * 256 + wid * 32) * rr + mres;
#pragma unroll
    for (int d = 0; d < ND; ++d)
#pragma unroll
      for (int r = 0; r < 16; ++r) {
        const size_t idx = (size_t)(tokw + crow(r, hi) * rr) * 768 + g * 256 + h * 64 + d * 32 + r32;
        const float y = o[d][r] * rli[r];
        OB[idx] = (bf16_t)(cvtpk(y, y) & 0xffffu);
      }
    if (hi == 0) LSE[((size_t)g * T + qtok) * 4 + h] = m_reg * SCALE + __logf(l_reg);
  } else {
    const bf16_t* Z = (const bf16_t*)(p.ws + OFF_Z); bf16_t* Y = (bf16_t*)(p.ws + OFF_Y);
#pragma unroll
    for (int d = 0; d < ND; ++d)
#pragma unroll
      for (int r = 0; r < 16; ++r) {
        const size_t idx = (size_t)(qtok0 + crow(r, hi)) * 1024 + 768 + h * 64 + d * 32 + r32;
        const float y = o[d][r] * rli[r] * siluf(bf2f(Z[idx]));
        Y[idx] = (bf16_t)(cvtpk(y, y) & 0xffffu);
      }
  }
  __syncthreads();
}

DEV void phase_attn(const Params& p, int layer) {
  for (int u = blockIdx.x; u < 512; u += gridDim.x) attn_unit<0>(p, layer, u);
  for (int u = blockIdx.x; u < 768; u += gridDim.x) attn_unit<1>(p, layer, u);
  for (int u = blockIdx.x; u < 256; u += gridDim.x) attn_unit<2>(p, layer, u);
}

__global__ void __launch_bounds__(512, 1) mk_forward(Params p) {
  cg::grid_group grid = cg::this_grid();
  phase0(p);
  grid.sync();
#pragma unroll 1
  for (int layer = 0; layer < 2; ++layer) {
    const float* xin = layer == 0 ? p.x : p.out;
    phase_norm(p, layer, xin);
    grid.sync();
    phase_inproj(p);
    grid.sync();
    phase_attn(p, layer);
    grid.sync();
    phase_gates(p);
    grid.sync();
    phase_merge(p, layer);
    grid.sync();
    phase_out(p, layer, xin);
    grid.sync();
  }
  phase_final(p);
}

extern "C" void kernel_launch(void* const* d_in, const int* in_sizes, int n_in, void* d_out, int out_size, void* d_ws, size_t ws_size, hipStream_t stream) {
  static int grid_blocks = 0;
  if (ws_size < WS_NEED) { fprintf(stderr, "kernel_launch: workspace too small: %zu < %zu\n", ws_size, WS_NEED); return; }
  if (!grid_blocks) {
    int dev = 0, cus = 0, per_cu = 0;
    hipGetDevice(&dev);
    hipDeviceGetAttribute(&cus, hipDeviceAttributeMultiprocessorCount, dev);
    if (hipFuncSetAttribute((const void*)mk_forward, hipFuncAttributeMaxDynamicSharedMemorySize, LDS_BYTES) != hipSuccess) { fprintf(stderr, "kernel_launch: LDS attribute failed\n"); return; }
    hipOccupancyMaxActiveBlocksPerMultiprocessor(&per_cu, mk_forward, 512, LDS_BYTES);
    if (per_cu < 1) { fprintf(stderr, "kernel_launch: occupancy 0\n"); return; }
    grid_blocks = cus;
  }
  Params p{};
  p.x = (const float*)d_in[0]; p.c = (const float*)d_in[1]; p.pos = (const int*)d_in[2]; p.norm_gain = (const float*)d_in[3];
  p.w_ada = (const float*)d_in[4]; p.b_ada = (const float*)d_in[5]; p.w_in = (const float*)d_in[6]; p.diff_lambda = (const float*)d_in[7];
  p.subln = (const float*)d_in[8]; p.rpb = (const float*)d_in[9]; p.w_branch = (const float*)d_in[10]; p.w_out = (const float*)d_in[11];
  p.final_gain = (const float*)d_in[12]; p.out = (float*)d_out; p.ws = (char*)d_ws;
  void* args[] = {&p};
  hipError_t e = hipLaunchCooperativeKernel((void*)mk_forward, dim3(grid_blocks), dim3(512), args, LDS_BYTES, stream);
  if (e != hipSuccess) fprintf(stderr, "cooperative launch failed: %s (grid %d)\n", hipGetErrorString(e), grid_blocks);
}
```

```cpp
#include <hip/hip_runtime.h>
#include <hip/hip_cooperative_groups.h>
#include <cstdio>
#include <cstdint>
namespace cg = cooperative_groups;

#ifndef MK_MULTI
#define MK_MULTI 0
#endif

typedef unsigned short bf16_t;
typedef short bf16x8 __attribute__((ext_vector_type(8)));
typedef short s16x4 __attribute__((ext_vector_type(4)));
typedef float f32x4 __attribute__((ext_vector_type(4)));
typedef float f32x2 __attribute__((ext_vector_type(2)));
typedef float f32x16 __attribute__((ext_vector_type(16)));
typedef unsigned u32x4 __attribute__((ext_vector_type(4)));
typedef unsigned u32x2 __attribute__((ext_vector_type(2)));
#define DEV __device__ __forceinline__

constexpr int T = 16384, SEQ = 4096, DM = 1024, NB = 4;
constexpr int IN_COLS = 8704;
constexpr float RMS_EPS = 1e-6f;
constexpr float SCALE = 0.125f;

constexpr size_t SZ_T1024 = (size_t)T * 1024 * 2;
constexpr size_t OFF_AQK = 0;
constexpr size_t OFF_AV = OFF_AQK + SZ_T1024;
constexpr size_t OFF_BK = OFF_AV + (size_t)T * 512 * 2;
constexpr size_t OFF_BV = OFF_BK + (size_t)T * 768 * 2;
constexpr size_t OFF_C = OFF_BV + (size_t)T * 768 * 2;
constexpr size_t OFF_BQ = OFF_C + (size_t)T * 768 * 2;
constexpr size_t OFF_Z = OFF_BQ + (size_t)T * 768 * 2;
constexpr size_t OFF_H = OFF_Z + SZ_T1024;
constexpr size_t OFF_Y = OFF_H + SZ_T1024;
constexpr size_t OFF_WIN = OFF_Y + SZ_T1024;
constexpr size_t OFF_WBR = OFF_WIN + (size_t)IN_COLS * 1024 * 2;
constexpr size_t OFF_WOUT = OFF_WBR + (size_t)2 * 1024 * 1024 * 2;
constexpr size_t OFF_LSE = OFF_WOUT + (size_t)2 * 1024 * 1024 * 2;
constexpr size_t OFF_ROPE = OFF_LSE + (size_t)3 * T * 4 * 4;
constexpr size_t OFF_MOD = OFF_ROPE + (size_t)T * 8 * 8;
constexpr size_t OFF_LAM = OFF_MOD + (size_t)2 * 4 * 3072 * 4;
constexpr size_t OFF_BAR = OFF_LAM + 256;
constexpr size_t WS_NEED = OFF_BAR + 3456 * 4;
constexpr size_t OFF_G = OFF_AQK;

constexpr int LDS_BYTES = 131072 + 4096;

struct Params {
  const float* x; const float* c; const int* pos; const float* norm_gain; const float* w_ada; const float* b_ada; const float* w_in;
  const float* diff_lambda; const float* subln; const float* rpb; const float* w_branch; const float* w_out; const float* final_gain;
  float* out; char* ws;
};

extern __shared__ __attribute__((aligned(16))) char smem[];

DEV unsigned cvtpk(float lo, float hi) { unsigned r; asm volatile("v_cvt_pk_bf16_f32 %0, %1, %2" : "=v"(r) : "v"(lo), "v"(hi)); return r; }
DEV float bflo(unsigned w) { return __uint_as_float(w << 16); }
DEV float bfhi(unsigned w) { return __uint_as_float(w & 0xffff0000u); }
DEV float bf2f(bf16_t v) { return __uint_as_float(((unsigned)v) << 16); }
DEV float sigmoidf(float x) { return 1.0f / (1.0f + __expf(-x)); }
DEV float siluf(float x) { return x / (1.0f + __expf(-x)); }
DEV int perm32(int rho) { const int n = rho >> 4, i = rho & 15; return 8 * (i >> 2) + 4 * n + (i & 3); }
DEV int ltid() { int t = threadIdx.x; asm volatile("" : "+v"(t)); return t; }
DEV int lbid() { int t = blockIdx.x; asm volatile("" : "+s"(t)); return t; }
DEV int crow(int r, int hi) { return (r & 3) + 8 * (r >> 2) + 4 * hi; }

#define XB_TMO      128
#define XB_XCNT(j)  (256  + 64 * (j))
#define XB_XSUB(j)  (1280 + 64 * (j))
#define XB_XGEN(j)  (2304 + 64 * (j))
#define XB_TOP      3328
#define XB_TOPGEN   3392
#define XCD_BAR_WORDS 3456
#define XB_SPIN_CAP (1u << 18)
#define LAS __attribute__((address_space(3)))
DEV unsigned xb_ld(unsigned* p) { return __hip_atomic_load(p, __ATOMIC_RELAXED, __HIP_MEMORY_SCOPE_AGENT); }
DEV unsigned xb_add(unsigned* p, unsigned v) { return __hip_atomic_fetch_add(p, v, __ATOMIC_RELAXED, __HIP_MEMORY_SCOPE_AGENT); }
DEV unsigned xb_xcc_id() { return (unsigned)__builtin_amdgcn_s_getreg((3 << 11) | 20) & 0xFu; }
#define XB_SPIN(cond, bar) do { unsigned _sp = 0; while (cond) { __builtin_amdgcn_s_sleep(1); \
    if ((++_sp & 255u) == 0u) { if (xb_ld(&(bar)[XB_TMO])) break; if (_sp > XB_SPIN_CAP) { atomicAdd(&(bar)[XB_TMO], 1u); break; } } } } while (0)
struct XcdBarrier { unsigned* bar; unsigned x; volatile LAS unsigned* st; };
DEV XcdBarrier xcd_barrier_post(unsigned* bar, volatile LAS unsigned* st) {
  XcdBarrier b; b.bar = bar; b.x = xb_xcc_id(); b.st = st;
  if (threadIdx.x == 0) (void)xb_add(&bar[XB_XCNT(b.x)], 1u);
  return b;
}
DEV void xcd_barrier_complete(unsigned* bar, unsigned x, unsigned& nloc, unsigned& nx) {
  const unsigned G = gridDim.x * gridDim.y * gridDim.z;
  unsigned sum, cnt, mine, sp = 0u;
  for (;;) {
    sum = 0u; cnt = 0u; mine = 0u;
#pragma unroll
    for (unsigned j = 0; j < 16; ++j) { const unsigned c = xb_ld(&bar[XB_XCNT(j)]); sum += c; cnt += (c > 0u) ? 1u : 0u; mine = (j == x) ? c : mine; }
    if (sum == G) break;
    __builtin_amdgcn_s_sleep(1);
    if ((++sp & 255u) == 0u) { if (xb_ld(&bar[XB_TMO])) break; if (sp > XB_SPIN_CAP) { atomicAdd(&bar[XB_TMO], 1u); break; } }
  }
  nloc = mine > 0u ? mine : 1u; nx = cnt > 0u ? cnt : 1u;
}
DEV void xcd_barrier(const XcdBarrier& b) {
  asm volatile("s_waitcnt vmcnt(0)" ::: "memory");
  __syncthreads();
  if (threadIdx.x == 0) {
    unsigned* bar = b.bar;
    __builtin_amdgcn_s_waitcnt(0);
    unsigned nloc = b.st[0], nx = b.st[1];
    if (nloc == 0u) { xcd_barrier_complete(bar, b.x, nloc, nx); b.st[0] = nloc; b.st[1] = nx; }
    const unsigned old = xb_add(&bar[XB_XSUB(b.x)], 1u);
    const unsigned gen = old / nloc;
    if (old + 1u == (gen + 1u) * nloc) {
      __builtin_amdgcn_fence(__ATOMIC_RELEASE, "agent");
      asm volatile("s_waitcnt vmcnt(0)" ::: "memory");
      const unsigned og = xb_add(&bar[XB_TOP], 1u);
      const unsigned tg = og / nx;
      if (og + 1u == (tg + 1u) * nx) xb_add(&bar[XB_TOPGEN], 1u);
      else XB_SPIN(xb_ld(&bar[XB_TOPGEN]) == tg, bar);
      __builtin_amdgcn_fence(__ATOMIC_ACQUIRE, "agent");
      xb_add(&bar[XB_XGEN(b.x)], 1u);
      asm volatile("s_waitcnt vmcnt(0)" ::: "memory");
    } else {
      XB_SPIN(xb_ld(&bar[XB_XGEN(b.x)]) == gen, bar);
      __builtin_amdgcn_fence(__ATOMIC_ACQUIRE, "agent");
      asm volatile("s_waitcnt vmcnt(0)" ::: "memory");
    }
  }
  __syncthreads();
}

DEV int win_src_col(int j) {
  const int c = (j & ~31) + perm32(j & 31);
  int orig; bool rope;
  if (c < 1024) { orig = c; rope = true; }
  else if (c < 1536) { orig = c; rope = false; }
  else if (c < 2304) { orig = 2304 + (c - 1536); rope = true; }
  else if (c < 3072) { orig = 3072 + (c - 2304); rope = false; }
  else if (c < 3840) { orig = 3840 + (c - 3072); rope = false; }
  else if (c < 4608) { orig = 1536 + (c - 3840); rope = true; }
  else { orig = c; rope = false; }
  if (rope) { int p = orig & 63; if (p < 16) { const int i = p >> 1; p = (p & 1) ? i + 8 : i; orig = (orig & ~63) + p; } }
  return orig;
}

struct CvtTile { const float* src; int ld; bf16_t* dst; int j0, k0, o0; bool win; };
DEV void cvt_decode(const Params& p, int layer, int t, CvtTile& c) {
  if (t < 2176) { const int kt = t & 15, nt = t >> 4; c.src = p.w_in + (size_t)layer * 1024 * IN_COLS; c.ld = IN_COLS; c.dst = (bf16_t*)(p.ws + OFF_WIN); c.j0 = nt * 64; c.k0 = kt * 64; c.o0 = win_src_col(c.j0) & ~63; c.win = true; }
  else { const int tt0 = t - 2176, mat = tt0 >> 8, tt = tt0 & 255, kt = tt & 15, nt = tt >> 4, l = mat & 1;
    c.src = (mat < 2 ? p.w_branch : p.w_out) + (size_t)l * 1024 * 1024; c.ld = 1024; c.dst = (bf16_t*)(p.ws + (mat < 2 ? OFF_WBR : OFF_WOUT)) + (size_t)l * 1024 * 1024; c.j0 = nt * 64; c.k0 = kt * 64; c.o0 = c.j0; c.win = false; }
}
DEV void cvt_range(const Params& p, int layer, int tbeg, int tend) {
  float* l = (float*)smem;
  const int tid = ltid();
  int t = tbeg + blockIdx.x;
  if (t >= tend) return;
  CvtTile c; cvt_decode(p, layer, t, c);
  f32x4 v0, v1;
  { const int kr = tid >> 4, c4 = (tid & 15) * 4;
    v0 = *(const f32x4*)(c.src + (size_t)(c.k0 + kr) * c.ld + c.o0 + c4); v1 = *(const f32x4*)(c.src + (size_t)(c.k0 + 32 + kr) * c.ld + c.o0 + c4); }
  for (;;) {
    { const int kr = tid >> 4, c4 = (tid & 15) * 4;
      l[kr * 65 + c4 + 0] = v0[0]; l[kr * 65 + c4 + 1] = v0[1]; l[kr * 65 + c4 + 2] = v0[2]; l[kr * 65 + c4 + 3] = v0[3];
      l[(kr + 32) * 65 + c4 + 0] = v1[0]; l[(kr + 32) * 65 + c4 + 1] = v1[1]; l[(kr + 32) * 65 + c4 + 2] = v1[2]; l[(kr + 32) * 65 + c4 + 3] = v1[3]; }
    __syncthreads();
    const int tn = t + gridDim.x; CvtTile cn;
    if (tn < tend) { cvt_decode(p, layer, tn, cn); const int kr = tid >> 4, c4 = (tid & 15) * 4;
      v0 = *(const f32x4*)(cn.src + (size_t)(cn.k0 + kr) * cn.ld + cn.o0 + c4); v1 = *(const f32x4*)(cn.src + (size_t)(cn.k0 + 32 + kr) * cn.ld + cn.o0 + c4); }
    const int jj = tid >> 3, kc = (tid & 7) * 8, j = c.j0 + jj;
    const int oc = (c.win ? win_src_col(j) : ((j & ~31) + perm32(j & 31))) - c.o0;
    u32x4 w;
    w[0] = cvtpk(l[(kc + 0) * 65 + oc], l[(kc + 1) * 65 + oc]);
    w[1] = cvtpk(l[(kc + 2) * 65 + oc], l[(kc + 3) * 65 + oc]);
    w[2] = cvtpk(l[(kc + 4) * 65 + oc], l[(kc + 5) * 65 + oc]);
    w[3] = cvtpk(l[(kc + 6) * 65 + oc], l[(kc + 7) * 65 + oc]);
    *(u32x4*)(c.dst + (size_t)j * 1024 + c.k0 + kc) = w;
    __syncthreads();
    if (tn >= tend) break;
    t = tn; c = cn;
  }
}
DEV void cvt_win_layer(const Params& p, int layer) { cvt_range(p, layer, 0, 2176); }

DEV void phase0(const Params& p) {
  const int tid = ltid();
  cvt_range(p, 0, 0, 3200);
  float* mod = (float*)(p.ws + OFF_MOD);
  if (blockIdx.x < 192) {
    float* cact = (float*)smem; float* l4 = (float*)(smem + 16384);
    for (int i = tid; i < 4096; i += 512) cact[i] = siluf(p.c[i]);
    __syncthreads();
    for (int it = blockIdx.x; it < 192; it += gridDim.x) {
      const int l = it / 96, j0 = (it % 96) * 32, w = tid >> 6, lane = tid & 63, cl = lane & 31, kh = w * 2 + (lane >> 5);
      const float* wa = p.w_ada + (size_t)l * 1024 * 3072 + j0 + cl;
      float a0 = 0.f, a1 = 0.f, a2 = 0.f, a3 = 0.f;
      for (int k = kh * 64; k < kh * 64 + 64; k += 16) {
        float wv[16];
#pragma unroll
        for (int q = 0; q < 16; ++q) wv[q] = wa[(size_t)(k + q) * 3072];
#pragma unroll
        for (int q = 0; q < 16; ++q) { a0 += cact[k + q] * wv[q]; a1 += cact[1024 + k + q] * wv[q]; a2 += cact[2048 + k + q] * wv[q]; a3 += cact[3072 + k + q] * wv[q]; }
      }
      l4[(kh * 4 + 0) * 32 + cl] = a0; l4[(kh * 4 + 1) * 32 + cl] = a1; l4[(kh * 4 + 2) * 32 + cl] = a2; l4[(kh * 4 + 3) * 32 + cl] = a3;
      __syncthreads();
      if (tid < 128) {
        const int b = tid >> 5, c2 = tid & 31; float s = 0.f;
        for (int q = 0; q < 16; ++q) s += l4[(q * 4 + b) * 32 + c2];
        mod[((size_t)l * 4 + b) * 3072 + j0 + c2] = s + p.b_ada[l * 3072 + j0 + c2];
      }
      __syncthreads();
    }
  }
  f32x2* rope = (f32x2*)(p.ws + OFF_ROPE);
  for (int i = blockIdx.x * 512 + tid; i < T * 8; i += gridDim.x * 512) {
    const int tok = i >> 3, fi = i & 7;
    float inv;
    switch (fi) { case 0: inv = 1.0f; break; case 1: inv = 0.1939227432012558f; break; case 2: inv = 0.03760603070259094f; break; case 3: inv = 0.007292664609849453f; break;
                  case 4: inv = 0.0014142135623842478f; break; case 5: inv = 0.00027424818836152554f; break; case 6: inv = 5.318296098266728e-05f; break; default: inv = 1.0313386155758053e-05f; break; }
    const float angf = (float)p.pos[tok] * inv;
    const double a = (double)angf;
    const double q = rint(a * 0.63661977236758134308);
    double r = fma(-q, 1.57079632679489655800, a); r = fma(-q, 6.12323399573676603587e-17, r);
    const int n = ((int)q) & 3;
    const double r2 = r * r;
    const double sn = r + r * r2 * (-1.0 / 6 + r2 * (1.0 / 120 + r2 * (-1.0 / 5040 + r2 * (1.0 / 362880 - r2 * (1.0 / 39916800)))));
    const double cs = 1.0 + r2 * (-0.5 + r2 * (1.0 / 24 + r2 * (-1.0 / 720 + r2 * (1.0 / 40320 + r2 * (-1.0 / 3628800 + r2 * (1.0 / 479001600))))));
    double co, si;
    if (n == 0) { co = cs; si = sn; } else if (n == 1) { co = -sn; si = cs; } else if (n == 2) { co = -cs; si = -sn; } else { co = sn; si = -cs; }
    rope[i] = (f32x2){(float)co, (float)si};
  }
  if (blockIdx.x == 0 && tid < 2) {
    const float* dl = p.diff_lambda + tid * 256;
    float s1 = 0.f, s2 = 0.f;
    for (int i = 0; i < 64; ++i) { s1 += dl[i] * dl[64 + i]; s2 += dl[128 + i] * dl[192 + i]; }
    const float li = 0.8f - 0.6f * expf(-0.3f * (float)tid);
    ((float*)(p.ws + OFF_LAM))[tid] = expf(s1) - expf(s2) + li;
  }
}

DEV void phase_norm(const Params& p, int layer, const float* __restrict__ xin) {
  const int tid_ = ltid(); const int wid = tid_ >> 6, lane = tid_ & 63;
  const float* mod = (const float*)(p.ws + OFF_MOD) + (size_t)layer * 4 * 3072;
  const float* gain = p.norm_gain + layer * 1024;
  bf16_t* H = (bf16_t*)(p.ws + OFF_H);
  for (int row = blockIdx.x * 8 + wid; row < T; row += gridDim.x * 8) {
    const int b = row >> 12;
    const float* xr = xin + (size_t)row * 1024;
    f32x4 v[4]; float ss = 0.f;
#pragma unroll
    for (int i = 0; i < 4; ++i) { v[i] = *(const f32x4*)(xr + i * 256 + lane * 4); ss += v[i][0] * v[i][0] + v[i][1] * v[i][1] + v[i][2] * v[i][2] + v[i][3] * v[i][3]; }
#pragma unroll
    for (int o = 32; o > 0; o >>= 1) ss += __shfl_xor(ss, o);
    const float rstd = rsqrtf(ss * (1.0f / 1024.0f) + RMS_EPS);
#pragma unroll
    for (int i = 0; i < 4; ++i) {
      const int c = i * 256 + lane * 4;
      const f32x4 g = *(const f32x4*)(gain + c), sh = *(const f32x4*)(mod + b * 3072 + c), sc = *(const f32x4*)(mod + b * 3072 + 1024 + c);
      float h0 = v[i][0] * rstd * g[0] * (1.f + sc[0]) + sh[0], h1 = v[i][1] * rstd * g[1] * (1.f + sc[1]) + sh[1];
      float h2 = v[i][2] * rstd * g[2] * (1.f + sc[2]) + sh[2], h3 = v[i][3] * rstd * g[3] * (1.f + sc[3]) + sh[3];
      u32x2 w; w[0] = cvtpk(h0, h1); w[1] = cvtpk(h2, h3);
      *(u32x2*)(H + (size_t)row * 1024 + c) = w;
    }
  }
}

DEV void phase_final(const Params& p) {
  const int tid_ = ltid(); const int wid = tid_ >> 6, lane = tid_ & 63;
  for (int row = blockIdx.x * 8 + wid; row < T; row += gridDim.x * 8) {
    float* xr = p.out + (size_t)row * 1024;
    f32x4 v[4]; float ss = 0.f;
#pragma unroll
    for (int i = 0; i < 4; ++i) { v[i] = *(const f32x4*)(xr + i * 256 + lane * 4); ss += v[i][0] * v[i][0] + v[i][1] * v[i][1] + v[i][2] * v[i][2] + v[i][3] * v[i][3]; }
#pragma unroll
    for (int o = 32; o > 0; o >>= 1) ss += __shfl_xor(ss, o);
    const float rstd = rsqrtf(ss * (1.0f / 1024.0f) + RMS_EPS);
#pragma unroll
    for (int i = 0; i < 4; ++i) {
      const int c = i * 256 + lane * 4;
      const f32x4 g = *(const f32x4*)(p.final_gain + c);
      f32x4 o; o[0] = v[i][0] * rstd * g[0]; o[1] = v[i][1] * rstd * g[1]; o[2] = v[i][2] * rstd * g[2]; o[3] = v[i][3] * rstd * g[3];
      *(f32x4*)(xr + c) = o;
    }
  }
}

constexpr int HALF = 128, BK = 64, HT = HALF * BK;
DEV int lds_byte(int r, int c) { const int st = (r >> 4) * 2 + (c >> 5), rr = r & 15, cc = c & 31, ob = rr * 64 + cc * 2; return st * 1024 + (ob ^ (((ob >> 9) & 1) << 5)); }
DEV void stage_rc(int b, int& R, int& C) { const int st = b / 1024, sb = b % 1024, swz = sb ^ (((sb >> 9) & 1) << 5); R = (st >> 1) * 16 + swz / 64; C = (st & 1) * 32 + (swz % 64) / 2; }

DEV bool gemm_next(int i, int nM, int nN, int& pm, int& pn) {
  const int nwg = nM * nN; const long L = (long)i * gridDim.x + blockIdx.x; if (L >= nwg) return false;
  int wgid = (int)L; { const int q = nwg / 8, r = nwg % 8, xcd = wgid % 8, off = wgid / 8; wgid = (xcd < r ? xcd * (q + 1) : r * (q + 1) + (xcd - r) * q) + off; }
  const int nig = 8 * nN, gid = wgid / nig, fm = gid * 8, gsz = (nM - fm) < 8 ? (nM - fm) : 8;
  pm = fm + ((wgid % nig) % gsz); pn = (wgid % nig) / gsz; return true;
}

struct GUnit { const char* a; const char* b; int nt, pm, pn, s; };
typedef __attribute__((address_space(3))) unsigned char LDSC;
template <class Next, class Epi>
DEV void gemm_stream(Next&& next, Epi&& epi) {
  LDSC* lds = (LDSC*)smem;
  const int tid = ltid(), wid = __builtin_amdgcn_readfirstlane(tid >> 6), lane = tid & 63, wr = wid >> 2, wc = wid & 3, fr = lane & 15, fq = lane >> 4;
  unsigned voff[2];
#pragma unroll
  for (int i = 0; i < 2; ++i) { int R, C; stage_rc(tid * 16 + i * 8192, R, C); voff[i] = (unsigned)(R * 1024 + C) * 2u; }
  constexpr size_t kstep = 128, hstep = (size_t)128 * 1024 * 2;
  constexpr int HTB = 128 * 64 * 2;
  const unsigned ldsw = (unsigned)wid * 1024u;
  const int aoff = lds_byte(wr * 64 + fr, fq * 8), boff = lds_byte(wc * 32 + fr, fq * 8);
#define G_SA(b, h) (((b) * 2 + (h)) * HTB)
#define G_SB(b, h) ((4 + (b) * 2 + (h)) * HTB)
#define G_STAGE(bufoff, gbase) do { _Pragma("unroll") for (int _i = 0; _i < 2; ++_i) \
    __builtin_amdgcn_global_load_lds((const unsigned*)((const char*)(gbase) + voff[_i]), (__attribute__((address_space(3))) unsigned*)(lds + (bufoff) + ldsw + _i * 8192), 16, 0, 0); } while (0)
#define G_LDA(dst, b, h) do { _Pragma("unroll") for (int m = 0; m < 4; ++m) _Pragma("unroll") for (int k = 0; k < 2; ++k) dst[m][k] = *(const __attribute__((address_space(3))) bf16x8*)(lds + G_SA(b, h) + aoff + m * 2048 + k * 1024); } while (0)
#define G_LDB(dst, b, h) do { _Pragma("unroll") for (int n = 0; n < 2; ++n) _Pragma("unroll") for (int k = 0; k < 2; ++k) dst[n][k] = *(const __attribute__((address_space(3))) bf16x8*)(lds + G_SB(b, h) + boff + n * 2048 + k * 1024); } while (0)
#define G_MMA(ai, bj, At, Bf) do { __builtin_amdgcn_s_setprio(1); _Pragma("unroll") for (int m = 0; m < 4; ++m) _Pragma("unroll") for (int n = 0; n < 2; ++n) _Pragma("unroll") for (int k = 0; k < 2; ++k) \
    acc[ai][bj][m][n] = __builtin_amdgcn_mfma_f32_16x16x32_bf16(Bf[n][k], At[m][k], acc[ai][bj][m][n], 0, 0, 0); __builtin_amdgcn_s_setprio(0); } while (0)
#define G_WAIT_V(n) asm volatile("s_waitcnt vmcnt(" #n ")" ::: "memory")
#define G_WAIT_L(n) asm volatile("s_waitcnt lgkmcnt(" #n ")" ::: "memory")
#define G_BAR __builtin_amdgcn_s_barrier()
#define G_SCHED __builtin_amdgcn_sched_barrier(0)
  GUnit cur, nxt; int ui = 0;
  if (!next(0, cur)) return;
  f32x4 acc[2][2][4][2];
#pragma unroll
  for (int a = 0; a < 2; ++a)
#pragma unroll
    for (int b = 0; b < 2; ++b)
#pragma unroll
      for (int m = 0; m < 4; ++m)
#pragma unroll
        for (int n = 0; n < 2; ++n) acc[a][b][m][n] = (f32x4){0.f, 0.f, 0.f, 0.f};
  bf16x8 At[4][2], B0[2][2], B1[2][2];
  const char* cA = cur.a; const char* cB = cur.b;
  G_STAGE(G_SB(0, 0), cB); G_STAGE(G_SA(0, 0), cA); G_STAGE(G_SB(0, 1), cB + hstep); G_STAGE(G_SA(0, 1), cA + hstep);
  if (wr == 1) G_BAR;
  G_WAIT_V(4); G_BAR;
  G_STAGE(G_SB(1, 0), cB + kstep); G_STAGE(G_SA(1, 0), cA + kstep); G_STAGE(G_SB(1, 1), cB + hstep + kstep);
  G_WAIT_V(6); G_BAR;
  for (;;) {
    const bool has_next = next(ui + 1, nxt);
    const char* nA = has_next ? nxt.a : cA; const char* nB = has_next ? nxt.b : cB;
    const int nt = cur.nt;
    for (int t = 0; t < nt; t += 2) {
      const bool last = (t == nt - 2);
      const char* a1 = cA + (size_t)(t + 1) * kstep;
      const char* a2 = last ? nA : cA + (size_t)(t + 2) * kstep; const char* b2 = last ? nB : cB + (size_t)(t + 2) * kstep;
      const char* a3 = a2 + kstep; const char* b3 = b2 + kstep;
      G_LDB(B0, 0, 0); G_SCHED; G_LDA(At, 0, 0); G_STAGE(G_SA(1, 1), a1 + hstep);
      G_WAIT_L(8); G_BAR; G_WAIT_L(0); G_MMA(0, 0, At, B0); G_BAR; G_SCHED;
      G_LDB(B1, 0, 1); G_STAGE(G_SB(0, 0), b2);
      G_BAR; G_WAIT_L(0); G_MMA(0, 1, At, B1); G_BAR;
      G_LDA(At, 0, 1); G_STAGE(G_SA(0, 0), a2);
      G_BAR; G_WAIT_L(0); G_MMA(1, 0, At, B0); G_BAR; G_SCHED;
      G_STAGE(G_SB(0, 1), b2 + hstep);
      G_WAIT_V(6); G_BAR; G_MMA(1, 1, At, B1); G_BAR;
      G_LDB(B0, 1, 0); G_SCHED; G_LDA(At, 1, 0); G_STAGE(G_SA(0, 1), a2 + hstep);
      G_WAIT_L(8); G_BAR; G_WAIT_L(0); G_MMA(0, 0, At, B0); G_BAR; G_SCHED;
      G_LDB(B1, 1, 1); G_STAGE(G_SB(1, 0), b3);
      G_BAR; G_WAIT_L(0); G_MMA(0, 1, At, B1); G_BAR;
      G_LDA(At, 1, 1); G_STAGE(G_SA(1, 0), a3);
      G_BAR; G_WAIT_L(0); G_MMA(1, 0, At, B0); G_BAR; G_SCHED;
      G_STAGE(G_SB(1, 1), b3 + hstep);
      G_WAIT_V(6); G_BAR; G_MMA(1, 1, At, B1); G_BAR;
    }
    epi(acc, cur, wr, wc, fr, fq);
    if (!has_next) break;
#pragma unroll
    for (int a = 0; a < 2; ++a)
#pragma unroll
      for (int b = 0; b < 2; ++b)
#pragma unroll
        for (int m = 0; m < 4; ++m)
#pragma unroll
          for (int n = 0; n < 2; ++n) acc[a][b][m][n] = (f32x4){0.f, 0.f, 0.f, 0.f};
    cur = nxt; cA = nA; cB = nB; ++ui;
  }
  G_WAIT_V(0);
  if (wr == 0) G_BAR;
  G_BAR;
#undef G_SA
#undef G_SB
#undef G_STAGE
#undef G_LDA
#undef G_LDB
#undef G_MMA
}

DEV void phase_inproj(const Params& p) {
  const char* H = p.ws + OFF_H;
  const char* W = p.ws + OFF_WIN;
  const f32x4* rope = (const f32x4*)(p.ws + OFF_ROPE);
  char* ws = p.ws;
  __syncthreads();
  gemm_stream([&](int i, GUnit& u) -> bool {
      int pm, pn; if (!gemm_next(i, 64, 22, pm, pn)) return false;
      u.a = H + (size_t)pm * 256 * 2048; u.b = W + (size_t)pn * 256 * 2048; u.nt = 16; u.pm = pm; u.pn = pn; u.s = 0; return true; },
    [&](f32x4 (&acc)[2][2][4][2], const GUnit& u, int wr, int wc, int fr, int fq) {
      const int c0 = u.pn * 256;
      size_t base; int ld, lc; bool rp;
      if (c0 < 1024) { base = OFF_AQK; ld = 1024; lc = c0; rp = true; }
      else if (c0 < 1536) { base = OFF_AV; ld = 512; lc = c0 - 1024; rp = false; }
      else if (c0 < 2304) { base = OFF_BK; ld = 768; lc = c0 - 1536; rp = true; }
      else if (c0 < 3072) { base = OFF_BV; ld = 768; lc = c0 - 2304; rp = false; }
      else if (c0 < 3840) { base = OFF_C; ld = 768; lc = c0 - 3072; rp = false; }
      else if (c0 < 4608) { base = OFF_BQ; ld = 768; lc = c0 - 3840; rp = true; }
      else { base = OFF_Z; ld = 1024; lc = c0 - 4608; rp = false; }
      bf16_t* dst = (bf16_t*)(ws + base);
      const bool dorope = rp && ((wc & 1) == 0) && (fq < 2);
#pragma unroll
      for (int ai = 0; ai < 2; ++ai)
#pragma unroll
        for (int m = 0; m < 4; ++m) {
          const int row = u.pm * 256 + ai * 128 + wr * 64 + m * 16 + fr;
          f32x4 cs0 = {1.f, 0.f, 1.f, 0.f}, cs1 = {1.f, 0.f, 1.f, 0.f};
          if (dorope) { cs0 = rope[(size_t)row * 4 + fq * 2]; cs1 = rope[(size_t)row * 4 + fq * 2 + 1]; }
#pragma unroll
          for (int bj = 0; bj < 2; ++bj) {
            f32x4 v0 = acc[ai][bj][m][0], v1 = acc[ai][bj][m][1];
            if (dorope) {
              f32x4 a, b;
              a[0] = v0[0] * cs0[0] - v0[1] * cs0[1]; a[1] = v0[1] * cs0[0] + v0[0] * cs0[1];
              a[2] = v0[2] * cs0[2] - v0[3] * cs0[3]; a[3] = v0[3] * cs0[2] + v0[2] * cs0[3];
              b[0] = v1[0] * cs1[0] - v1[1] * cs1[1]; b[1] = v1[1] * cs1[0] + v1[0] * cs1[1];
              b[2] = v1[2] * cs1[2] - v1[3] * cs1[3]; b[3] = v1[3] * cs1[2] + v1[2] * cs1[3];
              v0 = a; v1 = b;
            }
            u32x4 w; w[0] = cvtpk(v0[0], v0[1]); w[1] = cvtpk(v0[2], v0[3]); w[2] = cvtpk(v1[0], v1[1]); w[3] = cvtpk(v1[2], v1[3]);
            *(u32x4*)(dst + (size_t)row * ld + lc + bj * 128 + wc * 32 + fq * 8) = w;
          }
        }
    });
}

DEV void phase_gates(const Params& p) {
  {
    const bf16_t* OB = (const bf16_t*)(p.ws + OFF_BQ);
    const float* LSE = (const float*)(p.ws + OFF_LSE);
    const bf16_t* Z = (const bf16_t*)(p.ws + OFF_Z);
    bf16_t* Y = (bf16_t*)(p.ws + OFF_Y);
    for (int i = blockIdx.x * 512 + ltid(); i < T * 32; i += gridDim.x * 512) {
      const int tok = i >> 5, hs = (i >> 3) & 3, dc = (i & 7) * 8;
      const float l0 = LSE[((size_t)0 * T + tok) * 4 + hs], l1 = LSE[((size_t)1 * T + tok) * 4 + hs], l2 = LSE[((size_t)2 * T + tok) * 4 + hs];
      const float mx = fmaxf(l0, fmaxf(l1, l2));
      float e0 = __expf(l0 - mx), e1 = __expf(l1 - mx), e2 = __expf(l2 - mx);
      const float inv = 1.0f / (e0 + e1 + e2); e0 *= inv; e1 *= inv; e2 *= inv;
      const u32x4 a = *(const u32x4*)(OB + (size_t)tok * 768 + 0 * 256 + hs * 64 + dc);
      const u32x4 b = *(const u32x4*)(OB + (size_t)tok * 768 + 1 * 256 + hs * 64 + dc);
      const u32x4 c = *(const u32x4*)(OB + (size_t)tok * 768 + 2 * 256 + hs * 64 + dc);
      const u32x4 z = *(const u32x4*)(Z + (size_t)tok * 1024 + 512 + hs * 64 + dc);
      u32x4 w;
#pragma unroll
      for (int k = 0; k < 4; ++k) {
        const float lo = (e0 * bflo(a[k]) + e1 * bflo(b[k]) + e2 * bflo(c[k])) * siluf(bflo(z[k]));
        const float hi = (e0 * bfhi(a[k]) + e1 * bfhi(b[k]) + e2 * bfhi(c[k])) * siluf(bfhi(z[k]));
        w[k] = cvtpk(lo, hi);
      }
      *(u32x4*)(Y + (size_t)tok * 1024 + 512 + hs * 64 + dc) = w;
    }
  }
  const char* H = p.ws + OFF_H;
  const char* W = p.ws + OFF_WIN + (size_t)5632 * 2048;
  bf16_t* G = (bf16_t*)(p.ws + OFF_G);
  __syncthreads();
  gemm_stream([&](int i, GUnit& u) -> bool {
      int pm, pn; if (!gemm_next(i, 64, 12, pm, pn)) return false;
      u.a = H + (size_t)pm * 256 * 2048; u.b = W + (size_t)pn * 256 * 2048; u.nt = 16; u.pm = pm; u.pn = pn; u.s = 0; return true; },
    [&](f32x4 (&acc)[2][2][4][2], const GUnit& u, int wr, int wc, int fr, int fq) {
#pragma unroll
      for (int ai = 0; ai < 2; ++ai)
#pragma unroll
        for (int m = 0; m < 4; ++m) {
          const int row = u.pm * 256 + ai * 128 + wr * 64 + m * 16 + fr;
#pragma unroll
          for (int bj = 0; bj < 2; ++bj) {
            const f32x4 v0 = acc[ai][bj][m][0], v1 = acc[ai][bj][m][1];
            u32x4 w; w[0] = cvtpk(sigmoidf(v0[0]), sigmoidf(v0[1])); w[1] = cvtpk(sigmoidf(v0[2]), sigmoidf(v0[3]));
            w[2] = cvtpk(sigmoidf(v1[0]), sigmoidf(v1[1])); w[3] = cvtpk(sigmoidf(v1[2]), sigmoidf(v1[3]));
            *(u32x4*)(G + (size_t)row * 3072 + u.pn * 256 + bj * 128 + wc * 32 + fq * 8) = w;
          }
        }
    });
}

DEV void phase_merge(const Params& p, int layer) {
  const char* Y = p.ws + OFF_Y;
  const char* W = p.ws + OFF_WBR + (size_t)layer * 1024 * 2048;
  const bf16_t* G = (const bf16_t*)(p.ws + OFF_G);
  bf16_t* M = (bf16_t*)(p.ws + OFF_H);
  __syncthreads();
  gemm_stream([&](int i, GUnit& u) -> bool {
      const int uu = i / 3, s = i - uu * 3;
      int pm, pn; if (!gemm_next(uu, 64, 4, pm, pn)) return false;
      const int koff = (s == 0) ? 0 : (s == 1 ? 512 : 768);
      u.a = Y + (size_t)pm * 256 * 2048 + koff * 2; u.b = W + (size_t)pn * 256 * 2048 + koff * 2; u.nt = (s == 0) ? 8 : 4; u.pm = pm; u.pn = pn; u.s = s; return true; },
    [&](f32x4 (&acc)[2][2][4][2], const GUnit& u, int wr, int wc, int fr, int fq) {
      const int s = u.s;
#pragma unroll
      for (int ai = 0; ai < 2; ++ai)
#pragma unroll
        for (int m = 0; m < 4; ++m) {
          const int row = u.pm * 256 + ai * 128 + wr * 64 + m * 16 + fr;
#pragma unroll
          for (int bj = 0; bj < 2; ++bj) {
            const int col = u.pn * 256 + bj * 128 + wc * 32 + fq * 8;
            const u32x4 g = *(const u32x4*)(G + (size_t)row * 3072 + s * 1024 + col);
            u32x4 old = {0u, 0u, 0u, 0u};
            if (s > 0) old = *(const u32x4*)(M + (size_t)row * 1024 + col);
            const f32x4 v0 = acc[ai][bj][m][0], v1 = acc[ai][bj][m][1];
            u32x4 w;
            w[0] = cvtpk(bflo(old[0]) + bflo(g[0]) * v0[0], bfhi(old[0]) + bfhi(g[0]) * v0[1]);
            w[1] = cvtpk(bflo(old[1]) + bflo(g[1]) * v0[2], bfhi(old[1]) + bfhi(g[1]) * v0[3]);
            w[2] = cvtpk(bflo(old[2]) + bflo(g[2]) * v1[0], bfhi(old[2]) + bfhi(g[2]) * v1[1]);
            w[3] = cvtpk(bflo(old[3]) + bflo(g[3]) * v1[2], bfhi(old[3]) + bfhi(g[3]) * v1[3]);
            *(u32x4*)(M + (size_t)row * 1024 + col) = w;
          }
        }
    });
}

DEV void phase_out(const Params& p, int layer, const float* __restrict__ xin) {
  const char* M = p.ws + OFF_H;
  const char* W = p.ws + OFF_WOUT + (size_t)layer * 1024 * 2048;
  const float* mod = (const float*)(p.ws + OFF_MOD) + (size_t)layer * 4 * 3072 + 2048;
  float* out = p.out;
  __syncthreads();
  gemm_stream([&](int i, GUnit& u) -> bool {
      int pm, pn; if (!gemm_next(i, 64, 4, pm, pn)) return false;
      u.a = M + (size_t)pm * 256 * 2048; u.b = W + (size_t)pn * 256 * 2048; u.nt = 16; u.pm = pm; u.pn = pn; u.s = 0; return true; },
    [&](f32x4 (&acc)[2][2][4][2], const GUnit& u, int wr, int wc, int fr, int fq) {
      const int b = u.pm >> 4;
#pragma unroll
      for (int bj = 0; bj < 2; ++bj) {
        const int col = u.pn * 256 + bj * 128 + wc * 32 + fq * 8;
        const f32x4 g0 = *(const f32x4*)(mod + b * 3072 + col), g1 = *(const f32x4*)(mod + b * 3072 + col + 4);
#pragma unroll
        for (int ai = 0; ai < 2; ++ai)
#pragma unroll
          for (int m = 0; m < 4; ++m) {
            const int row = u.pm * 256 + ai * 128 + wr * 64 + m * 16 + fr;
            const f32x4 x0 = *(const f32x4*)(xin + (size_t)row * 1024 + col), x1 = *(const f32x4*)(xin + (size_t)row * 1024 + col + 4);
            *(f32x4*)(out + (size_t)row * 1024 + col) = x0 + g0 * acc[ai][bj][m][0];
            *(f32x4*)(out + (size_t)row * 1024 + col + 4) = x1 + g1 * acc[ai][bj][m][1];
          }
      }
    });
  __syncthreads();
  if (layer == 0) cvt_win_layer(p, 1);
}

#define KSWZ_A(row, colB) ((row) * 256 + ((colB) ^ (((row) & 7) << 4)))
#define KSWZ_S(row, colB) ((row) * 128 + ((colB) ^ ((((row) >> 1) & 7) << 4)))
template <int DV> DEV int v_st(int k, int c) { const int kk = (k & ~0xC) | ((k & 4) << 1) | ((k & 8) >> 1); return ((kk >> 3) * (DV / 32) + (c >> 5)) * 512 + ((kk & 7) * 32 + (c & 31)) * 2; }
DEV int v_rd_base(int lane) { return ((lane & 3) << 3) | (((lane >> 2) & 3) << 6) | (((lane >> 4) & 1) << 5) | (((lane >> 5) & 1) << 8); }
template <int OFF> DEV s16x4 tr_read(int vb) { s16x4 r; asm volatile("ds_read_b64_tr_b16 %0, %1 offset:%2" : "=&v"(r) : "v"(vb), "i"(OFF) : "memory"); return r; }
template <int DV, int D0> DEV void pv_one(f32x16& od, int vb, bf16x8 pa0, bf16x8 pa1, bf16x8 pa2, bf16x8 pa3) {
  constexpr int KS = (DV / 32) * 1024, HF = (DV / 32) * 512;
  const s16x4 l0 = tr_read<D0 * 512 + 0 * KS>(vb), h0 = tr_read<D0 * 512 + 0 * KS + HF>(vb), l1 = tr_read<D0 * 512 + 1 * KS>(vb), h1 = tr_read<D0 * 512 + 1 * KS + HF>(vb);
  const s16x4 l2 = tr_read<D0 * 512 + 2 * KS>(vb), h2 = tr_read<D0 * 512 + 2 * KS + HF>(vb), l3 = tr_read<D0 * 512 + 3 * KS>(vb), h3 = tr_read<D0 * 512 + 3 * KS + HF>(vb);
  asm volatile("s_waitcnt lgkmcnt(0)" ::: "memory"); __builtin_amdgcn_sched_barrier(0);
#define PK(L, H) (bf16x8){L[0], L[1], L[2], L[3], H[0], H[1], H[2], H[3]}
  od = __builtin_amdgcn_mfma_f32_32x32x16_bf16(pa0, PK(l0, h0), od, 0, 0, 0);
  od = __builtin_amdgcn_mfma_f32_32x32x16_bf16(pa1, PK(l1, h1), od, 0, 0, 0);
  od = __builtin_amdgcn_mfma_f32_32x32x16_bf16(pa2, PK(l2, h2), od, 0, 0, 0);
  od = __builtin_amdgcn_mfma_f32_32x32x16_bf16(pa3, PK(l3, h3), od, 0, 0, 0);
#undef PK
}

template <int MODE>
DEV void attn_unit(const Params& p, int layer, int u) {
  constexpr int DV = (MODE == 0) ? 128 : 64, ND = DV / 32;
  constexpr int TB = (MODE == 0) ? 16384 : 8192;
  constexpr float C = SCALE * 1.4426950408889634f;
  constexpr float THRRAW = 8.0f / SCALE;
  const int tid = ltid(), wid = tid >> 6, lane = tid & 63, r32 = lane & 31, hi = lane >> 5;
  char* V_lds = smem; char* K_lds = smem + 2 * TB;
  float* wsc = (float*)(smem + 131072) + wid * 64; float* li_l = wsc; float* al_l = wsc + 32;
  float* rpb_l = (float*)(smem + 131072 + 2048);

  int b = 0, h = 0, NT = 0, tfirst = 0;
  int g = 0, rr = 1, mres = 0, blk = 0, Lsub = 0;
  int r0 = 0, row_lo = 0, qrow = 0, qcol = 0, rs = 0, cs = 0;
  const bf16_t *Qp, *Kb, *Vb; int ldkv;
  int qtok;
  int coff = 0;
  if (MODE == 0) {
    const int pair = ((u & 7) << 1) | (u >> 8), qb = (u >> 3) & 31; b = pair >> 2; h = pair & 3;
    const int g4 = wid >> 1, cm = wid & 1; coff = cm * 64;
    qtok = b * SEQ + qb * 128 + g4 * 32 + r32;
    Qp = (const bf16_t*)(p.ws + OFF_AQK) + (size_t)qtok * 1024 + h * 128 + cm * 64;
    Kb = (const bf16_t*)(p.ws + OFF_AQK) + 512 + h * 128; Vb = (const bf16_t*)(p.ws + OFF_AV) + h * 128; ldkv = 0;
    NT = 64; tfirst = 0;
  } else if (MODE == 1) {
    b = u / 192; int rem = u % 192; h = rem / 48; rem %= 48; g = rem / 16; const int uu = rem % 16;
    rr = (g == 0) ? 1 : (g == 1 ? 4 : 16); Lsub = SEQ / rr; mres = uu % rr; blk = uu / rr;
    const int qn = blk * 256 + wid * 32 + r32;
    qtok = b * SEQ + qn * rr + mres;
    Qp = (const bf16_t*)(p.ws + OFF_BQ) + (size_t)qtok * 768 + g * 256 + h * 64;
    Kb = (const bf16_t*)(p.ws + OFF_BK) + g * 256 + h * 64; Vb = (const bf16_t*)(p.ws + OFF_BV) + g * 256 + h * 64; ldkv = 768;
    tfirst = (blk == 0) ? 1 : 0; int tl = (Lsub - (blk * 256 - 64)) / 64 - 1; if (tl > 5) tl = 5; NT = tl + 1;
  } else {
    b = u >> 6; h = (u >> 4) & 3; r0 = (u & 15) * 4;
    qrow = r0 + (wid >> 1); qcol = (wid & 1) * 32 + r32;
    qtok = b * SEQ + qrow * 64 + qcol;
    Qp = (const bf16_t*)(p.ws + OFF_C) + (size_t)qtok * 768 + h * 64;
    Kb = (const bf16_t*)(p.ws + OFF_C) + 256 + h * 64; Vb = (const bf16_t*)(p.ws + OFF_C) + 512 + h * 64; ldkv = 768;
    row_lo = r0 - 4; if (row_lo < 0) row_lo = 0; if (row_lo > 56) row_lo = 56;
    int rl3 = r0 + 3 - 4; if (rl3 < 0) rl3 = 0; if (rl3 > 56) rl3 = 56;
    NT = rl3 + 8 - row_lo; tfirst = 0;
    rs = qrow - 4; if (rs < 0) rs = 0; if (rs > 56) rs = 56;
    cs = qcol - 8; if (cs < 0) cs = 0; if (cs > 48) cs = 48;
    const float* rp = p.rpb + ((size_t)layer * 4 + h) * 465;
    if (tid < 465) rpb_l[tid] = rp[tid] * (1.0f / SCALE);
  }
  (void)ldkv;

  bf16x8 qr[4];
#pragma unroll
  for (int d0 = 0; d0 < 4; ++d0) qr[d0] = *(const bf16x8*)(Qp + d0 * 16 + hi * 8);

  bf16x8 st0, st1, st2, st3;
  auto key_tok = [&](int t, int i) -> int {
    if (MODE == 0) return b * SEQ + t * 64 + i;
    if (MODE == 1) return b * SEQ + (blk * 256 - 64 + 64 * t + i) * rr + mres;
    return b * SEQ + (row_lo + t) * 64 + i;
  };
  auto sload = [&](int t) {
    if (MODE == 0) {
      const int sr = tid >> 4, sc = (tid & 15) * 8;
      const size_t k0 = (size_t)key_tok(t, sr), k1 = (size_t)key_tok(t, 32 + sr);
      st0 = *(const bf16x8*)(Vb + k0 * 512 + sc); st1 = *(const bf16x8*)(Vb + k1 * 512 + sc);
      st2 = *(const bf16x8*)(Kb + k0 * 1024 + sc); st3 = *(const bf16x8*)(Kb + k1 * 1024 + sc);
    } else {
      const int sr = tid >> 3, sc = (tid & 7) * 8;
      const size_t k0 = (size_t)key_tok(t, sr);
      st0 = *(const bf16x8*)(Vb + k0 * 768 + sc); st2 = *(const bf16x8*)(Kb + k0 * 768 + sc);
    }
  };
  auto swrite = [&](int buf) {
    if (MODE == 0) {
      const int sr = tid >> 4, sc = (tid & 15) * 8;
      *(bf16x8*)(V_lds + buf * TB + v_st<128>(sr, sc)) = st0; *(bf16x8*)(V_lds + buf * TB + v_st<128>(32 + sr, sc)) = st1;
      *(bf16x8*)(K_lds + buf * TB + KSWZ_A(sr, sc * 2)) = st2; *(bf16x8*)(K_lds + buf * TB + KSWZ_A(32 + sr, sc * 2)) = st3;
    } else {
      const int sr = tid >> 3, sc = (tid & 7) * 8;
      *(bf16x8*)(V_lds + buf * TB + v_st<64>(sr, sc)) = st0;
      *(bf16x8*)(K_lds + buf * TB + KSWZ_S(sr, sc * 2)) = st2;
    }
  };

  float m_reg = -1e30f, l_reg = 0.f;
  f32x16 o[ND];
#pragma unroll
  for (int d = 0; d < ND; ++d) o[d] = f32x16{};
  const int vb0 = (int)(uintptr_t)V_lds + v_rd_base(lane);

  sload(tfirst); swrite(0);
  __syncthreads();
  for (int t = tfirst, it = 0; t < NT; ++t, ++it) {
    const int buf = it & 1;
    const bool more = (t + 1 < NT);
    if (more) sload(t + 1);
    bool active = true;
    if (MODE == 1) { const int tn0 = blk * 256 - 64 + 64 * t, qa = blk * 256 + wid * 32; active = (tn0 + 63 >= qa - 64) && (tn0 <= qa + 31 + 64); }
    if (MODE == 2) { const int kr = row_lo + t; active = (kr >= rs) && (kr < rs + 8); }
    if (active) {
      f32x16 p0 = f32x16{}, p1 = f32x16{};
      const char* Kt = K_lds + buf * TB;
#pragma unroll
      for (int d0 = 0; d0 < 4; ++d0) {
        const int cb = (coff + d0 * 16 + hi * 8) * 2;
        bf16x8 b0, b1;
        if (MODE == 0) { b0 = *(const bf16x8*)(Kt + KSWZ_A(r32, cb)); b1 = *(const bf16x8*)(Kt + KSWZ_A(32 + r32, cb)); }
        else { b0 = *(const bf16x8*)(Kt + KSWZ_S(r32, cb)); b1 = *(const bf16x8*)(Kt + KSWZ_S(32 + r32, cb)); }
        p0 = __builtin_amdgcn_mfma_f32_32x32x16_bf16(b0, qr[d0], p0, 0, 0, 0);
        p1 = __builtin_amdgcn_mfma_f32_32x32x16_bf16(b1, qr[d0], p1, 0, 0, 0);
      }
      if (MODE == 1) {
        const int tn0 = blk * 256 - 64 + 64 * t, qn = blk * 256 + wid * 32 + r32;
#pragma unroll
        for (int r = 0; r < 16; ++r) {
          const int d0k = tn0 + crow(r, hi) - qn, d1k = d0k + 32;
          if (d0k > 64 || d0k < -64) p0[r] = -INFINITY;
          if (d1k > 64 || d1k < -64) p1[r] = -INFINITY;
        }
      }
      if (MODE == 2) {
        const int kr = row_lo + t; const int rb = (kr - qrow + 7) * 31;
#pragma unroll
        for (int r = 0; r < 16; ++r) {
          const int kc0 = crow(r, hi), kc1 = kc0 + 32;
          int dc0 = kc0 - qcol + 15, dc1 = kc1 - qcol + 15;
          dc0 = dc0 < 0 ? 0 : (dc0 > 30 ? 30 : dc0); dc1 = dc1 < 0 ? 0 : (dc1 > 30 ? 30 : dc1);
          const float b0 = rpb_l[rb + dc0], b1 = rpb_l[rb + dc1];
          p0[r] = (kc0 >= cs && kc0 < cs + 16) ? p0[r] + b0 : -INFINITY;
          p1[r] = (kc1 >= cs && kc1 < cs + 16) ? p1[r] + b1 : -INFINITY;
        }
      }
      float pmax = p0[0];
#pragma unroll
      for (int r = 1; r < 16; ++r) pmax = fmaxf(pmax, p0[r]);
#pragma unroll
      for (int r = 0; r < 16; ++r) pmax = fmaxf(pmax, p1[r]);
      { auto sw = __builtin_amdgcn_permlane32_swap(__float_as_uint(pmax), __float_as_uint(pmax), false, false);
        pmax = fmaxf(__uint_as_float(sw[0]), __uint_as_float(sw[1])); }
      float mn, alpha;
      if (__all(pmax - m_reg <= THRRAW)) { mn = m_reg; alpha = 1.f; }
      else { mn = fmaxf(m_reg, pmax); alpha = __builtin_amdgcn_exp2f((m_reg - mn) * C); m_reg = mn; }
      const float mnC = -mn * C;
      float ps = 0.f;
#pragma unroll
      for (int r = 0; r < 16; ++r) { p0[r] = __builtin_amdgcn_exp2f(fmaf(p0[r], C, mnC)); ps += p0[r]; }
#pragma unroll
      for (int r = 0; r < 16; ++r) { p1[r] = __builtin_amdgcn_exp2f(fmaf(p1[r], C, mnC)); ps += p1[r]; }
      { auto sw = __builtin_amdgcn_permlane32_swap(__float_as_uint(ps), __float_as_uint(ps), false, false);
        ps = __uint_as_float(sw[0]) + __uint_as_float(sw[1]); }
      l_reg = l_reg * alpha + ps;
      bf16x8 pa0, pa1, pa2, pa3;
#define PK4(P, BASE, OUT) do { unsigned a0 = cvtpk(P[BASE + 0], P[BASE + 1]), a1 = cvtpk(P[BASE + 2], P[BASE + 3]); \
    unsigned b0_ = cvtpk(P[BASE + 4], P[BASE + 5]), b1_ = cvtpk(P[BASE + 6], P[BASE + 7]); \
    auto r0_ = __builtin_amdgcn_permlane32_swap(a0, b0_, false, false); auto r1_ = __builtin_amdgcn_permlane32_swap(a1, b1_, false, false); \
    u32x4 w_ = {r0_[0], r1_[0], r0_[1], r1_[1]}; OUT = *reinterpret_cast<bf16x8*>(&w_); } while (0)
      PK4(p0, 0, pa0); PK4(p0, 8, pa1); PK4(p1, 0, pa2); PK4(p1, 8, pa3);
#undef PK4
      if (__any(alpha < 1.f)) {
        if (hi == 0) al_l[r32] = alpha;
        asm volatile("s_waitcnt lgkmcnt(0)" ::: "memory");
        float af[16];
#pragma unroll
        for (int r = 0; r < 16; ++r) af[r] = al_l[crow(r, hi)];
#pragma unroll
        for (int d = 0; d < ND; ++d)
#pragma unroll
          for (int r = 0; r < 16; ++r) o[d][r] *= af[r];
      }
      const int vb = vb0 + buf * TB;
      pv_one<DV, 0>(o[0], vb, pa0, pa1, pa2, pa3);
      pv_one<DV, 1>(o[1], vb, pa0, pa1, pa2, pa3);
      if (DV == 128) { pv_one<DV, 2>(o[ND - 2], vb, pa0, pa1, pa2, pa3); pv_one<DV, 3>(o[ND - 1], vb, pa0, pa1, pa2, pa3); }
    }
    if (more) swrite(buf ^ 1);
    __syncthreads();
  }

  if (hi == 0) li_l[r32] = l_reg;
  asm volatile("s_waitcnt lgkmcnt(0)" ::: "memory");
  float rli[16];
#pragma unroll
  for (int r = 0; r < 16; ++r) rli[r] = 1.0f / li_l[crow(r, hi)];
  const int qtok0 = __shfl(qtok, 0);
  if (MODE == 0) {
    const int g4 = wid >> 1, cm = wid & 1;
    float* X = (float*)smem + g4 * 4096;
    const float lam = ((const float*)(p.ws + OFF_LAM))[layer];
    if (cm == 1) {
#pragma unroll
      for (int d = 0; d < ND; ++d)
#pragma unroll
        for (int r = 0; r < 16; ++r) X[crow(r, hi) * 128 + d * 32 + r32] = -lam * o[d][r] * rli[r];
    }
    __syncthreads();
    if (cm == 0) {
      float ss[16];
#pragma unroll
      for (int r = 0; r < 16; ++r) ss[r] = 0.f;
#pragma unroll
      for (int d = 0; d < ND; ++d)
#pragma unroll
        for (int r = 0; r < 16; ++r) { const float dv = o[d][r] * rli[r] + X[crow(r, hi) * 128 + d * 32 + r32]; o[d][r] = dv; ss[r] += dv * dv; }
#pragma unroll
      for (int r = 0; r < 16; ++r) {
        float s = ss[r];
        s += __shfl_xor(s, 1); s += __shfl_xor(s, 2); s += __shfl_xor(s, 4); s += __shfl_xor(s, 8); s += __shfl_xor(s, 16);
        const float li = 0.8f - 0.6f * __expf(-0.3f * (float)layer);
        ss[r] = rsqrtf(s * (1.0f / 128.0f) + RMS_EPS) * (1.0f - li);
      }
      const bf16_t* Z = (const bf16_t*)(p.ws + OFF_Z); bf16_t* Y = (bf16_t*)(p.ws + OFF_Y);
#pragma unroll
      for (int d = 0; d < ND; ++d) {
        const float gn = p.subln[layer * 128 + d * 32 + r32];
#pragma unroll
        for (int r = 0; r < 16; ++r) {
          const size_t idx = (size_t)(qtok0 + crow(r, hi)) * 1024 + h * 128 + d * 32 + r32;
          const float y = o[d][r] * ss[r] * gn * siluf(bf2f(Z[idx]));
          Y[idx] = (bf16_t)(cvtpk(y, y) & 0xffffu);
        }
      }
    }
  } else if (MODE == 1) {
    bf16_t* OB = (bf16_t*)(p.ws + OFF_BQ);
    float* LSE = (float*)(p.ws + OFF_LSE);
    const int tokw = b * SEQ + (blk * 256 + wid * 32) * rr + mres;
#pragma unroll
    for (int d = 0; d < ND; ++d)
#pragma unroll
      for (int r = 0; r < 16; ++r) {
        const size_t idx = (size_t)(tokw + crow(r, hi) * rr) * 768 + g * 256 + h * 64 + d * 32 + r32;
        const float y = o[d][r] * rli[r];
        OB[idx] = (bf16_t)(cvtpk(y, y) & 0xffffu);
      }
    if (hi == 0) LSE[((size_t)g * T + qtok) * 4 + h] = m_reg * SCALE + __logf(l_reg);
  } else {
    const bf16_t* Z = (const bf16_t*)(p.ws + OFF_Z); bf16_t* Y = (bf16_t*)(p.ws + OFF_Y);
#pragma unroll
    for (int d = 0; d < ND; ++d)
#pragma unroll
      for (int r = 0; r < 16; ++r) {
        const size_t idx = (size_t)(qtok0 + crow(r, hi)) * 1024 + 768 + h * 64 + d * 32 + r32;
        const float y = o[d][r] * rli[r] * siluf(bf2f(Z[idx]));
        Y[idx] = (bf16_t)(cvtpk(y, y) & 0xffffu);
      }
  }
  __syncthreads();
}

DEV void phase_attn(const Params& p, int layer) {
  for (int u = blockIdx.x; u < 512; u += gridDim.x) attn_unit<0>(p, layer, u);
  for (int u = blockIdx.x; u < 768; u += gridDim.x) attn_unit<1>(p, layer, u);
  for (int u = blockIdx.x; u < 256; u += gridDim.x) attn_unit<2>(p, layer, u);
}

__global__ void __launch_bounds__(512, 1) mk_forward(Params p) {
  cg::grid_group grid = cg::this_grid();
  unsigned* bar = (unsigned*)(p.ws + OFF_BAR);
  volatile LAS unsigned* st = (volatile LAS unsigned*)(LAS unsigned*)(smem + 131072 + 3968);
  if (threadIdx.x == 0) { st[0] = 0u; st[1] = 0u; }
  if (blockIdx.x == 0) for (int i = threadIdx.x; i < XCD_BAR_WORDS; i += 512) __hip_atomic_store(bar + i, 0u, __ATOMIC_RELAXED, __HIP_MEMORY_SCOPE_AGENT);
  phase0(p);
  grid.sync();
  XcdBarrier xb = xcd_barrier_post(bar, st);
#pragma unroll 1
  for (int layer = 0; layer < 2; ++layer) {
    const float* xin = layer == 0 ? p.x : p.out;
    phase_norm(p, layer, xin);
    xcd_barrier(xb);
    phase_inproj(p);
    xcd_barrier(xb);
    phase_attn(p, layer);
    xcd_barrier(xb);
    phase_gates(p);
    xcd_barrier(xb);
    phase_merge(p, layer);
    xcd_barrier(xb);
    phase_out(p, layer, xin);
    xcd_barrier(xb);
  }
  phase_final(p);
}

extern "C" void kernel_launch(void* const* d_in, const int* in_sizes, int n_in, void* d_out, int out_size, void* d_ws, size_t ws_size, hipStream_t stream) {
  static int grid_blocks = 0;
  if (ws_size < WS_NEED) { fprintf(stderr, "kernel_launch: workspace too small: %zu < %zu\n", ws_size, WS_NEED); return; }
  if (!grid_blocks) {
    int dev = 0, cus = 0, per_cu = 0;
    hipGetDevice(&dev);
    hipDeviceGetAttribute(&cus, hipDeviceAttributeMultiprocessorCount, dev);
    if (hipFuncSetAttribute((const void*)mk_forward, hipFuncAttributeMaxDynamicSharedMemorySize, LDS_BYTES) != hipSuccess) { fprintf(stderr, "kernel_launch: LDS attribute failed\n"); return; }
    hipOccupancyMaxActiveBlocksPerMultiprocessor(&per_cu, mk_forward, 512, LDS_BYTES);
    if (per_cu < 1) { fprintf(stderr, "kernel_launch: occupancy 0\n"); return; }
    grid_blocks = cus;
  }
  Params p{};
  p.x = (const float*)d_in[0]; p.c = (const float*)d_in[1]; p.pos = (const int*)d_in[2]; p.norm_gain = (const float*)d_in[3];
  p.w_ada = (const float*)d_in[4]; p.b_ada = (const float*)d_in[5]; p.w_in = (const float*)d_in[6]; p.diff_lambda = (const float*)d_in[7];
  p.subln = (const float*)d_in[8]; p.rpb = (const float*)d_in[9]; p.w_branch = (const float*)d_in[10]; p.w_out = (const float*)d_in[11];
  p.final_gain = (const float*)d_in[12]; p.out = (float*)d_out; p.ws = (char*)d_ws;
  void* args[] = {&p};
  hipError_t e = hipLaunchCooperativeKernel((void*)mk_forward, dim3(grid_blocks), dim3(512), args, LDS_BYTES, stream);
  if (e != hipSuccess) fprintf(stderr, "cooperative launch failed: %s (grid %d)\n", hipGetErrorString(e), grid_blocks);
}
```

```cpp
#include <hip/hip_runtime.h>
#include <hip/hip_cooperative_groups.h>
#include <cstdio>
#include <cstdint>
namespace cg = cooperative_groups;

#ifndef MK_MULTI
#define MK_MULTI 0
#endif

typedef unsigned short bf16_t;
typedef short bf16x8 __attribute__((ext_vector_type(8)));
typedef short s16x4 __attribute__((ext_vector_type(4)));
typedef float f32x4 __attribute__((ext_vector_type(4)));
typedef float f32x2 __attribute__((ext_vector_type(2)));
typedef float f32x16 __attribute__((ext_vector_type(16)));
typedef unsigned u32x4 __attribute__((ext_vector_type(4)));
typedef unsigned u32x2 __attribute__((ext_vector_type(2)));
#define DEV __device__ __forceinline__

constexpr int T = 16384, SEQ = 4096, DM = 1024, NB = 4;
constexpr int IN_COLS = 8704;
constexpr float RMS_EPS = 1e-6f;
constexpr float SCALE = 0.125f;

constexpr size_t SZ_T1024 = (size_t)T * 1024 * 2;
constexpr size_t OFF_AQK = 0;
constexpr size_t OFF_AV = OFF_AQK + SZ_T1024;
constexpr size_t OFF_BK = OFF_AV + (size_t)T * 512 * 2;
constexpr size_t OFF_BV = OFF_BK + (size_t)T * 768 * 2;
constexpr size_t OFF_C = OFF_BV + (size_t)T * 768 * 2;
constexpr size_t OFF_BQ = OFF_C + (size_t)T * 768 * 2;
constexpr size_t OFF_Z = OFF_BQ + (size_t)T * 768 * 2;
constexpr size_t OFF_H = OFF_Z + SZ_T1024;
constexpr size_t OFF_Y = OFF_H + SZ_T1024;
constexpr size_t OFF_WIN = OFF_Y + SZ_T1024;
constexpr size_t OFF_WBR = OFF_WIN + (size_t)IN_COLS * 1024 * 2;
constexpr size_t OFF_WOUT = OFF_WBR + (size_t)2 * 1024 * 1024 * 2;
constexpr size_t OFF_LSE = OFF_WOUT + (size_t)2 * 1024 * 1024 * 2;
constexpr size_t OFF_ROPE = OFF_LSE + (size_t)3 * T * 4 * 4;
constexpr size_t OFF_MOD = OFF_ROPE + (size_t)T * 8 * 8;
constexpr size_t OFF_LAM = OFF_MOD + (size_t)2 * 4 * 3072 * 4;
constexpr size_t OFF_BAR = OFF_LAM + 256;
constexpr size_t WS_NEED = OFF_BAR + 3456 * 4;
constexpr size_t OFF_G = OFF_AQK;

constexpr int LDS_BYTES = 131072 + 4096;

struct Params {
  const float* x; const float* c; const int* pos; const float* norm_gain; const float* w_ada; const float* b_ada; const float* w_in;
  const float* diff_lambda; const float* subln; const float* rpb; const float* w_branch; const float* w_out; const float* final_gain;
  float* out; char* ws;
};

extern __shared__ __attribute__((aligned(16))) char smem[];

DEV unsigned cvtpk(float lo, float hi) { unsigned r; asm volatile("v_cvt_pk_bf16_f32 %0, %1, %2" : "=v"(r) : "v"(lo), "v"(hi)); return r; }
DEV float bflo(unsigned w) { return __uint_as_float(w << 16); }
DEV float bfhi(unsigned w) { return __uint_as_float(w & 0xffff0000u); }
DEV float bf2f(bf16_t v) { return __uint_as_float(((unsigned)v) << 16); }
DEV float sigmoidf(float x) { return 1.0f / (1.0f + __expf(-x)); }
DEV float siluf(float x) { return x / (1.0f + __expf(-x)); }
DEV int perm32(int rho) { const int n = rho >> 4, i = rho & 15; return 8 * (i >> 2) + 4 * n + (i & 3); }
DEV int ltid() { int t = threadIdx.x; asm volatile("" : "+v"(t)); return t; }
DEV int lbid() { int t = blockIdx.x; asm volatile("" : "+s"(t)); return t; }
DEV int crow(int r, int hi) { return (r & 3) + 8 * (r >> 2) + 4 * hi; }

#define XB_TMO      128
#define XB_XCNT(j)  (256  + 64 * (j))
#define XB_XSUB(j)  (1280 + 64 * (j))
#define XB_XGEN(j)  (2304 + 64 * (j))
#define XB_TOP      3328
#define XB_TOPGEN   3392
#define XCD_BAR_WORDS 3456
#define XB_SPIN_CAP (1u << 18)
#define LAS __attribute__((address_space(3)))
DEV unsigned xb_ld(unsigned* p) { return __hip_atomic_load(p, __ATOMIC_RELAXED, __HIP_MEMORY_SCOPE_AGENT); }
DEV unsigned xb_add(unsigned* p, unsigned v) { return __hip_atomic_fetch_add(p, v, __ATOMIC_RELAXED, __HIP_MEMORY_SCOPE_AGENT); }
DEV unsigned xb_xcc_id() { return (unsigned)__builtin_amdgcn_s_getreg((3 << 11) | 20) & 0xFu; }
#define XB_SPIN(cond, bar) do { unsigned _sp = 0; while (cond) { __builtin_amdgcn_s_sleep(1); \
    if ((++_sp & 255u) == 0u) { if (xb_ld(&(bar)[XB_TMO])) break; if (_sp > XB_SPIN_CAP) { atomicAdd(&(bar)[XB_TMO], 1u); break; } } } } while (0)
struct XcdBarrier { unsigned* bar; unsigned x; volatile LAS unsigned* st; };
DEV XcdBarrier xcd_barrier_post(unsigned* bar, volatile LAS unsigned* st) {
  XcdBarrier b; b.bar = bar; b.x = xb_xcc_id(); b.st = st;
  if (threadIdx.x == 0) (void)xb_add(&bar[XB_XCNT(b.x)], 1u);
  return b;
}
DEV void xcd_barrier_complete(unsigned* bar, unsigned x, unsigned& nloc, unsigned& nx) {
  const unsigned G = gridDim.x * gridDim.y * gridDim.z;
  unsigned sum, cnt, mine, sp = 0u;
  for (;;) {
    sum = 0u; cnt = 0u; mine = 0u;
#pragma unroll
    for (unsigned j = 0; j < 16; ++j) { const unsigned c = xb_ld(&bar[XB_XCNT(j)]); sum += c; cnt += (c > 0u) ? 1u : 0u; mine = (j == x) ? c : mine; }
    if (sum == G) break;
    __builtin_amdgcn_s_sleep(1);
    if ((++sp & 255u) == 0u) { if (xb_ld(&bar[XB_TMO])) break; if (sp > XB_SPIN_CAP) { atomicAdd(&bar[XB_TMO], 1u); break; } }
  }
  nloc = mine > 0u ? mine : 1u; nx = cnt > 0u ? cnt : 1u;
}
DEV void xcd_barrier(const XcdBarrier& b) {
  asm volatile("s_waitcnt vmcnt(0)" ::: "memory");
  __syncthreads();
  if (threadIdx.x == 0) {
    unsigned* bar = b.bar;
    __builtin_amdgcn_s_waitcnt(0);
    unsigned nloc = b.st[0], nx = b.st[1];
    if (nloc == 0u) { xcd_barrier_complete(bar, b.x, nloc, nx); b.st[0] = nloc; b.st[1] = nx; }
    const unsigned old = xb_add(&bar[XB_XSUB(b.x)], 1u);
    const unsigned gen = old / nloc;
    if (old + 1u == (gen + 1u) * nloc) {
      __builtin_amdgcn_fence(__ATOMIC_RELEASE, "agent");
      asm volatile("s_waitcnt vmcnt(0)" ::: "memory");
      const unsigned og = xb_add(&bar[XB_TOP], 1u);
      const unsigned tg = og / nx;
      if (og + 1u == (tg + 1u) * nx) xb_add(&bar[XB_TOPGEN], 1u);
      else XB_SPIN(xb_ld(&bar[XB_TOPGEN]) == tg, bar);
      __builtin_amdgcn_fence(__ATOMIC_ACQUIRE, "agent");
      xb_add(&bar[XB_XGEN(b.x)], 1u);
      asm volatile("s_waitcnt vmcnt(0)" ::: "memory");
    } else {
      XB_SPIN(xb_ld(&bar[XB_XGEN(b.x)]) == gen, bar);
      __builtin_amdgcn_fence(__ATOMIC_ACQUIRE, "agent");
      asm volatile("s_waitcnt vmcnt(0)" ::: "memory");
    }
  }
  __syncthreads();
}

DEV int win_src_col(int j) {
  const int c = (j & ~31) + perm32(j & 31);
  int orig; bool rope;
  if (c < 1024) { orig = c; rope = true; }
  else if (c < 1536) { orig = c; rope = false; }
  else if (c < 2304) { orig = 2304 + (c - 1536); rope = true; }
  else if (c < 3072) { orig = 3072 + (c - 2304); rope = false; }
  else if (c < 3840) { orig = 3840 + (c - 3072); rope = false; }
  else if (c < 4608) { orig = 1536 + (c - 3840); rope = true; }
  else { orig = c; rope = false; }
  if (rope) { int p = orig & 63; if (p < 16) { const int i = p >> 1; p = (p & 1) ? i + 8 : i; orig = (orig & ~63) + p; } }
  return orig;
}

struct CvtTile { const float* src; int ld; bf16_t* dst; int j0, k0, o0; bool win; };
DEV void cvt_decode(const Params& p, int layer, int t, CvtTile& c) {
  if (t < 2176) { const int kt = t & 15, nt = t >> 4; c.src = p.w_in + (size_t)layer * 1024 * IN_COLS; c.ld = IN_COLS; c.dst = (bf16_t*)(p.ws + OFF_WIN); c.j0 = nt * 64; c.k0 = kt * 64; c.o0 = win_src_col(c.j0) & ~63; c.win = true; }
  else { const int tt0 = t - 2176, mat = tt0 >> 8, tt = tt0 & 255, kt = tt & 15, nt = tt >> 4, l = mat & 1;
    c.src = (mat < 2 ? p.w_branch : p.w_out) + (size_t)l * 1024 * 1024; c.ld = 1024; c.dst = (bf16_t*)(p.ws + (mat < 2 ? OFF_WBR : OFF_WOUT)) + (size_t)l * 1024 * 1024; c.j0 = nt * 64; c.k0 = kt * 64; c.o0 = c.j0; c.win = false; }
}
DEV void cvt_range(const Params& p, int layer, int tbeg, int tend) {
  float* l = (float*)smem;
  const int tid = ltid();
  int t = tbeg + blockIdx.x;
  if (t >= tend) return;
  CvtTile c; cvt_decode(p, layer, t, c);
  f32x4 v0, v1;
  { const int kr = tid >> 4, c4 = (tid & 15) * 4;
    v0 = *(const f32x4*)(c.src + (size_t)(c.k0 + kr) * c.ld + c.o0 + c4); v1 = *(const f32x4*)(c.src + (size_t)(c.k0 + 32 + kr) * c.ld + c.o0 + c4); }
  for (;;) {
    { const int kr = tid >> 4, c4 = (tid & 15) * 4;
      l[kr * 65 + c4 + 0] = v0[0]; l[kr * 65 + c4 + 1] = v0[1]; l[kr * 65 + c4 + 2] = v0[2]; l[kr * 65 + c4 + 3] = v0[3];
      l[(kr + 32) * 65 + c4 + 0] = v1[0]; l[(kr + 32) * 65 + c4 + 1] = v1[1]; l[(kr + 32) * 65 + c4 + 2] = v1[2]; l[(kr + 32) * 65 + c4 + 3] = v1[3]; }
    __syncthreads();
    const int tn = t + gridDim.x; CvtTile cn;
    if (tn < tend) { cvt_decode(p, layer, tn, cn); const int kr = tid >> 4, c4 = (tid & 15) * 4;
      v0 = *(const f32x4*)(cn.src + (size_t)(cn.k0 + kr) * cn.ld + cn.o0 + c4); v1 = *(const f32x4*)(cn.src + (size_t)(cn.k0 + 32 + kr) * cn.ld + cn.o0 + c4); }
    const int jj = tid >> 3, kc = (tid & 7) * 8, j = c.j0 + jj;
    const int oc = (c.win ? win_src_col(j) : ((j & ~31) + perm32(j & 31))) - c.o0;
    u32x4 w;
    w[0] = cvtpk(l[(kc + 0) * 65 + oc], l[(kc + 1) * 65 + oc]);
    w[1] = cvtpk(l[(kc + 2) * 65 + oc], l[(kc + 3) * 65 + oc]);
    w[2] = cvtpk(l[(kc + 4) * 65 + oc], l[(kc + 5) * 65 + oc]);
    w[3] = cvtpk(l[(kc + 6) * 65 + oc], l[(kc + 7) * 65 + oc]);
    *(u32x4*)(c.dst + (size_t)j * 1024 + c.k0 + kc) = w;
    __syncthreads();
    if (tn >= tend) break;
    t = tn; c = cn;
  }
}
DEV void cvt_win_layer(const Params& p, int layer) { cvt_range(p, layer, 0, 2176); }

DEV void phase0(const Params& p) {
  const int tid = ltid();
  cvt_range(p, 0, 0, 3200);
  float* mod = (float*)(p.ws + OFF_MOD);
  if (blockIdx.x < 192) {
    float* cact = (float*)smem; float* l4 = (float*)(smem + 16384);
    for (int i = tid; i < 4096; i += 512) cact[i] = siluf(p.c[i]);
    __syncthreads();
    for (int it = blockIdx.x; it < 192; it += gridDim.x) {
      const int l = it / 96, j0 = (it % 96) * 32, w = tid >> 6, lane = tid & 63, cl = lane & 31, kh = w * 2 + (lane >> 5);
      const float* wa = p.w_ada + (size_t)l * 1024 * 3072 + j0 + cl;
      float a0 = 0.f, a1 = 0.f, a2 = 0.f, a3 = 0.f;
      for (int k = kh * 64; k < kh * 64 + 64; k += 16) {
        float wv[16];
#pragma unroll
        for (int q = 0; q < 16; ++q) wv[q] = wa[(size_t)(k + q) * 3072];
#pragma unroll
        for (int q = 0; q < 16; ++q) { a0 += cact[k + q] * wv[q]; a1 += cact[1024 + k + q] * wv[q]; a2 += cact[2048 + k + q] * wv[q]; a3 += cact[3072 + k + q] * wv[q]; }
      }
      l4[(kh * 4 + 0) * 32 + cl] = a0; l4[(kh * 4 + 1) * 32 + cl] = a1; l4[(kh * 4 + 2) * 32 + cl] = a2; l4[(kh * 4 + 3) * 32 + cl] = a3;
      __syncthreads();
      if (tid < 128) {
        const int b = tid >> 5, c2 = tid & 31; float s = 0.f;
        for (int q = 0; q < 16; ++q) s += l4[(q * 4 + b) * 32 + c2];
        mod[((size_t)l * 4 + b) * 3072 + j0 + c2] = s + p.b_ada[l * 3072 + j0 + c2];
      }
      __syncthreads();
    }
  }
  f32x2* rope = (f32x2*)(p.ws + OFF_ROPE);
  for (int i = blockIdx.x * 512 + tid; i < T * 8; i += gridDim.x * 512) {
    const int tok = i >> 3, fi = i & 7;
    float inv;
    switch (fi) { case 0: inv = 1.0f; break; case 1: inv = 0.1939227432012558f; break; case 2: inv = 0.03760603070259094f; break; case 3: inv = 0.007292664609849453f; break;
                  case 4: inv = 0.0014142135623842478f; break; case 5: inv = 0.00027424818836152554f; break; case 6: inv = 5.318296098266728e-05f; break; default: inv = 1.0313386155758053e-05f; break; }
    const float angf = (float)p.pos[tok] * inv;
    const double a = (double)angf;
    const double q = rint(a * 0.63661977236758134308);
    double r = fma(-q, 1.57079632679489655800, a); r = fma(-q, 6.12323399573676603587e-17, r);
    const int n = ((int)q) & 3;
    const double r2 = r * r;
    const double sn = r + r * r2 * (-1.0 / 6 + r2 * (1.0 / 120 + r2 * (-1.0 / 5040 + r2 * (1.0 / 362880 - r2 * (1.0 / 39916800)))));
    const double cs = 1.0 + r2 * (-0.5 + r2 * (1.0 / 24 + r2 * (-1.0 / 720 + r2 * (1.0 / 40320 + r2 * (-1.0 / 3628800 + r2 * (1.0 / 479001600))))));
    double co, si;
    if (n == 0) { co = cs; si = sn; } else if (n == 1) { co = -sn; si = cs; } else if (n == 2) { co = -cs; si = -sn; } else { co = sn; si = -cs; }
    rope[i] = (f32x2){(float)co, (float)si};
  }
  if (blockIdx.x == 0 && tid < 2) {
    const float* dl = p.diff_lambda + tid * 256;
    float s1 = 0.f, s2 = 0.f;
    for (int i = 0; i < 64; ++i) { s1 += dl[i] * dl[64 + i]; s2 += dl[128 + i] * dl[192 + i]; }
    const float li = 0.8f - 0.6f * expf(-0.3f * (float)tid);
    ((float*)(p.ws + OFF_LAM))[tid] = expf(s1) - expf(s2) + li;
  }
}

DEV void phase_norm(const Params& p, int layer, const float* __restrict__ xin) {
  const int tid_ = ltid(); const int wid = tid_ >> 6, lane = tid_ & 63;
  const float* mod = (const float*)(p.ws + OFF_MOD) + (size_t)layer * 4 * 3072;
  const float* gain = p.norm_gain + layer * 1024;
  bf16_t* H = (bf16_t*)(p.ws + OFF_H);
  for (int row = blockIdx.x * 8 + wid; row < T; row += gridDim.x * 8) {
    const int b = row >> 12;
    const float* xr = xin + (size_t)row * 1024;
    f32x4 v[4]; float ss = 0.f;
#pragma unroll
    for (int i = 0; i < 4; ++i) { v[i] = *(const f32x4*)(xr + i * 256 + lane * 4); ss += v[i][0] * v[i][0] + v[i][1] * v[i][1] + v[i][2] * v[i][2] + v[i][3] * v[i][3]; }
#pragma unroll
    for (int o = 32; o > 0; o >>= 1) ss += __shfl_xor(ss, o);
    const float rstd = rsqrtf(ss * (1.0f / 1024.0f) + RMS_EPS);
#pragma unroll
    for (int i = 0; i < 4; ++i) {
      const int c = i * 256 + lane * 4;
      const f32x4 g = *(const f32x4*)(gain + c), sh = *(const f32x4*)(mod + b * 3072 + c), sc = *(const f32x4*)(mod + b * 3072 + 1024 + c);
      float h0 = v[i][0] * rstd * g[0] * (1.f + sc[0]) + sh[0], h1 = v[i][1] * rstd * g[1] * (1.f + sc[1]) + sh[1];
      float h2 = v[i][2] * rstd * g[2] * (1.f + sc[2]) + sh[2], h3 = v[i][3] * rstd * g[3] * (1.f + sc[3]) + sh[3];
      u32x2 w; w[0] = cvtpk(h0, h1); w[1] = cvtpk(h2, h3);
      *(u32x2*)(H + (size_t)row * 1024 + c) = w;
    }
  }
}

DEV void phase_final(const Params& p) {
  const int tid_ = ltid(); const int wid = tid_ >> 6, lane = tid_ & 63;
  for (int row = blockIdx.x * 8 + wid; row < T; row += gridDim.x * 8) {
    float* xr = p.out + (size_t)row * 1024;
    f32x4 v[4]; float ss = 0.f;
#pragma unroll
    for (int i = 0; i < 4; ++i) { v[i] = *(const f32x4*)(xr + i * 256 + lane * 4); ss += v[i][0] * v[i][0] + v[i][1] * v[i][1] + v[i][2] * v[i][2] + v[i][3] * v[i][3]; }
#pragma unroll
    for (int o = 32; o > 0; o >>= 1) ss += __shfl_xor(ss, o);
    const float rstd = rsqrtf(ss * (1.0f / 1024.0f) + RMS_EPS);
#pragma unroll
    for (int i = 0; i < 4; ++i) {
      const int c = i * 256 + lane * 4;
      const f32x4 g = *(const f32x4*)(p.final_gain + c);
      f32x4 o; o[0] = v[i][0] * rstd * g[0]; o[1] = v[i][1] * rstd * g[1]; o[2] = v[i][2] * rstd * g[2]; o[3] = v[i][3] * rstd * g[3];
      *(f32x4*)(xr + c) = o;
    }
  }
}

constexpr int HALF = 128, BK = 64, HT = HALF * BK;
DEV int lds_byte(int r, int c) { const int st = (r >> 4) * 2 + (c >> 5), rr = r & 15, cc = c & 31, ob = rr * 64 + cc * 2; return st * 1024 + (ob ^ (((ob >> 9) & 1) << 5)); }
DEV void stage_rc(int b, int& R, int& C) { const int st = b / 1024, sb = b % 1024, swz = sb ^ (((sb >> 9) & 1) << 5); R = (st >> 1) * 16 + swz / 64; C = (st & 1) * 32 + (swz % 64) / 2; }

DEV bool gemm_next(int i, int nM, int nN, int& pm, int& pn) {
  const int nwg = nM * nN; const long L = (long)i * gridDim.x + blockIdx.x; if (L >= nwg) return false;
  int wgid = (int)L; { const int q = nwg / 8, r = nwg % 8, xcd = wgid % 8, off = wgid / 8; wgid = (xcd < r ? xcd * (q + 1) : r * (q + 1) + (xcd - r) * q) + off; }
  const int nig = 8 * nN, gid = wgid / nig, fm = gid * 8, gsz = (nM - fm) < 8 ? (nM - fm) : 8;
  pm = fm + ((wgid % nig) % gsz); pn = (wgid % nig) / gsz; return true;
}

struct GUnit { const char* a; const char* b; int nt, pm, pn, s; };
typedef __attribute__((address_space(3))) unsigned char LDSC;
template <class Next, class Epi>
DEV void gemm_stream(Next&& next, Epi&& epi) {
  LDSC* lds = (LDSC*)smem;
  const int tid = ltid(), wid = __builtin_amdgcn_readfirstlane(tid >> 6), lane = tid & 63, wr = wid >> 2, wc = wid & 3, fr = lane & 15, fq = lane >> 4;
  unsigned voff[2];
#pragma unroll
  for (int i = 0; i < 2; ++i) { int R, C; stage_rc(tid * 16 + i * 8192, R, C); voff[i] = (unsigned)(R * 1024 + C) * 2u; }
  constexpr size_t kstep = 128, hstep = (size_t)128 * 1024 * 2;
  constexpr int HTB = 128 * 64 * 2;
  const unsigned ldsw = (unsigned)wid * 1024u;
  const int aoff = lds_byte(wr * 64 + fr, fq * 8), boff = lds_byte(wc * 32 + fr, fq * 8);
#define G_SA(b, h) (((b) * 2 + (h)) * HTB)
#define G_SB(b, h) ((4 + (b) * 2 + (h)) * HTB)
#define G_STAGE(bufoff, gbase) do { _Pragma("unroll") for (int _i = 0; _i < 2; ++_i) \
    __builtin_amdgcn_global_load_lds((const unsigned*)((const char*)(gbase) + voff[_i]), (__attribute__((address_space(3))) unsigned*)(lds + (bufoff) + ldsw + _i * 8192), 16, 0, 0); } while (0)
#define G_LDA(dst, b, h) do { _Pragma("unroll") for (int m = 0; m < 4; ++m) _Pragma("unroll") for (int k = 0; k < 2; ++k) dst[m][k] = *(const __attribute__((address_space(3))) bf16x8*)(lds + G_SA(b, h) + aoff + m * 2048 + k * 1024); } while (0)
#define G_LDB(dst, b, h) do { _Pragma("unroll") for (int n = 0; n < 2; ++n) _Pragma("unroll") for (int k = 0; k < 2; ++k) dst[n][k] = *(const __attribute__((address_space(3))) bf16x8*)(lds + G_SB(b, h) + boff + n * 2048 + k * 1024); } while (0)
#define G_MMA(ai, bj, At, Bf) do { __builtin_amdgcn_s_setprio(1); _Pragma("unroll") for (int m = 0; m < 4; ++m) _Pragma("unroll") for (int n = 0; n < 2; ++n) _Pragma("unroll") for (int k = 0; k < 2; ++k) \
    acc[ai][bj][m][n] = __builtin_amdgcn_mfma_f32_16x16x32_bf16(Bf[n][k], At[m][k], acc[ai][bj][m][n], 0, 0, 0); __builtin_amdgcn_s_setprio(0); } while (0)
#define G_WAIT_V(n) asm volatile("s_waitcnt vmcnt(" #n ")" ::: "memory")
#define G_WAIT_L(n) asm volatile("s_waitcnt lgkmcnt(" #n ")" ::: "memory")
#define G_BAR __builtin_amdgcn_s_barrier()
#define G_SCHED __builtin_amdgcn_sched_barrier(0)
  GUnit cur, nxt; int ui = 0;
  if (!next(0, cur)) return;
  f32x4 acc[2][2][4][2];
#pragma unroll
  for (int a = 0; a < 2; ++a)
#pragma unroll
    for (int b = 0; b < 2; ++b)
#pragma unroll
      for (int m = 0; m < 4; ++m)
#pragma unroll
        for (int n = 0; n < 2; ++n) acc[a][b][m][n] = (f32x4){0.f, 0.f, 0.f, 0.f};
  bf16x8 At[4][2], B0[2][2], B1[2][2];
  const char* cA = cur.a; const char* cB = cur.b;
  G_STAGE(G_SB(0, 0), cB); G_STAGE(G_SA(0, 0), cA); G_STAGE(G_SB(0, 1), cB + hstep); G_STAGE(G_SA(0, 1), cA + hstep);
  if (wr == 1) G_BAR;
  G_WAIT_V(4); G_BAR;
  G_STAGE(G_SB(1, 0), cB + kstep); G_STAGE(G_SA(1, 0), cA + kstep); G_STAGE(G_SB(1, 1), cB + hstep + kstep);
  G_WAIT_V(6); G_BAR;
  for (;;) {
    const bool has_next = next(ui + 1, nxt);
    const char* nA = has_next ? nxt.a : cA; const char* nB = has_next ? nxt.b : cB;
    const int nt = cur.nt;
    for (int t = 0; t < nt; t += 2) {
      const bool last = (t == nt - 2);
      const char* a1 = cA + (size_t)(t + 1) * kstep;
      const char* a2 = last ? nA : cA + (size_t)(t + 2) * kstep; const char* b2 = last ? nB : cB + (size_t)(t + 2) * kstep;
      const char* a3 = a2 + kstep; const char* b3 = b2 + kstep;
      G_LDB(B0, 0, 0); G_SCHED; G_LDA(At, 0, 0); G_STAGE(G_SA(1, 1), a1 + hstep);
      G_WAIT_L(8); G_BAR; G_WAIT_L(0); G_MMA(0, 0, At, B0); G_BAR; G_SCHED;
      G_LDB(B1, 0, 1); G_STAGE(G_SB(0, 0), b2);
      G_BAR; G_WAIT_L(0); G_MMA(0, 1, At, B1); G_BAR;
      G_LDA(At, 0, 1); G_STAGE(G_SA(0, 0), a2);
      G_BAR; G_WAIT_L(0); G_MMA(1, 0, At, B0); G_BAR; G_SCHED;
      G_STAGE(G_SB(0, 1), b2 + hstep);
      G_WAIT_V(6); G_BAR; G_MMA(1, 1, At, B1); G_BAR;
      G_LDB(B0, 1, 0); G_SCHED; G_LDA(At, 1, 0); G_STAGE(G_SA(0, 1), a2 + hstep);
      G_WAIT_L(8); G_BAR; G_WAIT_L(0); G_MMA(0, 0, At, B0); G_BAR; G_SCHED;
      G_LDB(B1, 1, 1); G_STAGE(G_SB(1, 0), b3);
      G_BAR; G_WAIT_L(0); G_MMA(0, 1, At, B1); G_BAR;
      G_LDA(At, 1, 1); G_STAGE(G_SA(1, 0), a3);
      G_BAR; G_WAIT_L(0); G_MMA(1, 0, At, B0); G_BAR; G_SCHED;
      G_STAGE(G_SB(1, 1), b3 + hstep);
      G_WAIT_V(6); G_BAR; G_MMA(1, 1, At, B1); G_BAR;
    }
    epi(acc, cur, wr, wc, fr, fq);
    if (!has_next) break;
#pragma unroll
    for (int a = 0; a < 2; ++a)
#pragma unroll
      for (int b = 0; b < 2; ++b)
#pragma unroll
        for (int m = 0; m < 4; ++m)
#pragma unroll
          for (int n = 0; n < 2; ++n) acc[a][b][m][n] = (f32x4){0.f, 0.f, 0.f, 0.f};
    cur = nxt; cA = nA; cB = nB; ++ui;
  }
  G_WAIT_V(0);
  if (wr == 0) G_BAR;
  G_BAR;
#undef G_SA
#undef G_SB
#undef G_STAGE
#undef G_LDA
#undef G_LDB
#undef G_MMA
}

DEV void phase_inproj(const Params& p) {
  const char* H = p.ws + OFF_H;
  const char* W = p.ws + OFF_WIN;
  const f32x4* rope = (const f32x4*)(p.ws + OFF_ROPE);
  char* ws = p.ws;
  __syncthreads();
  gemm_stream([&](int i, GUnit& u) -> bool {
      int pm, pn; if (!gemm_next(i, 64, 22, pm, pn)) return false;
      u.a = H + (size_t)pm * 256 * 2048; u.b = W + (size_t)pn * 256 * 2048; u.nt = 16; u.pm = pm; u.pn = pn; u.s = 0; return true; },
    [&](f32x4 (&acc)[2][2][4][2], const GUnit& u, int wr, int wc, int fr, int fq) {
      const int c0 = u.pn * 256;
      size_t base; int ld, lc; bool rp;
      if (c0 < 1024) { base = OFF_AQK; ld = 1024; lc = c0; rp = true; }
      else if (c0 < 1536) { base = OFF_AV; ld = 512; lc = c0 - 1024; rp = false; }
      else if (c0 < 2304) { base = OFF_BK; ld = 768; lc = c0 - 1536; rp = true; }
      else if (c0 < 3072) { base = OFF_BV; ld = 768; lc = c0 - 2304; rp = false; }
      else if (c0 < 3840) { base = OFF_C; ld = 768; lc = c0 - 3072; rp = false; }
      else if (c0 < 4608) { base = OFF_BQ; ld = 768; lc = c0 - 3840; rp = true; }
      else { base = OFF_Z; ld = 1024; lc = c0 - 4608; rp = false; }
      bf16_t* dst = (bf16_t*)(ws + base);
      const bool dorope = rp && ((wc & 1) == 0) && (fq < 2);
#pragma unroll
      for (int ai = 0; ai < 2; ++ai)
#pragma unroll
        for (int m = 0; m < 4; ++m) {
          const int row = u.pm * 256 + ai * 128 + wr * 64 + m * 16 + fr;
          f32x4 cs0 = {1.f, 0.f, 1.f, 0.f}, cs1 = {1.f, 0.f, 1.f, 0.f};
          if (dorope) { cs0 = rope[(size_t)row * 4 + fq * 2]; cs1 = rope[(size_t)row * 4 + fq * 2 + 1]; }
#pragma unroll
          for (int bj = 0; bj < 2; ++bj) {
            f32x4 v0 = acc[ai][bj][m][0], v1 = acc[ai][bj][m][1];
            if (dorope) {
              f32x4 a, b;
              a[0] = v0[0] * cs0[0] - v0[1] * cs0[1]; a[1] = v0[1] * cs0[0] + v0[0] * cs0[1];
              a[2] = v0[2] * cs0[2] - v0[3] * cs0[3]; a[3] = v0[3] * cs0[2] + v0[2] * cs0[3];
              b[0] = v1[0] * cs1[0] - v1[1] * cs1[1]; b[1] = v1[1] * cs1[0] + v1[0] * cs1[1];
              b[2] = v1[2] * cs1[2] - v1[3] * cs1[3]; b[3] = v1[3] * cs1[2] + v1[2] * cs1[3];
              v0 = a; v1 = b;
            }
            u32x4 w; w[0] = cvtpk(v0[0], v0[1]); w[1] = cvtpk(v0[2], v0[3]); w[2] = cvtpk(v1[0], v1[1]); w[3] = cvtpk(v1[2], v1[3]);
            *(u32x4*)(dst + (size_t)row * ld + lc + bj * 128 + wc * 32 + fq * 8) = w;
          }
        }
    });
}

DEV void phase_gates(const Params& p) {
  {
    const bf16_t* OB = (const bf16_t*)(p.ws + OFF_BQ);
    const float* LSE = (const float*)(p.ws + OFF_LSE);
    const bf16_t* Z = (const bf16_t*)(p.ws + OFF_Z);
    bf16_t* Y = (bf16_t*)(p.ws + OFF_Y);
    for (int i = blockIdx.x * 512 + ltid(); i < T * 32; i += gridDim.x * 512) {
      const int tok = i >> 5, hs = (i >> 3) & 3, dc = (i & 7) * 8;
      const float l0 = LSE[((size_t)0 * T + tok) * 4 + hs], l1 = LSE[((size_t)1 * T + tok) * 4 + hs], l2 = LSE[((size_t)2 * T + tok) * 4 + hs];
      const float mx = fmaxf(l0, fmaxf(l1, l2));
      float e0 = __expf(l0 - mx), e1 = __expf(l1 - mx), e2 = __expf(l2 - mx);
      const float inv = 1.0f / (e0 + e1 + e2); e0 *= inv; e1 *= inv; e2 *= inv;
      const u32x4 a = *(const u32x4*)(OB + (size_t)tok * 768 + 0 * 256 + hs * 64 + dc);
      const u32x4 b = *(const u32x4*)(OB + (size_t)tok * 768 + 1 * 256 + hs * 64 + dc);
      const u32x4 c = *(const u32x4*)(OB + (size_t)tok * 768 + 2 * 256 + hs * 64 + dc);
      const u32x4 z = *(const u32x4*)(Z + (size_t)tok * 1024 + 512 + hs * 64 + dc);
      u32x4 w;
#pragma unroll
      for (int k = 0; k < 4; ++k) {
        const float lo = (e0 * bflo(a[k]) + e1 * bflo(b[k]) + e2 * bflo(c[k])) * siluf(bflo(z[k]));
        const float hi = (e0 * bfhi(a[k]) + e1 * bfhi(b[k]) + e2 * bfhi(c[k])) * siluf(bfhi(z[k]));
        w[k] = cvtpk(lo, hi);
      }
      *(u32x4*)(Y + (size_t)tok * 1024 + 512 + hs * 64 + dc) = w;
    }
  }
  const char* H = p.ws + OFF_H;
  const char* W = p.ws + OFF_WIN + (size_t)5632 * 2048;
  bf16_t* G = (bf16_t*)(p.ws + OFF_G);
  __syncthreads();
  gemm_stream([&](int i, GUnit& u) -> bool {
      int pm, pn; if (!gemm_next(i, 64, 12, pm, pn)) return false;
      u.a = H + (size_t)pm * 256 * 2048; u.b = W + (size_t)pn * 256 * 2048; u.nt = 16; u.pm = pm; u.pn = pn; u.s = 0; return true; },
    [&](f32x4 (&acc)[2][2][4][2], const GUnit& u, int wr, int wc, int fr, int fq) {
#pragma unroll
      for (int ai = 0; ai < 2; ++ai)
#pragma unroll
        for (int m = 0; m < 4; ++m) {
          const int row = u.pm * 256 + ai * 128 + wr * 64 + m * 16 + fr;
#pragma unroll
          for (int bj = 0; bj < 2; ++bj) {
            const f32x4 v0 = acc[ai][bj][m][0], v1 = acc[ai][bj][m][1];
            u32x4 w; w[0] = cvtpk(sigmoidf(v0[0]), sigmoidf(v0[1])); w[1] = cvtpk(sigmoidf(v0[2]), sigmoidf(v0[3]));
            w[2] = cvtpk(sigmoidf(v1[0]), sigmoidf(v1[1])); w[3] = cvtpk(sigmoidf(v1[2]), sigmoidf(v1[3]));
            *(u32x4*)(G + (size_t)row * 3072 + u.pn * 256 + bj * 128 + wc * 32 + fq * 8) = w;
          }
        }
    });
}

DEV void phase_merge(const Params& p, int layer) {
  const char* Y = p.ws + OFF_Y;
  const char* W = p.ws + OFF_WBR + (size_t)layer * 1024 * 2048;
  const bf16_t* G = (const bf16_t*)(p.ws + OFF_G);
  bf16_t* M = (bf16_t*)(p.ws + OFF_H);
  __syncthreads();
  gemm_stream([&](int i, GUnit& u) -> bool {
      const int uu = i / 3, s = i - uu * 3;
      int pm, pn; if (!gemm_next(uu, 64, 4, pm, pn)) return false;
      const int koff = (s == 0) ? 0 : (s == 1 ? 512 : 768);
      u.a = Y + (size_t)pm * 256 * 2048 + koff * 2; u.b = W + (size_t)pn * 256 * 2048 + koff * 2; u.nt = (s == 0) ? 8 : 4; u.pm = pm; u.pn = pn; u.s = s; return true; },
    [&](f32x4 (&acc)[2][2][4][2], const GUnit& u, int wr, int wc, int fr, int fq) {
      const int s = u.s;
#pragma unroll
      for (int ai = 0; ai < 2; ++ai)
#pragma unroll
        for (int m = 0; m < 4; ++m) {
          const int row = u.pm * 256 + ai * 128 + wr * 64 + m * 16 + fr;
#pragma unroll
          for (int bj = 0; bj < 2; ++bj) {
            const int col = u.pn * 256 + bj * 128 + wc * 32 + fq * 8;
            const u32x4 g = *(const u32x4*)(G + (size_t)row * 3072 + s * 1024 + col);
            u32x4 old = {0u, 0u, 0u, 0u};
            if (s > 0) old = *(const u32x4*)(M + (size_t)row * 1024 + col);
            const f32x4 v0 = acc[ai][bj][m][0], v1 = acc[ai][bj][m][1];
            u32x4 w;
            w[0] = cvtpk(bflo(old[0]) + bflo(g[0]) * v0[0], bfhi(old[0]) + bfhi(g[0]) * v0[1]);
            w[1] = cvtpk(bflo(old[1]) + bflo(g[1]) * v0[2], bfhi(old[1]) + bfhi(g[1]) * v0[3]);
            w[2] = cvtpk(bflo(old[2]) + bflo(g[2]) * v1[0], bfhi(old[2]) + bfhi(g[2]) * v1[1]);
            w[3] = cvtpk(bflo(old[3]) + bflo(g[3]) * v1[2], bfhi(old[3]) + bfhi(g[3]) * v1[3]);
            *(u32x4*)(M + (size_t)row * 1024 + col) = w;
          }
        }
    });
}

DEV void phase_out(const Params& p, int layer, const float* __restrict__ xin) {
  const char* M = p.ws + OFF_H;
  const char* W = p.ws + OFF_WOUT + (size_t)layer * 1024 * 2048;
  const float* mod = (const float*)(p.ws + OFF_MOD) + (size_t)layer * 4 * 3072 + 2048;
  float* out = p.out;
  __syncthreads();
  gemm_stream([&](int i, GUnit& u) -> bool {
      int pm, pn; if (!gemm_next(i, 64, 4, pm, pn)) return false;
      u.a = M + (size_t)pm * 256 * 2048; u.b = W + (size_t)pn * 256 * 2048; u.nt = 16; u.pm = pm; u.pn = pn; u.s = 0; return true; },
    [&](f32x4 (&acc)[2][2][4][2], const GUnit& u, int wr, int wc, int fr, int fq) {
      const int b = u.pm >> 4;
#pragma unroll
      for (int bj = 0; bj < 2; ++bj) {
        const int col = u.pn * 256 + bj * 128 + wc * 32 + fq * 8;
        const f32x4 g0 = *(const f32x4*)(mod + b * 3072 + col), g1 = *(const f32x4*)(mod + b * 3072 + col + 4);
#pragma unroll
        for (int ai = 0; ai < 2; ++ai)
#pragma unroll
          for (int m = 0; m < 4; ++m) {
            const int row = u.pm * 256 + ai * 128 + wr * 64 + m * 16 + fr;
            const f32x4 x0 = *(const f32x4*)(xin + (size_t)row * 1024 + col), x1 = *(const f32x4*)(xin + (size_t)row * 1024 + col + 4);
            *(f32x4*)(out + (size_t)row * 1024 + col) = x0 + g0 * acc[ai][bj][m][0];
            *(f32x4*)(out + (size_t)row * 1024 + col + 4) = x1 + g1 * acc[ai][bj][m][1];
          }
      }
    });
  __syncthreads();
  if (layer == 0) cvt_win_layer(p, 1);
}

#define KSWZ_A(row, colB) ((row) * 256 + ((colB) ^ (((row) & 7) << 4)))
#define KSWZ_S(row, colB) ((row) * 128 + ((colB) ^ ((((row) >> 1) & 7) << 4)))
template <int DV> DEV int v_st(int k, int c) { const int kk = (k & ~0xC) | ((k & 4) << 1) | ((k & 8) >> 1); return ((kk >> 3) * (DV / 32) + (c >> 5)) * 512 + ((kk & 7) * 32 + (c & 31)) * 2; }
DEV int v_rd_base(int lane) { return ((lane & 3) << 3) | (((lane >> 2) & 3) << 6) | (((lane >> 4) & 1) << 5) | (((lane >> 5) & 1) << 8); }
template <int OFF> DEV s16x4 tr_read(int vb) { s16x4 r; asm volatile("ds_read_b64_tr_b16 %0, %1 offset:%2" : "=&v"(r) : "v"(vb), "i"(OFF) : "memory"); return r; }
template <int DV, int D0> DEV void pv_one(f32x16& od, int vb, bf16x8 pa0, bf16x8 pa1, bf16x8 pa2, bf16x8 pa3) {
  constexpr int KS = (DV / 32) * 1024, HF = (DV / 32) * 512;
  const s16x4 l0 = tr_read<D0 * 512 + 0 * KS>(vb), h0 = tr_read<D0 * 512 + 0 * KS + HF>(vb), l1 = tr_read<D0 * 512 + 1 * KS>(vb), h1 = tr_read<D0 * 512 + 1 * KS + HF>(vb);
  const s16x4 l2 = tr_read<D0 * 512 + 2 * KS>(vb), h2 = tr_read<D0 * 512 + 2 * KS + HF>(vb), l3 = tr_read<D0 * 512 + 3 * KS>(vb), h3 = tr_read<D0 * 512 + 3 * KS + HF>(vb);
  asm volatile("s_waitcnt lgkmcnt(0)" ::: "memory"); __builtin_amdgcn_sched_barrier(0);
#define PK(L, H) (bf16x8){L[0], L[1], L[2], L[3], H[0], H[1], H[2], H[3]}
  od = __builtin_amdgcn_mfma_f32_32x32x16_bf16(pa0, PK(l0, h0), od, 0, 0, 0);
  od = __builtin_amdgcn_mfma_f32_32x32x16_bf16(pa1, PK(l1, h1), od, 0, 0, 0);
  od = __builtin_amdgcn_mfma_f32_32x32x16_bf16(pa2, PK(l2, h2), od, 0, 0, 0);
  od = __builtin_amdgcn_mfma_f32_32x32x16_bf16(pa3, PK(l3, h3), od, 0, 0, 0);
#undef PK
}

template <int MODE>
DEV void attn_unit(const Params& p, int layer, int u) {
  constexpr int DV = (MODE == 0) ? 128 : 64, ND = DV / 32;
  constexpr int TB = (MODE == 0) ? 16384 : 8192;
  constexpr float C = SCALE * 1.4426950408889634f;
  constexpr float THRRAW = 8.0f / SCALE;
  const int tid = ltid(), wid = tid >> 6, lane = tid & 63, r32 = lane & 31, hi = lane >> 5;
  char* V_lds = smem; char* K_lds = smem + 2 * TB;
  float* wsc = (float*)(smem + 131072) + wid * 64; float* li_l = wsc; float* al_l = wsc + 32;
  float* rpb_l = (float*)(smem + 131072 + 2048);

  int b = 0, h = 0, NT = 0, tfirst = 0;
  int g = 0, rr = 1, mres = 0, blk = 0, Lsub = 0;
  int r0 = 0, row_lo = 0, qrow = 0, qcol = 0, rs = 0, cs = 0;
  const bf16_t *Qp, *Kb, *Vb; int ldkv;
  int qtok;
  int coff = 0;
  if (MODE == 0) {
    const int pair = ((u & 7) << 1) | (u >> 8), qb = (u >> 3) & 31; b = pair >> 2; h = pair & 3;
    const int g4 = wid >> 1, cm = wid & 1; coff = cm * 64;
    qtok = b * SEQ + qb * 128 + g4 * 32 + r32;
    Qp = (const bf16_t*)(p.ws + OFF_AQK) + (size_t)qtok * 1024 + h * 128 + cm * 64;
    Kb = (const bf16_t*)(p.ws + OFF_AQK) + 512 + h * 128; Vb = (const bf16_t*)(p.ws + OFF_AV) + h * 128; ldkv = 0;
    NT = 64; tfirst = 0;
  } else if (MODE == 1) {
    b = u / 192; int rem = u % 192; h = rem / 48; rem %= 48; g = rem / 16; const int uu = rem % 16;
    rr = (g == 0) ? 1 : (g == 1 ? 4 : 16); Lsub = SEQ / rr; mres = uu % rr; blk = uu / rr;
    const int qn = blk * 256 + wid * 32 + r32;
    qtok = b * SEQ + qn * rr + mres;
    Qp = (const bf16_t*)(p.ws + OFF_BQ) + (size_t)qtok * 768 + g * 256 + h * 64;
    Kb = (const bf16_t*)(p.ws + OFF_BK) + g * 256 + h * 64; Vb = (const bf16_t*)(p.ws + OFF_BV) + g * 256 + h * 64; ldkv = 768;
    tfirst = (blk == 0) ? 1 : 0; int tl = (Lsub - (blk * 256 - 64)) / 64 - 1; if (tl > 5) tl = 5; NT = tl + 1;
  } else {
    b = u >> 6; h = (u >> 4) & 3; r0 = (u & 15) * 4;
    qrow = r0 + (wid >> 1); qcol = (wid & 1) * 32 + r32;
    qtok = b * SEQ + qrow * 64 + qcol;
    Qp = (const bf16_t*)(p.ws + OFF_C) + (size_t)qtok * 768 + h * 64;
    Kb = (const bf16_t*)(p.ws + OFF_C) + 256 + h * 64; Vb = (const bf16_t*)(p.ws + OFF_C) + 512 + h * 64; ldkv = 768;
    row_lo = r0 - 4; if (row_lo < 0) row_lo = 0; if (row_lo > 56) row_lo = 56;
    int rl3 = r0 + 3 - 4; if (rl3 < 0) rl3 = 0; if (rl3 > 56) rl3 = 56;
    NT = rl3 + 8 - row_lo; tfirst = 0;
    rs = qrow - 4; if (rs < 0) rs = 0; if (rs > 56) rs = 56;
    cs = qcol - 8; if (cs < 0) cs = 0; if (cs > 48) cs = 48;
    const float* rp = p.rpb + ((size_t)layer * 4 + h) * 465;
    if (tid < 465) rpb_l[tid] = rp[tid] * (1.0f / SCALE);
  }
  (void)ldkv;

  bf16x8 qr[4];
#pragma unroll
  for (int d0 = 0; d0 < 4; ++d0) qr[d0] = *(const bf16x8*)(Qp + d0 * 16 + hi * 8);

  bf16x8 st0, st1, st2, st3;
  auto key_tok = [&](int t, int i) -> int {
    if (MODE == 0) return b * SEQ + t * 64 + i;
    if (MODE == 1) return b * SEQ + (blk * 256 - 64 + 64 * t + i) * rr + mres;
    return b * SEQ + (row_lo + t) * 64 + i;
  };
  auto sload = [&](int t) {
    if (MODE == 0) {
      const int sr = tid >> 4, sc = (tid & 15) * 8;
      const size_t k0 = (size_t)key_tok(t, sr), k1 = (size_t)key_tok(t, 32 + sr);
      st0 = *(const bf16x8*)(Vb + k0 * 512 + sc); st1 = *(const bf16x8*)(Vb + k1 * 512 + sc);
      st2 = *(const bf16x8*)(Kb + k0 * 1024 + sc); st3 = *(const bf16x8*)(Kb + k1 * 1024 + sc);
    } else {
      const int sr = tid >> 3, sc = (tid & 7) * 8;
      const size_t k0 = (size_t)key_tok(t, sr);
      st0 = *(const bf16x8*)(Vb + k0 * 768 + sc); st2 = *(const bf16x8*)(Kb + k0 * 768 + sc);
    }
  };
  auto swrite = [&](int buf) {
    if (MODE == 0) {
      const int sr = tid >> 4, sc = (tid & 15) * 8;
      *(bf16x8*)(V_lds + buf * TB + v_st<128>(sr, sc)) = st0; *(bf16x8*)(V_lds + buf * TB + v_st<128>(32 + sr, sc)) = st1;
      *(bf16x8*)(K_lds + buf * TB + KSWZ_A(sr, sc * 2)) = st2; *(bf16x8*)(K_lds + buf * TB + KSWZ_A(32 + sr, sc * 2)) = st3;
    } else {
      const int sr = tid >> 3, sc = (tid & 7) * 8;
      *(bf16x8*)(V_lds + buf * TB + v_st<64>(sr, sc)) = st0;
      *(bf16x8*)(K_lds + buf * TB + KSWZ_S(sr, sc * 2)) = st2;
    }
  };

  float m_reg = -1e30f, l_reg = 0.f;
  f32x16 o[ND];
#pragma unroll
  for (int d = 0; d < ND; ++d) o[d] = f32x16{};
  const int vb0 = (int)(uintptr_t)V_lds + v_rd_base(lane);

  sload(tfirst); swrite(0);
  __syncthreads();
  for (int t = tfirst, it = 0; t < NT; ++t, ++it) {
    const int buf = it & 1;
    const bool more = (t + 1 < NT);
    if (more) sload(t + 1);
    bool active = true;
    if (MODE == 1) { const int tn0 = blk * 256 - 64 + 64 * t, qa = blk * 256 + wid * 32; active = (tn0 + 63 >= qa - 64) && (tn0 <= qa + 31 + 64); }
    if (MODE == 2) { const int kr = row_lo + t; active = (kr >= rs) && (kr < rs + 8); }
    if (active) {
      f32x16 p0 = f32x16{}, p1 = f32x16{};
      const char* Kt = K_lds + buf * TB;
#pragma unroll
      for (int d0 = 0; d0 < 4; ++d0) {
        const int cb = (coff + d0 * 16 + hi * 8) * 2;
        bf16x8 b0, b1;
        if (MODE == 0) { b0 = *(const bf16x8*)(Kt + KSWZ_A(r32, cb)); b1 = *(const bf16x8*)(Kt + KSWZ_A(32 + r32, cb)); }
        else { b0 = *(const bf16x8*)(Kt + KSWZ_S(r32, cb)); b1 = *(const bf16x8*)(Kt + KSWZ_S(32 + r32, cb)); }
        p0 = __builtin_amdgcn_mfma_f32_32x32x16_bf16(b0, qr[d0], p0, 0, 0, 0);
        p1 = __builtin_amdgcn_mfma_f32_32x32x16_bf16(b1, qr[d0], p1, 0, 0, 0);
      }
      if (MODE == 1) {
        const int tn0 = blk * 256 - 64 + 64 * t, qn = blk * 256 + wid * 32 + r32;
#pragma unroll
        for (int r = 0; r < 16; ++r) {
          const int d0k = tn0 + crow(r, hi) - qn, d1k = d0k + 32;
          if (d0k > 64 || d0k < -64) p0[r] = -INFINITY;
          if (d1k > 64 || d1k < -64) p1[r] = -INFINITY;
        }
      }
      if (MODE == 2) {
        const int kr = row_lo + t; const int rb = (kr - qrow + 7) * 31;
#pragma unroll
        for (int r = 0; r < 16; ++r) {
          const int kc0 = crow(r, hi), kc1 = kc0 + 32;
          int dc0 = kc0 - qcol + 15, dc1 = kc1 - qcol + 15;
          dc0 = dc0 < 0 ? 0 : (dc0 > 30 ? 30 : dc0); dc1 = dc1 < 0 ? 0 : (dc1 > 30 ? 30 : dc1);
          const float b0 = rpb_l[rb + dc0], b1 = rpb_l[rb + dc1];
          p0[r] = (kc0 >= cs && kc0 < cs + 16) ? p0[r] + b0 : -INFINITY;
          p1[r] = (kc1 >= cs && kc1 < cs + 16) ? p1[r] + b1 : -INFINITY;
        }
      }
      float pmax = p0[0];
#pragma unroll
      for (int r = 1; r < 16; ++r) pmax = fmaxf(pmax, p0[r]);
#pragma unroll
      for (int r = 0; r < 16; ++r) pmax = fmaxf(pmax, p1[r]);
      { auto sw = __builtin_amdgcn_permlane32_swap(__float_as_uint(pmax), __float_as_uint(pmax), false, false);
        pmax = fmaxf(__uint_as_float(sw[0]), __uint_as_float(sw[1])); }
      float mn, alpha;
      if (__all(pmax - m_reg <= THRRAW)) { mn = m_reg; alpha = 1.f; }
      else { mn = fmaxf(m_reg, pmax); alpha = __builtin_amdgcn_exp2f((m_reg - mn) * C); m_reg = mn; }
      const float mnC = -mn * C;
      float ps = 0.f;
#pragma unroll
      for (int r = 0; r < 16; ++r) { p0[r] = __builtin_amdgcn_exp2f(fmaf(p0[r], C, mnC)); ps += p0[r]; }
#pragma unroll
      for (int r = 0; r < 16; ++r) { p1[r] = __builtin_amdgcn_exp2f(fmaf(p1[r], C, mnC)); ps += p1[r]; }
      { auto sw = __builtin_amdgcn_permlane32_swap(__float_as_uint(ps), __float_as_uint(ps), false, false);
        ps = __uint_as_float(sw[0]) + __uint_as_float(sw[1]); }
      l_reg = l_reg * alpha + ps;
      bf16x8 pa0, pa1, pa2, pa3;
#define PK4(P, BASE, OUT) do { unsigned a0 = cvtpk(P[BASE + 0], P[BASE + 1]), a1 = cvtpk(P[BASE + 2], P[BASE + 3]); \
    unsigned b0_ = cvtpk(P[BASE + 4], P[BASE + 5]), b1_ = cvtpk(P[BASE + 6], P[BASE + 7]); \
    auto r0_ = __builtin_amdgcn_permlane32_swap(a0, b0_, false, false); auto r1_ = __builtin_amdgcn_permlane32_swap(a1, b1_, false, false); \
    u32x4 w_ = {r0_[0], r1_[0], r0_[1], r1_[1]}; OUT = *reinterpret_cast<bf16x8*>(&w_); } while (0)
      PK4(p0, 0, pa0); PK4(p0, 8, pa1); PK4(p1, 0, pa2); PK4(p1, 8, pa3);
#undef PK4
      if (__any(alpha < 1.f)) {
        if (hi == 0) al_l[r32] = alpha;
        asm volatile("s_waitcnt lgkmcnt(0)" ::: "memory");
        float af[16];
#pragma unroll
        for (int r = 0; r < 16; ++r) af[r] = al_l[crow(r, hi)];
#pragma unroll
        for (int d = 0; d < ND; ++d)
#pragma unroll
          for (int r = 0; r < 16; ++r) o[d][r] *= af[r];
      }
      const int vb = vb0 + buf * TB;
      pv_one<DV, 0>(o[0], vb, pa0, pa1, pa2, pa3);
      pv_one<DV, 1>(o[1], vb, pa0, pa1, pa2, pa3);
      if (DV == 128) { pv_one<DV, 2>(o[ND - 2], vb, pa0, pa1, pa2, pa3); pv_one<DV, 3>(o[ND - 1], vb, pa0, pa1, pa2, pa3); }
    }
    if (more) swrite(buf ^ 1);
    __syncthreads();
  }

  if (hi == 0) li_l[r32] = l_reg;
  asm volatile("s_waitcnt lgkmcnt(0)" ::: "memory");
  float rli[16];
#pragma unroll
  for (int r = 0; r < 16; ++r) rli[r] = 1.0f / li_l[crow(r, hi)];
  const int qtok0 = __shfl(qtok, 0);
  if (MODE == 0) {
    const int g4 = wid >> 1, cm = wid & 1;
    float* X = (float*)smem + g4 * 4096;
    const float lam = ((const float*)(p.ws + OFF_LAM))[layer];
    if (cm == 1) {
#pragma unroll
      for (int d = 0; d < ND; ++d)
#pragma unroll
        for (int r = 0; r < 16; ++r) X[crow(r, hi) * 128 + d * 32 + r32] = -lam * o[d][r] * rli[r];
    }
    __syncthreads();
    if (cm == 0) {
      float ss[16];
#pragma unroll
      for (int r = 0; r < 16; ++r) ss[r] = 0.f;
#pragma unroll
      for (int d = 0; d < ND; ++d)
#pragma unroll
        for (int r = 0; r < 16; ++r) { const float dv = o[d][r] * rli[r] + X[crow(r, hi) * 128 + d * 32 + r32]; o[d][r] = dv; ss[r] += dv * dv; }
#pragma unroll
      for (int r = 0; r < 16; ++r) {
        float s = ss[r];
        s += __shfl_xor(s, 1); s += __shfl_xor(s, 2); s += __shfl_xor(s, 4); s += __shfl_xor(s, 8); s += __shfl_xor(s, 16);
        const float li = 0.8f - 0.6f * __expf(-0.3f * (float)layer);
        ss[r] = rsqrtf(s * (1.0f / 128.0f) + RMS_EPS) * (1.0f - li);
      }
      const bf16_t* Z = (const bf16_t*)(p.ws + OFF_Z); bf16_t* Y = (bf16_t*)(p.ws + OFF_Y);
#pragma unroll
      for (int d = 0; d < ND; ++d) {
        const float gn = p.subln[layer * 128 + d * 32 + r32];
#pragma unroll
        for (int r = 0; r < 16; ++r) {
          const size_t idx = (size_t)(qtok0 + crow(r, hi)) * 1024 + h * 128 + d * 32 + r32;
          const float y = o[d][r] * ss[r] * gn * siluf(bf2f(Z[idx]));
          Y[idx] = (bf16_t)(cvtpk(y, y) & 0xffffu);
        }
      }
    }
  } else if (MODE == 1) {
    bf16_t* OB = (bf16_t*)(p.ws + OFF_BQ);
    float* LSE = (float*)(p.ws + OFF_LSE);
    const int tokw = b * SEQ + (blk * 256 + wid * 32) * rr + mres;
#pragma unroll
    for (int d = 0; d < ND; ++d)
#pragma unroll
      for (int r = 0; r < 16; ++r) {
        const size_t idx = (size_t)(tokw + crow(r, hi) * rr) * 768 + g * 256 + h * 64 + d * 32 + r32;
        const float y = o[d][r] * rli[r];
        OB[idx] = (bf16_t)(cvtpk(y, y) & 0xffffu);
      }
    if (hi == 0) LSE[((size_t)g * T + qtok) * 4 + h] = m_reg * SCALE + __logf(l_reg);
  } else {
    const bf16_t* Z = (const bf16_t*)(p.ws + OFF_Z); bf16_t* Y = (bf16_t*)(p.ws + OFF_Y);
#pragma unroll
    for (int d = 0; d < ND; ++d)
#pragma unroll
      for (int r = 0; r < 16; ++r) {
        const size_t idx = (size_t)(qtok0 + crow(r, hi)) * 1024 + 768 + h * 64 + d * 32 + r32;
        const float y = o[d][r] * rli[r] * siluf(bf2f(Z[idx]));
        Y[idx] = (bf16_t)(cvtpk(y, y) & 0xffffu);
      }
  }
  __syncthreads();
}

DEV void smA_partial(f32x16& p0, f32x16& p1, float& m_reg, float& alpha) {
  constexpr float C = SCALE * 1.4426950408889634f; constexpr float THRRAW = 8.0f / SCALE;
  float pmax = p0[0];
#pragma unroll
  for (int r = 1; r < 16; ++r) pmax = fmaxf(pmax, p0[r]);
#pragma unroll
  for (int r = 0; r < 16; ++r) pmax = fmaxf(pmax, p1[r]);
  { auto sw = __builtin_amdgcn_permlane32_swap(__float_as_uint(pmax), __float_as_uint(pmax), false, false);
    pmax = fmaxf(__uint_as_float(sw[0]), __uint_as_float(sw[1])); }
  float mn;
  if (__builtin_expect(__all(pmax - m_reg <= THRRAW), 1)) { mn = m_reg; alpha = 1.f; }
  else { mn = fmaxf(m_reg, pmax); alpha = __builtin_amdgcn_exp2f((m_reg - mn) * C); m_reg = mn; }
  const float mnC = -mn * C;
#pragma unroll
  for (int r = 0; r < 16; ++r) p0[r] = fmaf(p0[r], C, mnC);
#pragma unroll
  for (int r = 0; r < 16; ++r) p1[r] = fmaf(p1[r], C, mnC);
#pragma unroll
  for (int r = 0; r < 16; ++r) p0[r] = __builtin_amdgcn_exp2f(p0[r]);
}
DEV void smA_finish(f32x16& p0, f32x16& p1, float alpha, float& l_reg, bf16x8& pa0, bf16x8& pa1, bf16x8& pa2, bf16x8& pa3) {
#pragma unroll
  for (int r = 0; r < 16; ++r) p1[r] = __builtin_amdgcn_exp2f(p1[r]);
  float ps = 0.f;
#pragma unroll
  for (int r = 0; r < 16; ++r) ps += p0[r];
#pragma unroll
  for (int r = 0; r < 16; ++r) ps += p1[r];
  { auto sw = __builtin_amdgcn_permlane32_swap(__float_as_uint(ps), __float_as_uint(ps), false, false);
    ps = __uint_as_float(sw[0]) + __uint_as_float(sw[1]); }
  l_reg = l_reg * alpha + ps;
#define PK4(P, BASE, OUT) do { unsigned a0 = cvtpk(P[BASE + 0], P[BASE + 1]), a1 = cvtpk(P[BASE + 2], P[BASE + 3]); \
    unsigned b0_ = cvtpk(P[BASE + 4], P[BASE + 5]), b1_ = cvtpk(P[BASE + 6], P[BASE + 7]); \
    auto r0_ = __builtin_amdgcn_permlane32_swap(a0, b0_, false, false); auto r1_ = __builtin_amdgcn_permlane32_swap(a1, b1_, false, false); \
    u32x4 w_ = {r0_[0], r1_[0], r0_[1], r1_[1]}; OUT = *reinterpret_cast<bf16x8*>(&w_); } while (0)
  PK4(p0, 0, pa0); PK4(p0, 8, pa1); PK4(p1, 0, pa2); PK4(p1, 8, pa3);
#undef PK4
}

DEV void attn_unit_A(const Params& p, int layer, int u) {
  constexpr int TB = 16384;
  const int tid = ltid(), wid = tid >> 6, lane = tid & 63, r32 = lane & 31, hi = lane >> 5;
  char* V_lds = smem; char* K_lds = smem + 2 * TB;
  float* wsc = (float*)(smem + 131072) + wid * 64; float* li_l = wsc; float* al_l = wsc + 32;
  const int pair = ((u & 7) << 1) | (u >> 8), qb = (u >> 3) & 31, b = pair >> 2, h = pair & 3;
  const int g4 = wid >> 1, cm = wid & 1, coff = cm * 64;
  const int qtok = b * SEQ + qb * 128 + g4 * 32 + r32;
  const bf16_t* Qp = (const bf16_t*)(p.ws + OFF_AQK) + (size_t)qtok * 1024 + h * 128 + cm * 64;
  const int sr = tid >> 4, sc = (tid & 15) * 8;
  const bf16_t* Kt0 = (const bf16_t*)(p.ws + OFF_AQK) + (size_t)(b * SEQ + sr) * 1024 + 512 + h * 128 + sc;
  const bf16_t* Vt0 = (const bf16_t*)(p.ws + OFF_AV) + (size_t)(b * SEQ + sr) * 512 + h * 128 + sc;
  constexpr int NT = 64;
  bf16x8 qr[4];
#pragma unroll
  for (int d0 = 0; d0 < 4; ++d0) qr[d0] = *(const bf16x8*)(Qp + d0 * 16 + hi * 8);
  const int vst0 = v_st<128>(sr, sc), vst1 = v_st<128>(32 + sr, sc), kst0 = KSWZ_A(sr, sc * 2), kst1 = KSWZ_A(32 + sr, sc * 2);
  const int vb0 = (int)(uintptr_t)V_lds + v_rd_base(lane);
  bf16x8 sv0, sv1, sk0, sk1;
#define SLOAD(t) do { sv0 = *(const bf16x8*)(Vt0 + (size_t)(t) * 64 * 512); sv1 = *(const bf16x8*)(Vt0 + (size_t)((t) * 64 + 32) * 512); \
    sk0 = *(const bf16x8*)(Kt0 + (size_t)(t) * 64 * 1024); sk1 = *(const bf16x8*)(Kt0 + (size_t)((t) * 64 + 32) * 1024); } while (0)
#define SWRITE(bf) do { *(bf16x8*)(V_lds + (bf) * TB + vst0) = sv0; *(bf16x8*)(V_lds + (bf) * TB + vst1) = sv1; \
    *(bf16x8*)(K_lds + (bf) * TB + kst0) = sk0; *(bf16x8*)(K_lds + (bf) * TB + kst1) = sk1; } while (0)
#define SBAR() __builtin_amdgcn_sched_barrier(0)
#define QKT(P0, P1, bf) do { P0 = f32x16{}; P1 = f32x16{}; const char* Kt_ = K_lds + (bf) * TB; _Pragma("unroll") for (int d0 = 0; d0 < 4; ++d0) { const int cb = (coff + d0 * 16 + hi * 8) * 2; \
    const bf16x8 b0 = *(const bf16x8*)(Kt_ + KSWZ_A(r32, cb)); const bf16x8 b1 = *(const bf16x8*)(Kt_ + KSWZ_A(32 + r32, cb)); \
    P0 = __builtin_amdgcn_mfma_f32_32x32x16_bf16(b0, qr[d0], P0, 0, 0, 0); P1 = __builtin_amdgcn_mfma_f32_32x32x16_bf16(b1, qr[d0], P1, 0, 0, 0); } } while (0)
#define PVD(bf) do { const int vb_ = vb0 + (bf) * TB; pv_one<128, 0>(o[0], vb_, pa0, pa1, pa2, pa3); pv_one<128, 1>(o[1], vb_, pa0, pa1, pa2, pa3); \
    pv_one<128, 2>(o[2], vb_, pa0, pa1, pa2, pa3); pv_one<128, 3>(o[3], vb_, pa0, pa1, pa2, pa3); } while (0)
#define RESC(a) do { if (__any((a) < 1.f)) { if (hi == 0) al_l[r32] = (a); asm volatile("s_waitcnt lgkmcnt(0)" ::: "memory"); \
    _Pragma("unroll") for (int r = 0; r < 16; ++r) { const float af_ = al_l[crow(r, hi)]; o[0][r] *= af_; o[1][r] *= af_; o[2][r] *= af_; o[3][r] *= af_; } } } while (0)
  float m_reg = -1e30f, l_reg = 0.f;
  f32x16 o[4] = {f32x16{}, f32x16{}, f32x16{}, f32x16{}};
  f32x16 pA0, pA1, pB0, pB1; float alA, alB; bf16x8 pa0, pa1, pa2, pa3;
  SLOAD(0); SWRITE(0); __syncthreads();
  QKT(pA0, pA1, 0); smA_partial(pA0, pA1, m_reg, alA);
  SLOAD(1); SWRITE(1); __syncthreads();
  for (int j = 1; j + 1 < NT; j += 2) {
    SBAR(); QKT(pB0, pB1, 1);
    smA_finish(pA0, pA1, alA, l_reg, pa0, pa1, pa2, pa3); SBAR();
    SLOAD(j + 1); SBAR();
    PVD(0); smA_partial(pB0, pB1, m_reg, alB);
    __syncthreads(); SWRITE(0);
    RESC(alB); __syncthreads();
    SBAR(); QKT(pA0, pA1, 0);
    smA_finish(pB0, pB1, alB, l_reg, pa0, pa1, pa2, pa3); SBAR();
    SLOAD(j + 2); SBAR();
    PVD(1); smA_partial(pA0, pA1, m_reg, alA);
    __syncthreads(); SWRITE(1);
    RESC(alA); __syncthreads();
  }
  SBAR(); QKT(pB0, pB1, 1);
  smA_finish(pA0, pA1, alA, l_reg, pa0, pa1, pa2, pa3); SBAR();
  PVD(0); smA_partial(pB0, pB1, m_reg, alB);
  __syncthreads(); RESC(alB);
  smA_finish(pB0, pB1, alB, l_reg, pa0, pa1, pa2, pa3); SBAR();
  PVD(1);
#undef SLOAD
#undef SWRITE
#undef QKT
#undef PVD
#undef RESC
  __syncthreads();
  if (hi == 0) li_l[r32] = l_reg;
  asm volatile("s_waitcnt lgkmcnt(0)" ::: "memory");
  float rli[16];
#pragma unroll
  for (int r = 0; r < 16; ++r) rli[r] = 1.0f / li_l[crow(r, hi)];
  const int qtok0 = b * SEQ + qb * 128 + g4 * 32;
  float* X = (float*)smem + g4 * 4096;
  const float lam = ((const float*)(p.ws + OFF_LAM))[layer];
  if (cm == 1) {
#pragma unroll
    for (int d = 0; d < 4; ++d)
#pragma unroll
      for (int r = 0; r < 16; ++r) X[crow(r, hi) * 128 + d * 32 + r32] = -lam * o[d][r] * rli[r];
  }
  __syncthreads();
  if (cm == 0) {
    float ss[16];
#pragma unroll
    for (int r = 0; r < 16; ++r) ss[r] = 0.f;
#pragma unroll
    for (int d = 0; d < 4; ++d)
#pragma unroll
      for (int r = 0; r < 16; ++r) { const float dv = o[d][r] * rli[r] + X[crow(r, hi) * 128 + d * 32 + r32]; o[d][r] = dv; ss[r] += dv * dv; }
    const float li = 0.8f - 0.6f * __expf(-0.3f * (float)layer);
#pragma unroll
    for (int r = 0; r < 16; ++r) {
      float s = ss[r];
      s += __shfl_xor(s, 1); s += __shfl_xor(s, 2); s += __shfl_xor(s, 4); s += __shfl_xor(s, 8); s += __shfl_xor(s, 16);
      ss[r] = rsqrtf(s * (1.0f / 128.0f) + RMS_EPS) * (1.0f - li);
    }
    const bf16_t* Z = (const bf16_t*)(p.ws + OFF_Z); bf16_t* Y = (bf16_t*)(p.ws + OFF_Y);
#pragma unroll
    for (int d = 0; d < 4; ++d) {
      const float gn = p.subln[layer * 128 + d * 32 + r32];
#pragma unroll
      for (int r = 0; r < 16; ++r) {
        const size_t idx = (size_t)(qtok0 + crow(r, hi)) * 1024 + h * 128 + d * 32 + r32;
        const float y = o[d][r] * ss[r] * gn * siluf(bf2f(Z[idx]));
        Y[idx] = (bf16_t)(cvtpk(y, y) & 0xffffu);
      }
    }
  }
  __syncthreads();
}

DEV void phase_attn(const Params& p, int layer) {
  for (int u = blockIdx.x; u < 512; u += gridDim.x) attn_unit_A(p, layer, u);
  for (int u = blockIdx.x; u < 768; u += gridDim.x) attn_unit<1>(p, layer, u);
  for (int u = blockIdx.x; u < 256; u += gridDim.x) attn_unit<2>(p, layer, u);
}

__global__ void __launch_bounds__(512, 1) mk_forward(Params p) {
  cg::grid_group grid = cg::this_grid();
  unsigned* bar = (unsigned*)(p.ws + OFF_BAR);
  volatile LAS unsigned* st = (volatile LAS unsigned*)(LAS unsigned*)(smem + 131072 + 3968);
  if (threadIdx.x == 0) { st[0] = 0u; st[1] = 0u; }
  if (blockIdx.x == 0) for (int i = threadIdx.x; i < XCD_BAR_WORDS; i += 512) __hip_atomic_store(bar + i, 0u, __ATOMIC_RELAXED, __HIP_MEMORY_SCOPE_AGENT);
  phase0(p);
  grid.sync();
  XcdBarrier xb = xcd_barrier_post(bar, st);
#pragma unroll 1
  for (int layer = 0; layer < 2; ++layer) {
    const float* xin = layer == 0 ? p.x : p.out;
    phase_norm(p, layer, xin);
    xcd_barrier(xb);
    phase_inproj(p);
    xcd_barrier(xb);
    phase_attn(p, layer);
    xcd_barrier(xb);
    phase_gates(p);
    xcd_barrier(xb);
    phase_merge(p, layer);
    xcd_barrier(xb);
    phase_out(p, layer, xin);
    xcd_barrier(xb);
  }
  phase_final(p);
}

extern "C" void kernel_launch(void* const* d_in, const int* in_sizes, int n_in, void* d_out, int out_size, void* d_ws, size_t ws_size, hipStream_t stream) {
  static int grid_blocks = 0;
  if (ws_size < WS_NEED) { fprintf(stderr, "kernel_launch: workspace too small: %zu < %zu\n", ws_size, WS_NEED); return; }
  if (!grid_blocks) {
    int dev = 0, cus = 0, per_cu = 0;
    hipGetDevice(&dev);
    hipDeviceGetAttribute(&cus, hipDeviceAttributeMultiprocessorCount, dev);
    if (hipFuncSetAttribute((const void*)mk_forward, hipFuncAttributeMaxDynamicSharedMemorySize, LDS_BYTES) != hipSuccess) { fprintf(stderr, "kernel_launch: LDS attribute failed\n"); return; }
    hipOccupancyMaxActiveBlocksPerMultiprocessor(&per_cu, mk_forward, 512, LDS_BYTES);
    if (per_cu < 1) { fprintf(stderr, "kernel_launch: occupancy 0\n"); return; }
    grid_blocks = cus;
  }
  Params p{};
  p.x = (const float*)d_in[0]; p.c = (const float*)d_in[1]; p.pos = (const int*)d_in[2]; p.norm_gain = (const float*)d_in[3];
  p.w_ada = (const float*)d_in[4]; p.b_ada = (const float*)d_in[5]; p.w_in = (const float*)d_in[6]; p.diff_lambda = (const float*)d_in[7];
  p.subln = (const float*)d_in[8]; p.rpb = (const float*)d_in[9]; p.w_branch = (const float*)d_in[10]; p.w_out = (const float*)d_in[11];
  p.final_gain = (const float*)d_in[12]; p.out = (float*)d_out; p.ws = (char*)d_ws;
  void* args[] = {&p};
  hipError_t e = hipLaunchCooperativeKernel((void*)mk_forward, dim3(grid_blocks), dim3(512), args, LDS_BYTES, stream);
  if (e != hipSuccess) fprintf(stderr, "cooperative launch failed: %s (grid %d)\n", hipGetErrorString(e), grid_blocks);
}
```

```cpp
#include <hip/hip_runtime.h>
#include <hip/hip_cooperative_groups.h>
#include <cstdio>
#include <cstdint>
namespace cg = cooperative_groups;

#ifndef INPROJ_SKEW_TICKS
#define INPROJ_SKEW_TICKS 1500ull
#endif
#ifndef PROBE_SEG
#define PROBE_SEG 0
#endif
#ifndef PROBE_DBL
#define PROBE_DBL 0
#endif
#ifndef MK_MULTI
#define MK_MULTI 0
#endif

typedef unsigned short bf16_t;
typedef short bf16x8 __attribute__((ext_vector_type(8)));
typedef short s16x4 __attribute__((ext_vector_type(4)));
typedef float f32x4 __attribute__((ext_vector_type(4)));
typedef float f32x2 __attribute__((ext_vector_type(2)));
typedef float f32x16 __attribute__((ext_vector_type(16)));
typedef unsigned u32x4 __attribute__((ext_vector_type(4)));
typedef unsigned u32x2 __attribute__((ext_vector_type(2)));
#define DEV __device__ __forceinline__

constexpr int T = 16384, SEQ = 4096, DM = 1024, NB = 4;
constexpr int IN_COLS = 8704;
constexpr float RMS_EPS = 1e-6f;
constexpr float SCALE = 0.125f;

constexpr size_t SZ_T1024 = (size_t)T * 1024 * 2;
constexpr size_t OFF_AQK = 0;
constexpr size_t OFF_AK = OFF_AQK + (size_t)T * 512 * 2;
constexpr size_t OFF_AV = OFF_AQK + SZ_T1024;
constexpr size_t OFF_BK = OFF_AV + (size_t)T * 512 * 2;
constexpr size_t OFF_BV = OFF_BK + (size_t)T * 768 * 2;
constexpr size_t OFF_C = OFF_BV + (size_t)T * 768 * 2;
constexpr size_t OFF_BQ = OFF_C + (size_t)T * 768 * 2;
constexpr size_t OFF_Z = OFF_BQ + (size_t)T * 768 * 2;
constexpr size_t OFF_H = OFF_Z + SZ_T1024;
constexpr size_t OFF_Y = OFF_H + SZ_T1024;
constexpr size_t OFF_WIN = OFF_Y + SZ_T1024;
constexpr size_t OFF_WBR = OFF_WIN + (size_t)IN_COLS * 1024 * 2;
constexpr size_t OFF_WOUT = OFF_WBR + (size_t)2 * 1024 * 1024 * 2;
constexpr size_t OFF_LSE = OFF_WOUT + (size_t)2 * 1024 * 1024 * 2;
constexpr size_t OFF_ROPE = OFF_LSE + (size_t)3 * T * 4 * 4;
constexpr size_t OFF_MOD = OFF_ROPE + (size_t)T * 8 * 8;
constexpr size_t OFF_LAM = OFF_MOD + (size_t)2 * 4 * 3072 * 4;
constexpr size_t OFF_BAR = OFF_LAM + 256;
constexpr size_t OFF_CNT = OFF_BAR + 3456 * 4;
constexpr size_t OFF_KMX = OFF_CNT + 256 * 4;
constexpr size_t WS_NEED = OFF_KMX + 128 * 4 + 8192;
constexpr size_t OFF_G = OFF_AQK;

constexpr int LDS_BYTES = 131072 + 4096;

struct Params {
  const float* x; const float* c; const int* pos; const float* norm_gain; const float* w_ada; const float* b_ada; const float* w_in;
  const float* diff_lambda; const float* subln; const float* rpb; const float* w_branch; const float* w_out; const float* final_gain;
  float* out; char* ws;
};

extern __shared__ __attribute__((aligned(16))) char smem[];

DEV unsigned cvtpk(float lo, float hi) { unsigned r; asm volatile("v_cvt_pk_bf16_f32 %0, %1, %2" : "=v"(r) : "v"(lo), "v"(hi)); return r; }
DEV unsigned cvtpk_t(float lo, float hi) { unsigned r; asm volatile("s_nop 1\n\tv_cvt_pk_bf16_f32 %0, %1, %2" : "=v"(r) : "v"(lo), "v"(hi)); return r; }
DEV float bflo(unsigned w) { return __uint_as_float(w << 16); }
DEV float bfhi(unsigned w) { return __uint_as_float(w & 0xffff0000u); }
DEV float bf2f(bf16_t v) { return __uint_as_float(((unsigned)v) << 16); }
DEV float sigmoidf(float x) { return __builtin_amdgcn_rcpf(1.0f + __expf(-x)); }
DEV float sig2(float t) { return __builtin_amdgcn_rcpf(1.0f + __builtin_amdgcn_exp2f(t)); }
DEV float siluf(float x) { return x * __builtin_amdgcn_rcpf(1.0f + __expf(-x)); }
DEV int perm32(int rho) { const int n = rho >> 4, i = rho & 15; return 8 * (i >> 2) + 4 * n + (i & 3); }
DEV int ltid() { int t = threadIdx.x; asm volatile("" : "+v"(t)); return t; }
DEV int lbid() { int t = blockIdx.x; asm volatile("" : "+s"(t)); return t; }
DEV int crow(int r, int hi) { return (r & 3) + 8 * (r >> 2) + 4 * hi; }

#define XB_TMO      128
#define XB_XCNT(j)  (256  + 64 * (j))
#define XB_XSUB(j)  (1280 + 64 * (j))
#define XB_XGEN(j)  (2304 + 64 * (j))
#define XB_TOP      3328
#define XB_TOPGEN   3392
#define XCD_BAR_WORDS 3456
#define XB_SPIN_CAP (1u << 18)
#define LAS __attribute__((address_space(3)))
DEV unsigned xb_ld(unsigned* p) { return __hip_atomic_load(p, __ATOMIC_RELAXED, __HIP_MEMORY_SCOPE_AGENT); }
DEV unsigned xb_add(unsigned* p, unsigned v) { return __hip_atomic_fetch_add(p, v, __ATOMIC_RELAXED, __HIP_MEMORY_SCOPE_AGENT); }
DEV unsigned xb_xcc_id() { return (unsigned)__builtin_amdgcn_s_getreg((3 << 11) | 20) & 0xFu; }
#define XB_SPIN(cond, bar) do { unsigned _sp = 0; while (cond) { __builtin_amdgcn_s_sleep(1); \
    if ((++_sp & 255u) == 0u) { if (xb_ld(&(bar)[XB_TMO])) break; if (_sp > XB_SPIN_CAP) { atomicAdd(&(bar)[XB_TMO], 1u); break; } } } } while (0)
struct XcdBarrier { unsigned* bar; unsigned x; volatile LAS unsigned* st; };
DEV XcdBarrier xcd_barrier_post(unsigned* bar, volatile LAS unsigned* st) {
  XcdBarrier b; b.bar = bar; b.x = xb_xcc_id(); b.st = st;
  if (threadIdx.x == 0) (void)xb_add(&bar[XB_XCNT(b.x)], 1u);
  return b;
}
DEV void xcd_barrier_complete(unsigned* bar, unsigned x, unsigned& nloc, unsigned& nx) {
  const unsigned G = gridDim.x * gridDim.y * gridDim.z;
  unsigned sum, cnt, mine, sp = 0u;
  for (;;) {
    sum = 0u; cnt = 0u; mine = 0u;
#pragma unroll
    for (unsigned j = 0; j < 16; ++j) { const unsigned c = xb_ld(&bar[XB_XCNT(j)]); sum += c; cnt += (c > 0u) ? 1u : 0u; mine = (j == x) ? c : mine; }
    if (sum == G) break;
    __builtin_amdgcn_s_sleep(1);
    if ((++sp & 255u) == 0u) { if (xb_ld(&bar[XB_TMO])) break; if (sp > XB_SPIN_CAP) { atomicAdd(&bar[XB_TMO], 1u); break; } }
  }
  nloc = mine > 0u ? mine : 1u; nx = cnt > 0u ? cnt : 1u;
}
DEV void xcd_barrier(const XcdBarrier& b) {
  asm volatile("s_waitcnt vmcnt(0)" ::: "memory");
  __syncthreads();
  if (threadIdx.x == 0) {
    size_t bz_ = 0; unsigned bx = b.x;
    asm volatile("" : "+s"(bz_), "+s"(bx));
    unsigned* bar = b.bar + bz_;
    __builtin_amdgcn_s_waitcnt(0);
    unsigned nloc = b.st[0], nx = b.st[1];
    if (nloc == 0u) { xcd_barrier_complete(bar, bx, nloc, nx); b.st[0] = nloc; b.st[1] = nx; }
    const unsigned old = xb_add(&bar[XB_XSUB(bx)], 1u);
    const unsigned gen = old / nloc;
    if (old + 1u == (gen + 1u) * nloc) {
      __builtin_amdgcn_fence(__ATOMIC_RELEASE, "agent");
      asm volatile("s_waitcnt vmcnt(0)" ::: "memory");
      const unsigned og = xb_add(&bar[XB_TOP], 1u);
      const unsigned tg = og / nx;
      if (og + 1u == (tg + 1u) * nx) xb_add(&bar[XB_TOPGEN], 1u);
      else XB_SPIN(xb_ld(&bar[XB_TOPGEN]) == tg, bar);
      __builtin_amdgcn_fence(__ATOMIC_ACQUIRE, "agent");
      xb_add(&bar[XB_XGEN(bx)], 1u);
      asm volatile("s_waitcnt vmcnt(0)" ::: "memory");
    } else {
      XB_SPIN(xb_ld(&bar[XB_XGEN(bx)]) == gen, bar);
      __builtin_amdgcn_fence(__ATOMIC_ACQUIRE, "agent");
      asm volatile("s_waitcnt vmcnt(0)" ::: "memory");
    }
  }
  __syncthreads();
}

DEV int win_src_col(int j) {
  const int c = (j & ~31) + perm32(j & 31);
  int orig; bool rope;
  if (c < 1024) { orig = c; rope = true; }
  else if (c < 1536) { orig = c; rope = false; }
  else if (c < 2304) { orig = 2304 + (c - 1536); rope = true; }
  else if (c < 3072) { orig = 3072 + (c - 2304); rope = false; }
  else if (c < 3840) { orig = 3840 + (c - 3072); rope = false; }
  else if (c < 4608) { orig = 1536 + (c - 3840); rope = true; }
  else { orig = c; rope = false; }
  if (rope) { int p = orig & 63; if (p < 16) { const int i = p >> 1; p = (p & 1) ? i + 8 : i; orig = (orig & ~63) + p; } }
  return orig;
}

struct CvtTile { const float* src; int ld; bf16_t* dst; int j0, k0, o0; bool win; };
DEV void cvt_decode(const Params& p, int layer, int t, CvtTile& c) {
  if (t < 2176) { const int kt = t & 15, nt = t >> 4; c.src = p.w_in + (size_t)layer * 1024 * IN_COLS; c.ld = IN_COLS; c.dst = (bf16_t*)(p.ws + OFF_WIN); c.j0 = nt * 64; c.k0 = kt * 64; c.o0 = win_src_col(c.j0) & ~63; c.win = true; }
  else { const int tt0 = t - 2176, mat = tt0 >> 8, tt = tt0 & 255, kt = tt & 15, nt = tt >> 4, l = mat & 1;
    c.src = (mat < 2 ? p.w_branch : p.w_out) + (size_t)l * 1024 * 1024; c.ld = 1024; c.dst = (bf16_t*)(p.ws + (mat < 2 ? OFF_WBR : OFF_WOUT)) + (size_t)l * 1024 * 1024; c.j0 = nt * 64; c.k0 = kt * 64; c.o0 = c.j0; c.win = false; }
}
DEV void cvt_range(const Params& p, int layer, int tbeg, int tend) {
  float* l = (float*)smem;
  const int tid = ltid();
  int t = tbeg + blockIdx.x;
  if (t >= tend) return;
  CvtTile c; cvt_decode(p, layer, t, c);
  f32x4 v0, v1;
  { const int kr = tid >> 4, c4 = (tid & 15) * 4;
    v0 = *(const f32x4*)(c.src + (size_t)(c.k0 + kr) * c.ld + c.o0 + c4); v1 = *(const f32x4*)(c.src + (size_t)(c.k0 + 32 + kr) * c.ld + c.o0 + c4); }
  for (;;) {
    { const int kr = tid >> 4, c4 = (tid & 15) * 4;
      l[kr * 65 + c4 + 0] = v0[0]; l[kr * 65 + c4 + 1] = v0[1]; l[kr * 65 + c4 + 2] = v0[2]; l[kr * 65 + c4 + 3] = v0[3];
      l[(kr + 32) * 65 + c4 + 0] = v1[0]; l[(kr + 32) * 65 + c4 + 1] = v1[1]; l[(kr + 32) * 65 + c4 + 2] = v1[2]; l[(kr + 32) * 65 + c4 + 3] = v1[3]; }
    __syncthreads();
    const int tn = t + gridDim.x; CvtTile cn;
    if (tn < tend) { cvt_decode(p, layer, tn, cn); const int kr = tid >> 4, c4 = (tid & 15) * 4;
      v0 = *(const f32x4*)(cn.src + (size_t)(cn.k0 + kr) * cn.ld + cn.o0 + c4); v1 = *(const f32x4*)(cn.src + (size_t)(cn.k0 + 32 + kr) * cn.ld + cn.o0 + c4); }
    const int jj = tid >> 3, kc = (tid & 7) * 8, j = c.j0 + jj;
    const int oc = (c.win ? win_src_col(j) : ((j & ~31) + perm32(j & 31))) - c.o0;
    const float ws_ = (c.win && j >= 5632) ? -1.4426950408889634f : 1.0f;
    u32x4 w;
    w[0] = cvtpk(l[(kc + 0) * 65 + oc] * ws_, l[(kc + 1) * 65 + oc] * ws_);
    w[1] = cvtpk(l[(kc + 2) * 65 + oc] * ws_, l[(kc + 3) * 65 + oc] * ws_);
    w[2] = cvtpk(l[(kc + 4) * 65 + oc] * ws_, l[(kc + 5) * 65 + oc] * ws_);
    w[3] = cvtpk(l[(kc + 6) * 65 + oc] * ws_, l[(kc + 7) * 65 + oc] * ws_);
    *(u32x4*)(c.dst + (size_t)j * 1024 + c.k0 + kc) = w;
    __syncthreads();
    if (tn >= tend) break;
    t = tn; c = cn;
  }
}
DEV void cvt_win_layer(const Params& p, int layer) { cvt_range(p, layer, 0, 2176); }

DEV void phase0(const Params& p_in) {
  Params p = p_in; { size_t z_ = 0; asm volatile("" : "+s"(z_)); p.ws = p_in.ws + z_; }
  const int tid = ltid();
  cvt_range(p, 0, 0, 3200);
  float* mod = (float*)(p.ws + OFF_MOD);
  if (blockIdx.x < 192) {
    float* cact = (float*)smem; float* l4 = (float*)(smem + 16384);
    for (int i = tid; i < 4096; i += 512) cact[i] = siluf(p.c[i]);
    __syncthreads();
    for (int it = blockIdx.x; it < 192; it += gridDim.x) {
      const int l = it / 96, j0 = (it % 96) * 32, w = tid >> 6, lane = tid & 63, cl = lane & 31, kh = w * 2 + (lane >> 5);
      const float* wa = p.w_ada + (size_t)l * 1024 * 3072 + j0 + cl;
      float a0 = 0.f, a1 = 0.f, a2 = 0.f, a3 = 0.f;
      for (int k = kh * 64; k < kh * 64 + 64; k += 16) {
        float wv[16];
#pragma unroll
        for (int q = 0; q < 16; ++q) wv[q] = wa[(size_t)(k + q) * 3072];
#pragma unroll
        for (int q = 0; q < 16; ++q) { a0 += cact[k + q] * wv[q]; a1 += cact[1024 + k + q] * wv[q]; a2 += cact[2048 + k + q] * wv[q]; a3 += cact[3072 + k + q] * wv[q]; }
      }
      l4[(kh * 4 + 0) * 32 + cl] = a0; l4[(kh * 4 + 1) * 32 + cl] = a1; l4[(kh * 4 + 2) * 32 + cl] = a2; l4[(kh * 4 + 3) * 32 + cl] = a3;
      __syncthreads();
      if (tid < 128) {
        const int b = tid >> 5, c2 = tid & 31; float s = 0.f;
        for (int q = 0; q < 16; ++q) s += l4[(q * 4 + b) * 32 + c2];
        mod[((size_t)l * 4 + b) * 3072 + j0 + c2] = s + p.b_ada[l * 3072 + j0 + c2];
      }
      __syncthreads();
    }
  }
  f32x2* rope = (f32x2*)(p.ws + OFF_ROPE);
  for (int i = blockIdx.x * 512 + tid; i < T * 8; i += gridDim.x * 512) {
    const int tok = i >> 3, fi = i & 7;
    float inv;
    switch (fi) { case 0: inv = 1.0f; break; case 1: inv = 0.1939227432012558f; break; case 2: inv = 0.03760603070259094f; break; case 3: inv = 0.007292664609849453f; break;
                  case 4: inv = 0.0014142135623842478f; break; case 5: inv = 0.00027424818836152554f; break; case 6: inv = 5.318296098266728e-05f; break; default: inv = 1.0313386155758053e-05f; break; }
    const float angf = (float)p.pos[tok] * inv;
    const double a = (double)angf;
    const double q = rint(a * 0.63661977236758134308);
    double r = fma(-q, 1.57079632679489655800, a); r = fma(-q, 6.12323399573676603587e-17, r);
    const int n = ((int)q) & 3;
    const double r2 = r * r;
    const double sn = r + r * r2 * (-1.0 / 6 + r2 * (1.0 / 120 + r2 * (-1.0 / 5040 + r2 * (1.0 / 362880 - r2 * (1.0 / 39916800)))));
    const double cs = 1.0 + r2 * (-0.5 + r2 * (1.0 / 24 + r2 * (-1.0 / 720 + r2 * (1.0 / 40320 + r2 * (-1.0 / 3628800 + r2 * (1.0 / 479001600))))));
    double co, si;
    if (n == 0) { co = cs; si = sn; } else if (n == 1) { co = -sn; si = cs; } else if (n == 2) { co = -cs; si = -sn; } else { co = sn; si = -cs; }
    rope[i] = (f32x2){(float)co, (float)si};
  }
  if (blockIdx.x == 0 && tid < 2) {
    const float* dl = p.diff_lambda + tid * 256;
    float s1 = 0.f, s2 = 0.f;
    for (int i = 0; i < 64; ++i) { s1 += dl[i] * dl[64 + i]; s2 += dl[128 + i] * dl[192 + i]; }
    const float li = 0.8f - 0.6f * expf(-0.3f * (float)tid);
    ((float*)(p.ws + OFF_LAM))[tid] = expf(s1) - expf(s2) + li;
  }
}

DEV void phase_norm(const Params& p_in, int layer, const float* __restrict__ xin) {
  Params p = p_in; { size_t z_ = 0; asm volatile("" : "+s"(z_)); p.ws = p_in.ws + z_; }
  const int tid_ = ltid(); const int wid = tid_ >> 6, lane = tid_ & 63;
  const float* mod = (const float*)(p.ws + OFF_MOD) + (size_t)layer * 4 * 3072;
  const float* gain = p.norm_gain + layer * 1024;
  bf16_t* H = (bf16_t*)(p.ws + OFF_H);
  for (int row = blockIdx.x * 8 + wid; row < T; row += gridDim.x * 16) {
    const int rowB = row + gridDim.x * 8; const bool hasB = rowB < T;
    const float* xr = xin + (size_t)row * 1024; const float* xrB = xin + (size_t)(hasB ? rowB : row) * 1024;
    f32x4 v[4], vB[4]; float ss = 0.f, ssB = 0.f;
#pragma unroll
    for (int i = 0; i < 4; ++i) { v[i] = *(const f32x4*)(xr + i * 256 + lane * 4); vB[i] = *(const f32x4*)(xrB + i * 256 + lane * 4); }
#pragma unroll
    for (int i = 0; i < 4; ++i) { ss += v[i][0] * v[i][0] + v[i][1] * v[i][1] + v[i][2] * v[i][2] + v[i][3] * v[i][3]; ssB += vB[i][0] * vB[i][0] + vB[i][1] * vB[i][1] + vB[i][2] * vB[i][2] + vB[i][3] * vB[i][3]; }
#pragma unroll
    for (int o = 32; o > 0; o >>= 1) { ss += __shfl_xor(ss, o); ssB += __shfl_xor(ssB, o); }
    const float rstd = rsqrtf(ss * (1.0f / 1024.0f) + RMS_EPS), rstdB = rsqrtf(ssB * (1.0f / 1024.0f) + RMS_EPS);
    const int b = row >> 12, bB = (hasB ? rowB : row) >> 12;
#pragma unroll
    for (int i = 0; i < 4; ++i) {
      const int c = i * 256 + lane * 4;
      const f32x4 g = *(const f32x4*)(gain + c);
      { const f32x4 sh = *(const f32x4*)(mod + b * 3072 + c), sc = *(const f32x4*)(mod + b * 3072 + 1024 + c);
        float h0 = v[i][0] * rstd * g[0] * (1.f + sc[0]) + sh[0], h1 = v[i][1] * rstd * g[1] * (1.f + sc[1]) + sh[1];
        float h2 = v[i][2] * rstd * g[2] * (1.f + sc[2]) + sh[2], h3 = v[i][3] * rstd * g[3] * (1.f + sc[3]) + sh[3];
        u32x2 w; w[0] = cvtpk(h0, h1); w[1] = cvtpk(h2, h3);
        *(u32x2*)(H + (size_t)row * 1024 + c) = w; }
      if (hasB) { const f32x4 sh = *(const f32x4*)(mod + bB * 3072 + c), sc = *(const f32x4*)(mod + bB * 3072 + 1024 + c);
        float h0 = vB[i][0] * rstdB * g[0] * (1.f + sc[0]) + sh[0], h1 = vB[i][1] * rstdB * g[1] * (1.f + sc[1]) + sh[1];
        float h2 = vB[i][2] * rstdB * g[2] * (1.f + sc[2]) + sh[2], h3 = vB[i][3] * rstdB * g[3] * (1.f + sc[3]) + sh[3];
        u32x2 w; w[0] = cvtpk(h0, h1); w[1] = cvtpk(h2, h3);
        *(u32x2*)(H + (size_t)rowB * 1024 + c) = w; }
    }
  }
}

DEV void phase_final(const Params& p_in) {
  Params p = p_in; { size_t z_ = 0; asm volatile("" : "+s"(z_)); p.ws = p_in.ws + z_; }
  const int tid_ = ltid(); const int wid = tid_ >> 6, lane = tid_ & 63;
  for (int row = blockIdx.x * 8 + wid; row < T; row += gridDim.x * 8) {
    float* xr = p.out + (size_t)row * 1024;
    f32x4 v[4]; float ss = 0.f;
#pragma unroll
    for (int i = 0; i < 4; ++i) { v[i] = *(const f32x4*)(xr + i * 256 + lane * 4); ss += v[i][0] * v[i][0] + v[i][1] * v[i][1] + v[i][2] * v[i][2] + v[i][3] * v[i][3]; }
#pragma unroll
    for (int o = 32; o > 0; o >>= 1) ss += __shfl_xor(ss, o);
    const float rstd = rsqrtf(ss * (1.0f / 1024.0f) + RMS_EPS);
#pragma unroll
    for (int i = 0; i < 4; ++i) {
      const int c = i * 256 + lane * 4;
      const f32x4 g = *(const f32x4*)(p.final_gain + c);
      f32x4 o; o[0] = v[i][0] * rstd * g[0]; o[1] = v[i][1] * rstd * g[1]; o[2] = v[i][2] * rstd * g[2]; o[3] = v[i][3] * rstd * g[3];
      *(f32x4*)(xr + c) = o;
    }
  }
}

constexpr int HALF = 128, BK = 64, HT = HALF * BK;
DEV int lds_byte(int r, int c) { const int st = (r >> 4) * 2 + (c >> 5), rr = r & 15, cc = c & 31, ob = rr * 64 + cc * 2; return st * 1024 + (ob ^ (((ob >> 9) & 1) << 5)); }
DEV void stage_rc(int b, int& R, int& C) { const int st = b / 1024, sb = b % 1024, swz = sb ^ (((sb >> 9) & 1) << 5); R = (st >> 1) * 16 + swz / 64; C = (st & 1) * 32 + (swz % 64) / 2; }

DEV bool gemm_next(int i, int nM, int nN, int& pm, int& pn) {
  const int nwg = nM * nN; const long L = (long)i * gridDim.x + blockIdx.x; if (L >= nwg) return false;
  int wgid = (int)L; { const int q = nwg / 8, r = nwg % 8, xcd = wgid % 8, off = wgid / 8; wgid = (xcd < r ? xcd * (q + 1) : r * (q + 1) + (xcd - r) * q) + off; }
  const int nig = 8 * nN, gid = wgid / nig, fm = gid * 8, gsz = (nM - fm) < 8 ? (nM - fm) : 8;
  pm = fm + ((wgid % nig) % gsz); pn = (wgid % nig) / gsz; return true;
}

struct GUnit { const char* a; const char* b; int nt, pm, pn, s; };
typedef __attribute__((address_space(3))) unsigned char LDSC;
template <class Next, class Epi>
DEV void gemm_stream(Next&& next, Epi&& epi) {
  LDSC* lds = (LDSC*)smem;
  const int tid = ltid(), wid = __builtin_amdgcn_readfirstlane(tid >> 6), lane = tid & 63, wr = wid >> 2, wc = wid & 3, fr = lane & 15, fq = lane >> 4;
  unsigned voff[2];
#pragma unroll
  for (int i = 0; i < 2; ++i) { int R, C; stage_rc(tid * 16 + i * 8192, R, C); voff[i] = (unsigned)(R * 1024 + C) * 2u; }
  constexpr size_t kstep = 128, hstep = (size_t)128 * 1024 * 2;
  constexpr int HTB = 128 * 64 * 2;
  const unsigned ldsw = (unsigned)wid * 1024u;
  const int aoff = lds_byte(wr * 64 + fr, fq * 8), boff = lds_byte(wc * 32 + fr, fq * 8);
#define G_SA(b, h) (((b) * 2 + (h)) * HTB)
#define G_SB(b, h) ((4 + (b) * 2 + (h)) * HTB)
#define G_STAGE(bufoff, gbase) do { _Pragma("unroll") for (int _i = 0; _i < 2; ++_i) \
    __builtin_amdgcn_global_load_lds((const unsigned*)((const char*)(gbase) + voff[_i]), (__attribute__((address_space(3))) unsigned*)(lds + (bufoff) + ldsw + _i * 8192), 16, 0, 0); } while (0)
#define G_LDA(dst, b, h) do { _Pragma("unroll") for (int m = 0; m < 4; ++m) _Pragma("unroll") for (int k = 0; k < 2; ++k) dst[m][k] = *(const __attribute__((address_space(3))) bf16x8*)(lds + G_SA(b, h) + aoff + m * 2048 + k * 1024); } while (0)
#define G_LDB(dst, b, h) do { _Pragma("unroll") for (int n = 0; n < 2; ++n) _Pragma("unroll") for (int k = 0; k < 2; ++k) dst[n][k] = *(const __attribute__((address_space(3))) bf16x8*)(lds + G_SB(b, h) + boff + n * 2048 + k * 1024); } while (0)
#define G_MMA(ai, bj, At, Bf) do { __builtin_amdgcn_s_setprio(1); _Pragma("unroll") for (int m = 0; m < 4; ++m) _Pragma("unroll") for (int n = 0; n < 2; ++n) _Pragma("unroll") for (int k = 0; k < 2; ++k) \
    acc[ai][bj][m][n] = __builtin_amdgcn_mfma_f32_16x16x32_bf16(Bf[n][k], At[m][k], acc[ai][bj][m][n], 0, 0, 0); __builtin_amdgcn_s_setprio(0); } while (0)
#define G_WAIT_V(n) asm volatile("s_waitcnt vmcnt(" #n ")" ::: "memory")
#define G_WAIT_L(n) asm volatile("s_waitcnt lgkmcnt(" #n ")" ::: "memory")
#define G_BAR __builtin_amdgcn_s_barrier()
#define G_SCHED __builtin_amdgcn_sched_barrier(0)
  GUnit cur, nxt; int ui = 0;
  if (!next(0, cur)) return;
  f32x4 acc[2][2][4][2];
#pragma unroll
  for (int a = 0; a < 2; ++a)
#pragma unroll
    for (int b = 0; b < 2; ++b)
#pragma unroll
      for (int m = 0; m < 4; ++m)
#pragma unroll
        for (int n = 0; n < 2; ++n) acc[a][b][m][n] = (f32x4){0.f, 0.f, 0.f, 0.f};
  bf16x8 At[4][2], B0[2][2], B1[2][2];
  const char* cA = cur.a; const char* cB = cur.b;
  G_STAGE(G_SB(0, 0), cB); G_STAGE(G_SA(0, 0), cA); G_STAGE(G_SB(0, 1), cB + hstep); G_STAGE(G_SA(0, 1), cA + hstep);
  if (wr == 1) G_BAR;
  G_WAIT_V(4); G_BAR;
  G_STAGE(G_SB(1, 0), cB + kstep); G_STAGE(G_SA(1, 0), cA + kstep); G_STAGE(G_SB(1, 1), cB + hstep + kstep);
  G_WAIT_V(6); G_BAR;
  for (;;) {
    const bool has_next = next(ui + 1, nxt);
    const char* nA = has_next ? nxt.a : cA; const char* nB = has_next ? nxt.b : cB;
    const int nt = cur.nt;
    for (int t = 0; t < nt; t += 2) {
      const bool last = (t == nt - 2);
      const char* a1 = cA + (size_t)(t + 1) * kstep;
      const char* a2 = last ? nA : cA + (size_t)(t + 2) * kstep; const char* b2 = last ? nB : cB + (size_t)(t + 2) * kstep;
      const char* a3 = a2 + kstep; const char* b3 = b2 + kstep;
      G_LDB(B0, 0, 0); G_SCHED; G_LDA(At, 0, 0); G_STAGE(G_SA(1, 1), a1 + hstep);
      G_WAIT_L(8); G_BAR; G_WAIT_L(0); G_MMA(0, 0, At, B0); G_BAR; G_SCHED;
      G_LDB(B1, 0, 1); G_STAGE(G_SB(0, 0), b2);
      G_BAR; G_WAIT_L(0); G_MMA(0, 1, At, B1); G_BAR;
      G_LDA(At, 0, 1); G_STAGE(G_SA(0, 0), a2);
      G_BAR; G_WAIT_L(0); G_MMA(1, 0, At, B0); G_BAR; G_SCHED;
      G_STAGE(G_SB(0, 1), b2 + hstep);
      G_WAIT_V(6); G_BAR; G_MMA(1, 1, At, B1); G_BAR;
      G_LDB(B0, 1, 0); G_SCHED; G_LDA(At, 1, 0); G_STAGE(G_SA(0, 1), a2 + hstep);
      G_WAIT_L(8); G_BAR; G_WAIT_L(0); G_MMA(0, 0, At, B0); G_BAR; G_SCHED;
      G_LDB(B1, 1, 1); G_STAGE(G_SB(1, 0), b3);
      G_BAR; G_WAIT_L(0); G_MMA(0, 1, At, B1); G_BAR;
      G_LDA(At, 1, 1); G_STAGE(G_SA(1, 0), a3);
      G_BAR; G_WAIT_L(0); G_MMA(1, 0, At, B0); G_BAR; G_SCHED;
      G_STAGE(G_SB(1, 1), b3 + hstep);
      G_WAIT_V(6); G_BAR; G_MMA(1, 1, At, B1); G_BAR;
    }
    epi(acc, cur, wr, wc, fr, fq);
    if (!has_next) break;
#pragma unroll
    for (int a = 0; a < 2; ++a)
#pragma unroll
      for (int b = 0; b < 2; ++b)
#pragma unroll
        for (int m = 0; m < 4; ++m)
#pragma unroll
          for (int n = 0; n < 2; ++n) acc[a][b][m][n] = (f32x4){0.f, 0.f, 0.f, 0.f};
    cur = nxt; cA = nA; cB = nB; ++ui;
  }
  G_WAIT_V(0);
  if (wr == 0) G_BAR;
  G_BAR;
#undef G_SA
#undef G_SB
#undef G_STAGE
#undef G_LDA
#undef G_LDB
#undef G_MMA
}

DEV void phase_inproj(const Params& p_in, int layer) {
  Params p = p_in; { size_t z_ = 0; asm volatile("" : "+s"(z_)); p.ws = p_in.ws + z_; }
  const char* H = p.ws + OFF_H;
  const char* W = p.ws + OFF_WIN;
  const f32x4* rope = (const f32x4*)(p.ws + OFF_ROPE);
  char* ws = p.ws;
  if (5 * (int)gridDim.x + (int)blockIdx.x >= 1408) { __builtin_amdgcn_s_sleep(127); __builtin_amdgcn_s_sleep(127); __builtin_amdgcn_s_sleep(127); __builtin_amdgcn_s_sleep(127); }
  __syncthreads();
  gemm_stream([&](int i, GUnit& u) -> bool {
      int pm, pn; if (!gemm_next(i, 64, 22, pm, pn)) return false;
      u.a = H + (size_t)pm * 256 * 2048; u.b = W + (size_t)pn * 256 * 2048; u.nt = 16; u.pm = pm; u.pn = pn; u.s = 0; return true; },
    [&](f32x4 (&acc)[2][2][4][2], const GUnit& u, int wr, int wc, int fr, int fq) {
      const int c0 = u.pn * 256;
      size_t base; int ld, lc; bool rp;
      const int akv = (c0 >= 512 && c0 < 1536) ? 1 : 0;
      if (c0 < 512) { base = OFF_AQK; ld = 512; lc = c0; rp = true; }
      else if (c0 < 1024) { base = OFF_AK; ld = 128; lc = 0; rp = true; }
      else if (c0 < 1536) { base = OFF_AV; ld = 128; lc = 0; rp = false; }
      else if (c0 < 2304) { base = OFF_BK; ld = 768; lc = c0 - 1536; rp = true; }
      else if (c0 < 3072) { base = OFF_BV; ld = 768; lc = c0 - 2304; rp = false; }
      else if (c0 < 3840) { base = OFF_C; ld = 768; lc = c0 - 3072; rp = false; }
      else if (c0 < 4608) { base = OFF_BQ; ld = 768; lc = c0 - 3840; rp = true; }
      else { base = OFF_Z; ld = 1024; lc = c0 - 4608; rp = false; }
      bf16_t* dst = (bf16_t*)(ws + base);
      const bool dorope = rp && ((wc & 1) == 0) && (fq < 2);
      const bool isk = (c0 >= 512 && c0 < 1024);
      const int head0 = ((c0 >> 8) & 1) * 2;
      float kmx0 = 0.f, kmx1 = 0.f;
      const bool ropewave = rp && ((wc & 1) == 0);
#pragma unroll
      for (int ai = 0; ai < 2; ++ai) {
        f32x4 csA[4], csB[4];
        if (ropewave) {
#pragma unroll
          for (int m = 0; m < 4; ++m) { const size_t ri = (size_t)(u.pm * 256 + ai * 128 + wr * 64 + m * 16 + fr) * 4 + (fq & 1) * 2; csA[m] = rope[ri]; csB[m] = rope[ri + 1]; }
          asm volatile("" ::: "memory");
        }
#pragma unroll
        for (int m = 0; m < 4; ++m) {
          const int row = u.pm * 256 + ai * 128 + wr * 64 + m * 16 + fr;
          f32x4 cs0 = {1.f, 0.f, 1.f, 0.f}, cs1 = {1.f, 0.f, 1.f, 0.f};
          if (dorope) { cs0 = csA[m]; cs1 = csB[m]; }
#pragma unroll
          for (int bj = 0; bj < 2; ++bj) {
            f32x4 v0 = acc[ai][bj][m][0], v1 = acc[ai][bj][m][1];
            if (dorope) {
              f32x4 a, b;
              a[0] = v0[0] * cs0[0] - v0[1] * cs0[1]; a[1] = v0[1] * cs0[0] + v0[0] * cs0[1];
              a[2] = v0[2] * cs0[2] - v0[3] * cs0[3]; a[3] = v0[3] * cs0[2] + v0[2] * cs0[3];
              b[0] = v1[0] * cs1[0] - v1[1] * cs1[1]; b[1] = v1[1] * cs1[0] + v1[0] * cs1[1];
              b[2] = v1[2] * cs1[2] - v1[3] * cs1[3]; b[3] = v1[3] * cs1[2] + v1[2] * cs1[3];
              v0 = a; v1 = b;
            }
            u32x4 w; w[0] = cvtpk(v0[0], v0[1]); w[1] = cvtpk(v0[2], v0[3]); w[2] = cvtpk(v1[0], v1[1]); w[3] = cvtpk(v1[2], v1[3]);
            if (akv) *(u32x4*)(dst + ((size_t)(((row >> 12) * 4 + head0 + bj) * SEQ + (row & 4095))) * 128 + wc * 32 + fq * 8) = w;
            else *(u32x4*)(dst + (size_t)row * ld + lc + bj * 128 + wc * 32 + fq * 8) = w;
            if (isk) {
              float s = v0[0] * v0[0] + v0[1] * v0[1] + v0[2] * v0[2] + v0[3] * v0[3] + v1[0] * v1[0] + v1[1] * v1[1] + v1[2] * v1[2] + v1[3] * v1[3];
              s += __shfl_xor(s, 16); s += __shfl_xor(s, 32);
              if (bj == 0) kmx0 = fmaxf(kmx0, s); else kmx1 = fmaxf(kmx1, s);
            }
          }
        }
      }
      if (isk) {
#pragma unroll
        for (int o_ = 1; o_ < 16; o_ <<= 1) { kmx0 = fmaxf(kmx0, __shfl_xor(kmx0, o_)); kmx1 = fmaxf(kmx1, __shfl_xor(kmx1, o_)); }
        if ((threadIdx.x & 63) == 0) {
          unsigned* kmx = (unsigned*)(ws + OFF_KMX) + layer * 64 + (u.pm >> 4) * 16 + (wc >> 1) * 2 + (wc & 1);
          atomicMax(kmx + (head0 + 0) * 4, __float_as_uint(kmx0));
          atomicMax(kmx + (head0 + 1) * 4, __float_as_uint(kmx1));
        }
      }
    });
}

DEV void phase_gates(const Params& p_in) {
  Params p = p_in; { size_t z_ = 0; asm volatile("" : "+s"(z_)); p.ws = p_in.ws + z_; }
  {
    const bf16_t* OB = (const bf16_t*)(p.ws + OFF_BQ);
    const float* LSE = (const float*)(p.ws + OFF_LSE);
    const bf16_t* Z = (const bf16_t*)(p.ws + OFF_Z);
    bf16_t* Y = (bf16_t*)(p.ws + OFF_Y);
    const int i0 = blockIdx.x * 512 + ltid(), istep = gridDim.x * 512;
    for (int ib = i0; ib < T * 32; ib += 4 * istep) {
      float l0[4], l1[4], l2[4]; u32x4 a[4], b[4], c[4], z[4];
#pragma unroll
      for (int k = 0; k < 4; ++k) {
        const int i = ib + k * istep;
        if (i < T * 32) {
          const int tok = i >> 5, hs = (i >> 3) & 3, dc = (i & 7) * 8;
          l0[k] = LSE[((size_t)0 * T + tok) * 4 + hs]; l1[k] = LSE[((size_t)1 * T + tok) * 4 + hs]; l2[k] = LSE[((size_t)2 * T + tok) * 4 + hs];
          a[k] = *(const u32x4*)(OB + (size_t)tok * 768 + 0 * 256 + hs * 64 + dc);
          b[k] = *(const u32x4*)(OB + (size_t)tok * 768 + 1 * 256 + hs * 64 + dc);
          c[k] = *(const u32x4*)(OB + (size_t)tok * 768 + 2 * 256 + hs * 64 + dc);
          z[k] = *(const u32x4*)(Z + (size_t)tok * 1024 + 512 + hs * 64 + dc);
        }
      }
#pragma unroll
      for (int k = 0; k < 4; ++k) {
        const int i = ib + k * istep;
        if (i < T * 32) {
          const int tok = i >> 5, hs = (i >> 3) & 3, dc = (i & 7) * 8;
          const float mx = fmaxf(l0[k], fmaxf(l1[k], l2[k]));
          float e0 = __expf(l0[k] - mx), e1 = __expf(l1[k] - mx), e2 = __expf(l2[k] - mx);
          const float inv = __builtin_amdgcn_rcpf(e0 + e1 + e2); e0 *= inv; e1 *= inv; e2 *= inv;
          u32x4 w;
#pragma unroll
          for (int q = 0; q < 4; ++q) {
            const float lo = (e0 * bflo(a[k][q]) + e1 * bflo(b[k][q]) + e2 * bflo(c[k][q])) * siluf(bflo(z[k][q]));
            const float hi = (e0 * bfhi(a[k][q]) + e1 * bfhi(b[k][q]) + e2 * bfhi(c[k][q])) * siluf(bfhi(z[k][q]));
            w[q] = cvtpk(lo, hi);
          }
          *(u32x4*)(Y + (size_t)tok * 1024 + 512 + hs * 64 + dc) = w;
        }
      }
    }
  }
  const char* H = p.ws + OFF_H;
  const char* W = p.ws + OFF_WIN + (size_t)5632 * 2048;
  bf16_t* G = (bf16_t*)(p.ws + OFF_G);
  __syncthreads();
  gemm_stream([&](int i, GUnit& u) -> bool {
      int pm, pn; if (!gemm_next(i, 64, 12, pm, pn)) return false;
      u.a = H + (size_t)pm * 256 * 2048; u.b = W + (size_t)pn * 256 * 2048; u.nt = 16; u.pm = pm; u.pn = pn; u.s = 0; return true; },
    [&](f32x4 (&acc)[2][2][4][2], const GUnit& u, int wr, int wc, int fr, int fq) {
#pragma unroll
      for (int ai = 0; ai < 2; ++ai)
#pragma unroll
        for (int m = 0; m < 4; ++m) {
          const int row = u.pm * 256 + ai * 128 + wr * 64 + m * 16 + fr;
#pragma unroll
          for (int bj = 0; bj < 2; ++bj) {
            const f32x4 v0 = acc[ai][bj][m][0], v1 = acc[ai][bj][m][1];
            u32x4 w; w[0] = cvtpk_t(sig2(v0[0]), sig2(v0[1])); w[1] = cvtpk_t(sig2(v0[2]), sig2(v0[3]));
            w[2] = cvtpk_t(sig2(v1[0]), sig2(v1[1])); w[3] = cvtpk_t(sig2(v1[2]), sig2(v1[3]));
            *(u32x4*)(G + (size_t)row * 3072 + u.pn * 256 + bj * 128 + wc * 32 + fq * 8) = w;
          }
        }
    });
}

DEV void phase_merge(const Params& p_in, int layer) {
  Params p = p_in; { size_t z_ = 0; asm volatile("" : "+s"(z_)); p.ws = p_in.ws + z_; }
  const char* Y = p.ws + OFF_Y;
  const char* W = p.ws + OFF_WBR + (size_t)layer * 1024 * 2048;
  const bf16_t* G = (const bf16_t*)(p.ws + OFF_G);
  bf16_t* M = (bf16_t*)(p.ws + OFF_H);
  __syncthreads();
  gemm_stream([&](int i, GUnit& u) -> bool {
      const int uu = i / 3, s = i - uu * 3;
      int pm, pn; if (!gemm_next(uu, 64, 4, pm, pn)) return false;
      const int koff = (s == 0) ? 0 : (s == 1 ? 512 : 768);
      u.a = Y + (size_t)pm * 256 * 2048 + koff * 2; u.b = W + (size_t)pn * 256 * 2048 + koff * 2; u.nt = (s == 0) ? 8 : 4; u.pm = pm; u.pn = pn; u.s = s; return true; },
    [&](f32x4 (&acc)[2][2][4][2], const GUnit& u, int wr, int wc, int fr, int fq) {
      const int s = u.s;
#pragma unroll
      for (int ai = 0; ai < 2; ++ai) {
        u32x4 gq[4][2], oq[4][2];
#pragma unroll
        for (int m = 0; m < 4; ++m)
#pragma unroll
          for (int bj = 0; bj < 2; ++bj) {
            const int row = u.pm * 256 + ai * 128 + wr * 64 + m * 16 + fr, col = u.pn * 256 + bj * 128 + wc * 32 + fq * 8;
            gq[m][bj] = *(const u32x4*)(G + (size_t)row * 3072 + s * 1024 + col);
            oq[m][bj] = (u32x4){0u, 0u, 0u, 0u};
            if (s > 0) oq[m][bj] = *(const u32x4*)(M + (size_t)row * 1024 + col);
          }
        asm volatile("" ::: "memory");
#pragma unroll
        for (int m = 0; m < 4; ++m)
#pragma unroll
          for (int bj = 0; bj < 2; ++bj) {
            const int row = u.pm * 256 + ai * 128 + wr * 64 + m * 16 + fr, col = u.pn * 256 + bj * 128 + wc * 32 + fq * 8;
            const u32x4 g = gq[m][bj], old = oq[m][bj];
            const f32x4 v0 = acc[ai][bj][m][0], v1 = acc[ai][bj][m][1];
            u32x4 w;
            w[0] = cvtpk(bflo(old[0]) + bflo(g[0]) * v0[0], bfhi(old[0]) + bfhi(g[0]) * v0[1]);
            w[1] = cvtpk(bflo(old[1]) + bflo(g[1]) * v0[2], bfhi(old[1]) + bfhi(g[1]) * v0[3]);
            w[2] = cvtpk(bflo(old[2]) + bflo(g[2]) * v1[0], bfhi(old[2]) + bfhi(g[2]) * v1[1]);
            w[3] = cvtpk(bflo(old[3]) + bflo(g[3]) * v1[2], bfhi(old[3]) + bfhi(g[3]) * v1[3]);
            *(u32x4*)(M + (size_t)row * 1024 + col) = w;
          }
      }
    });
}

DEV void phase_out(const Params& p_in, int layer, const float* __restrict__ xin) {
  Params p = p_in; { size_t z_ = 0; asm volatile("" : "+s"(z_)); p.ws = p_in.ws + z_; }
  const char* M = p.ws + OFF_H;
  const char* W = p.ws + OFF_WOUT + (size_t)layer * 1024 * 2048;
  const float* mod = (const float*)(p.ws + OFF_MOD) + (size_t)layer * 4 * 3072 + 2048;
  float* out = p.out;
  __syncthreads();
  gemm_stream([&](int i, GUnit& u) -> bool {
      int pm, pn; if (!gemm_next(i, 64, 4, pm, pn)) return false;
      u.a = M + (size_t)pm * 256 * 2048; u.b = W + (size_t)pn * 256 * 2048; u.nt = 16; u.pm = pm; u.pn = pn; u.s = 0; return true; },
    [&](f32x4 (&acc)[2][2][4][2], const GUnit& u, int wr, int wc, int fr, int fq) {
      const int b = u.pm >> 4;
#pragma unroll
      for (int bj = 0; bj < 2; ++bj) {
        const int col = u.pn * 256 + bj * 128 + wc * 32 + fq * 8;
        const f32x4 g0 = *(const f32x4*)(mod + b * 3072 + col), g1 = *(const f32x4*)(mod + b * 3072 + col + 4);
#pragma unroll
        for (int ai = 0; ai < 2; ++ai)
#pragma unroll
          for (int m = 0; m < 4; ++m) {
            const int row = u.pm * 256 + ai * 128 + wr * 64 + m * 16 + fr;
            const f32x4 x0 = *(const f32x4*)(xin + (size_t)row * 1024 + col), x1 = *(const f32x4*)(xin + (size_t)row * 1024 + col + 4);
            *(f32x4*)(out + (size_t)row * 1024 + col) = x0 + g0 * acc[ai][bj][m][0];
            *(f32x4*)(out + (size_t)row * 1024 + col + 4) = x1 + g1 * acc[ai][bj][m][1];
          }
      }
    });
  __syncthreads();
  if (layer == 0) cvt_win_layer(p, 1);
}

#define KSWZ_A(row, colB) ((row) * 256 + ((colB) ^ (((row) & 7) << 4)))
#define KSWZ_S(row, colB) ((row) * 128 + ((colB) ^ ((((row) >> 1) & 7) << 4)))
template <int DV> DEV int v_st(int k, int c) { const int kk = (k & ~0xC) | ((k & 4) << 1) | ((k & 8) >> 1); return ((kk >> 3) * (DV / 32) + (c >> 5)) * 512 + ((kk & 7) * 32 + (c & 31)) * 2; }
DEV int v_rd_base(int lane) { return ((lane & 3) << 3) | (((lane >> 2) & 3) << 6) | (((lane >> 4) & 1) << 5) | (((lane >> 5) & 1) << 8); }
template <int OFF> DEV s16x4 tr_read(int vb) { s16x4 r; asm volatile("ds_read_b64_tr_b16 %0, %1 offset:%2" : "=&v"(r) : "v"(vb), "i"(OFF) : "memory"); return r; }
template <int DV, int D0> DEV void pv_one(f32x16& od, int vb, bf16x8 pa0, bf16x8 pa1, bf16x8 pa2, bf16x8 pa3) {
  constexpr int KS = (DV / 32) * 1024, HF = (DV / 32) * 512;
  const s16x4 l0 = tr_read<D0 * 512 + 0 * KS>(vb), h0 = tr_read<D0 * 512 + 0 * KS + HF>(vb), l1 = tr_read<D0 * 512 + 1 * KS>(vb), h1 = tr_read<D0 * 512 + 1 * KS + HF>(vb);
  const s16x4 l2 = tr_read<D0 * 512 + 2 * KS>(vb), h2 = tr_read<D0 * 512 + 2 * KS + HF>(vb), l3 = tr_read<D0 * 512 + 3 * KS>(vb), h3 = tr_read<D0 * 512 + 3 * KS + HF>(vb);
  asm volatile("s_waitcnt lgkmcnt(0)" ::: "memory"); __builtin_amdgcn_sched_barrier(0);
#define PK(L, H) (bf16x8){L[0], L[1], L[2], L[3], H[0], H[1], H[2], H[3]}
  od = __builtin_amdgcn_mfma_f32_32x32x16_bf16(pa0, PK(l0, h0), od, 0, 0, 0);
  od = __builtin_amdgcn_mfma_f32_32x32x16_bf16(pa1, PK(l1, h1), od, 0, 0, 0);
  od = __builtin_amdgcn_mfma_f32_32x32x16_bf16(pa2, PK(l2, h2), od, 0, 0, 0);
  od = __builtin_amdgcn_mfma_f32_32x32x16_bf16(pa3, PK(l3, h3), od, 0, 0, 0);
#undef PK
}

template <int MODE>
DEV void attn_unit(const Params& p, int layer, int u) {
  constexpr int DV = (MODE == 0) ? 128 : 64, ND = DV / 32;
  constexpr int TB = (MODE == 0) ? 16384 : 8192;
  constexpr float C = SCALE * 1.4426950408889634f;
  constexpr float THRRAW = 8.0f / SCALE;
  const int tid = ltid(), wid = __builtin_amdgcn_readfirstlane(tid >> 6), lane = tid & 63, r32 = lane & 31, hi = lane >> 5;
  char* V_lds = smem; char* K_lds = smem + 2 * TB;
  float* wsc = (float*)(smem + 131072) + wid * 64; float* li_l = wsc; float* al_l = wsc + 32;
  float* rpb_l = (float*)(smem + 131072 + 2048);

  int b = 0, h = 0, NT = 0, tfirst = 0;
  int g = 0, rr = 1, mres = 0, blk = 0, Lsub = 0;
  int r0 = 0, row_lo = 0, qrow = 0, qcol = 0, rs = 0, cs = 0;
  const bf16_t *Qp, *Kb, *Vb; int ldkv;
  int qtok;
  int coff = 0;
  if (MODE == 0) {
    const int pair = ((u & 7) << 1) | (u >> 8), qb = (u >> 3) & 31; b = pair >> 2; h = pair & 3;
    const int g4 = wid >> 1, cm = wid & 1; coff = cm * 64;
    qtok = b * SEQ + qb * 128 + g4 * 32 + r32;
    Qp = (const bf16_t*)(p.ws + OFF_AQK) + (size_t)qtok * 1024 + h * 128 + cm * 64;
    Kb = (const bf16_t*)(p.ws + OFF_AQK) + 512 + h * 128; Vb = (const bf16_t*)(p.ws + OFF_AV) + h * 128; ldkv = 0;
    NT = 64; tfirst = 0;
  } else if (MODE == 1) {
    b = u / 192; int rem = u % 192; h = rem / 48; rem %= 48; g = rem / 16; const int uu = rem % 16;
    rr = (g == 0) ? 1 : (g == 1 ? 4 : 16); Lsub = SEQ / rr; mres = uu % rr; blk = uu / rr;
    const int qn = blk * 256 + wid * 32 + r32;
    qtok = b * SEQ + qn * rr + mres;
    Qp = (const bf16_t*)(p.ws + OFF_BQ) + (size_t)qtok * 768 + g * 256 + h * 64;
    Kb = (const bf16_t*)(p.ws + OFF_BK) + g * 256 + h * 64; Vb = (const bf16_t*)(p.ws + OFF_BV) + g * 256 + h * 64; ldkv = 768;
    tfirst = (blk == 0) ? 1 : 0; int tl = (Lsub - (blk * 256 - 64)) / 64 - 1; if (tl > 5) tl = 5; NT = tl + 1;
  } else {
    b = u >> 6; h = (u >> 4) & 3; r0 = (u & 15) * 4;
    qrow = r0 + (wid >> 1); qcol = (wid & 1) * 32 + r32;
    qtok = b * SEQ + qrow * 64 + qcol;
    Qp = (const bf16_t*)(p.ws + OFF_C) + (size_t)qtok * 768 + h * 64;
    Kb = (const bf16_t*)(p.ws + OFF_C) + 256 + h * 64; Vb = (const bf16_t*)(p.ws + OFF_C) + 512 + h * 64; ldkv = 768;
    row_lo = r0 - 4; if (row_lo < 0) row_lo = 0; if (row_lo > 56) row_lo = 56;
    int rl3 = r0 + 3 - 4; if (rl3 < 0) rl3 = 0; if (rl3 > 56) rl3 = 56;
    NT = rl3 + 8 - row_lo; tfirst = 0;
    rs = qrow - 4; if (rs < 0) rs = 0; if (rs > 56) rs = 56;
    cs = qcol - 8; if (cs < 0) cs = 0; if (cs > 48) cs = 48;
    const float* rp = p.rpb + ((size_t)layer * 4 + h) * 465;
    if (tid < 465) rpb_l[tid] = rp[tid] * (1.0f / SCALE);
  }
  (void)ldkv;

  bf16x8 qr[4];
#pragma unroll
  for (int d0 = 0; d0 < 4; ++d0) qr[d0] = *(const bf16x8*)(Qp + d0 * 16 + hi * 8);

  bf16x8 st0, st1, st2, st3;
  auto key_tok = [&](int t, int i) -> int {
    if (MODE == 0) return b * SEQ + t * 64 + i;
    if (MODE == 1) return b * SEQ + (blk * 256 - 64 + 64 * t + i) * rr + mres;
    return b * SEQ + (row_lo + t) * 64 + i;
  };
  auto sload = [&](int t) {
    if (MODE == 0) {
      const int sr = tid >> 4, sc = (tid & 15) * 8;
      const size_t k0 = (size_t)key_tok(t, sr), k1 = (size_t)key_tok(t, 32 + sr);
      st0 = *(const bf16x8*)(Vb + k0 * 512 + sc); st1 = *(const bf16x8*)(Vb + k1 * 512 + sc);
      st2 = *(const bf16x8*)(Kb + k0 * 1024 + sc); st3 = *(const bf16x8*)(Kb + k1 * 1024 + sc);
    } else {
      const int sr = tid >> 3, sc = (tid & 7) * 8;
      const size_t k0 = (size_t)key_tok(t, sr);
      st0 = *(const bf16x8*)(Vb + k0 * 768 + sc); st2 = *(const bf16x8*)(Kb + k0 * 768 + sc);
    }
  };
  auto swrite = [&](int buf) {
    if (MODE == 0) {
      const int sr = tid >> 4, sc = (tid & 15) * 8;
      *(bf16x8*)(V_lds + buf * TB + v_st<128>(sr, sc)) = st0; *(bf16x8*)(V_lds + buf * TB + v_st<128>(32 + sr, sc)) = st1;
      *(bf16x8*)(K_lds + buf * TB + KSWZ_A(sr, sc * 2)) = st2; *(bf16x8*)(K_lds + buf * TB + KSWZ_A(32 + sr, sc * 2)) = st3;
    } else {
      const int sr = tid >> 3, sc = (tid & 7) * 8;
      *(bf16x8*)(V_lds + buf * TB + v_st<64>(sr, sc)) = st0;
      *(bf16x8*)(K_lds + buf * TB + KSWZ_S(sr, sc * 2)) = st2;
    }
  };

  float m_reg = -1e30f, l_reg = 0.f;
  f32x16 o[ND];
#pragma unroll
  for (int d = 0; d < ND; ++d) o[d] = f32x16{};
  const int vb0 = (int)(uintptr_t)V_lds + v_rd_base(lane);

  sload(tfirst); swrite(0);
  __syncthreads();
  if (wid >= 4) __builtin_amdgcn_s_setprio(1);
  for (int t = tfirst, it = 0; t < NT; ++t, ++it) {
    const int buf = it & 1;
    const bool more = (t + 1 < NT);
    if (more) sload(t + 1);
    bool active = true;
    if (MODE == 1) { const int tn0 = blk * 256 - 64 + 64 * t, qa = blk * 256 + wid * 32; active = (tn0 + 63 >= qa - 64) && (tn0 <= qa + 31 + 64); }
    if (MODE == 2) { const int kr = row_lo + t; active = (kr >= rs) && (kr < rs + 8); }
    if (active) {
      f32x16 p0 = f32x16{}, p1 = f32x16{};
      const char* Kt = K_lds + buf * TB;
#pragma unroll
      for (int d0 = 0; d0 < 4; ++d0) {
        const int cb = (coff + d0 * 16 + hi * 8) * 2;
        bf16x8 b0, b1;
        if (MODE == 0) { b0 = *(const bf16x8*)(Kt + KSWZ_A(r32, cb)); b1 = *(const bf16x8*)(Kt + KSWZ_A(32 + r32, cb)); }
        else { b0 = *(const bf16x8*)(Kt + KSWZ_S(r32, cb)); b1 = *(const bf16x8*)(Kt + KSWZ_S(32 + r32, cb)); }
        p0 = __builtin_amdgcn_mfma_f32_32x32x16_bf16(b0, qr[d0], p0, 0, 0, 0);
        p1 = __builtin_amdgcn_mfma_f32_32x32x16_bf16(b1, qr[d0], p1, 0, 0, 0);
      }
      if (MODE == 1) {
        const int tn0 = blk * 256 - 64 + 64 * t, qn = blk * 256 + wid * 32 + r32;
#pragma unroll
        for (int r = 0; r < 16; ++r) {
          const int d0k = tn0 + crow(r, hi) - qn, d1k = d0k + 32;
          if (d0k > 64 || d0k < -64) p0[r] = -INFINITY;
          if (d1k > 64 || d1k < -64) p1[r] = -INFINITY;
        }
      }
      if (MODE == 2) {
        const int kr = row_lo + t; const int rb = (kr - qrow + 7) * 31;
#pragma unroll
        for (int r = 0; r < 16; ++r) {
          const int kc0 = crow(r, hi), kc1 = kc0 + 32;
          int dc0 = kc0 - qcol + 15, dc1 = kc1 - qcol + 15;
          dc0 = dc0 < 0 ? 0 : (dc0 > 30 ? 30 : dc0); dc1 = dc1 < 0 ? 0 : (dc1 > 30 ? 30 : dc1);
          const float b0 = rpb_l[rb + dc0], b1 = rpb_l[rb + dc1];
          p0[r] = (kc0 >= cs && kc0 < cs + 16) ? p0[r] + b0 : -INFINITY;
          p1[r] = (kc1 >= cs && kc1 < cs + 16) ? p1[r] + b1 : -INFINITY;
        }
      }
      float pmax = p0[0];
#pragma unroll
      for (int r = 1; r < 16; ++r) pmax = fmaxf(pmax, p0[r]);
#pragma unroll
      for (int r = 0; r < 16; ++r) pmax = fmaxf(pmax, p1[r]);
      { auto sw = __builtin_amdgcn_permlane32_swap(__float_as_uint(pmax), __float_as_uint(pmax), false, false);
        pmax = fmaxf(__uint_as_float(sw[0]), __uint_as_float(sw[1])); }
      float mn, alpha;
      if (__all(pmax - m_reg <= THRRAW)) { mn = m_reg; alpha = 1.f; }
      else { mn = fmaxf(m_reg, pmax); alpha = __builtin_amdgcn_exp2f((m_reg - mn) * C); m_reg = mn; }
      const float mnC = -mn * C;
      float ps = 0.f;
#pragma unroll
      for (int r = 0; r < 16; ++r) { p0[r] = __builtin_amdgcn_exp2f(fmaf(p0[r], C, mnC)); ps += p0[r]; }
#pragma unroll
      for (int r = 0; r < 16; ++r) { p1[r] = __builtin_amdgcn_exp2f(fmaf(p1[r], C, mnC)); ps += p1[r]; }
      { auto sw = __builtin_amdgcn_permlane32_swap(__float_as_uint(ps), __float_as_uint(ps), false, false);
        ps = __uint_as_float(sw[0]) + __uint_as_float(sw[1]); }
      l_reg = l_reg * alpha + ps;
      bf16x8 pa0, pa1, pa2, pa3;
#define PK4(P, BASE, OUT) do { unsigned a0 = cvtpk(P[BASE + 0], P[BASE + 1]), a1 = cvtpk(P[BASE + 2], P[BASE + 3]); \
    unsigned b0_ = cvtpk(P[BASE + 4], P[BASE + 5]), b1_ = cvtpk(P[BASE + 6], P[BASE + 7]); \
    auto r0_ = __builtin_amdgcn_permlane32_swap(a0, b0_, false, false); auto r1_ = __builtin_amdgcn_permlane32_swap(a1, b1_, false, false); \
    u32x4 w_ = {r0_[0], r1_[0], r0_[1], r1_[1]}; OUT = *reinterpret_cast<bf16x8*>(&w_); } while (0)
      PK4(p0, 0, pa0); PK4(p0, 8, pa1); PK4(p1, 0, pa2); PK4(p1, 8, pa3);
#undef PK4
      if (__any(alpha < 1.f)) {
        if (hi == 0) al_l[r32] = alpha;
        asm volatile("s_waitcnt lgkmcnt(0)" ::: "memory");
        float af[16];
#pragma unroll
        for (int r = 0; r < 16; ++r) af[r] = al_l[crow(r, hi)];
#pragma unroll
        for (int d = 0; d < ND; ++d)
#pragma unroll
          for (int r = 0; r < 16; ++r) o[d][r] *= af[r];
      }
      const int vb = vb0 + buf * TB;
      pv_one<DV, 0>(o[0], vb, pa0, pa1, pa2, pa3);
      pv_one<DV, 1>(o[1], vb, pa0, pa1, pa2, pa3);
      if (DV == 128) { pv_one<DV, 2>(o[ND - 2], vb, pa0, pa1, pa2, pa3); pv_one<DV, 3>(o[ND - 1], vb, pa0, pa1, pa2, pa3); }
    }
    if (more) swrite(buf ^ 1);
    __syncthreads();
  }

  __builtin_amdgcn_s_setprio(0);
  if (hi == 0) li_l[r32] = l_reg;
  asm volatile("s_waitcnt lgkmcnt(0)" ::: "memory");
  float rli[16];
#pragma unroll
  for (int r = 0; r < 16; ++r) rli[r] = __builtin_amdgcn_rcpf(li_l[crow(r, hi)]);
  const int qtok0 = __shfl(qtok, 0);
  if (MODE == 0) {
    const int g4 = wid >> 1, cm = wid & 1;
    float* X = (float*)smem + g4 * 4096;
    const float lam = ((const float*)(p.ws + OFF_LAM))[layer];
    if (cm == 1) {
#pragma unroll
      for (int d = 0; d < ND; ++d)
#pragma unroll
        for (int r = 0; r < 16; ++r) X[crow(r, hi) * 128 + d * 32 + r32] = -lam * o[d][r] * rli[r];
    }
    __syncthreads();
    if (cm == 0) {
      float ss[16];
#pragma unroll
      for (int r = 0; r < 16; ++r) ss[r] = 0.f;
#pragma unroll
      for (int d = 0; d < ND; ++d)
#pragma unroll
        for (int r = 0; r < 16; ++r) { const float dv = o[d][r] * rli[r] + X[crow(r, hi) * 128 + d * 32 + r32]; o[d][r] = dv; ss[r] += dv * dv; }
#pragma unroll
      for (int r = 0; r < 16; ++r) {
        float s = ss[r];
        s += __shfl_xor(s, 1); s += __shfl_xor(s, 2); s += __shfl_xor(s, 4); s += __shfl_xor(s, 8); s += __shfl_xor(s, 16);
        const float li = 0.8f - 0.6f * __expf(-0.3f * (float)layer);
        ss[r] = rsqrtf(s * (1.0f / 128.0f) + RMS_EPS) * (1.0f - li);
      }
      const bf16_t* Z = (const bf16_t*)(p.ws + OFF_Z); bf16_t* Y = (bf16_t*)(p.ws + OFF_Y);
#pragma unroll
      for (int d = 0; d < ND; ++d) {
        const float gn = p.subln[layer * 128 + d * 32 + r32];
#pragma unroll
        for (int r = 0; r < 16; ++r) {
          const size_t idx = (size_t)(qtok0 + crow(r, hi)) * 1024 + h * 128 + d * 32 + r32;
          const float y = o[d][r] * ss[r] * gn * siluf(bf2f(Z[idx]));
          Y[idx] = (bf16_t)(cvtpk(y, y) & 0xffffu);
        }
      }
    }
  } else if (MODE == 1) {
    bf16_t* OB = (bf16_t*)(p.ws + OFF_BQ);
    float* LSE = (float*)(p.ws + OFF_LSE);
    const int tokw = b * SEQ + (blk * 256 + wid * 32) * rr + mres;
#pragma unroll
    for (int d = 0; d < ND; ++d)
#pragma unroll
      for (int r = 0; r < 16; ++r) {
        const size_t idx = (size_t)(tokw + crow(r, hi) * rr) * 768 + g * 256 + h * 64 + d * 32 + r32;
        const float y = o[d][r] * rli[r];
        OB[idx] = (bf16_t)(cvtpk(y, y) & 0xffffu);
      }
    if (hi == 0) LSE[((size_t)g * T + qtok) * 4 + h] = m_reg * SCALE + __logf(l_reg);
  } else {
    const bf16_t* Z = (const bf16_t*)(p.ws + OFF_Z); bf16_t* Y = (bf16_t*)(p.ws + OFF_Y);
    float* Wf = (float*)(smem + 65536) + wid * 2048;
#pragma unroll
    for (int d = 0; d < ND; ++d)
#pragma unroll
      for (int r = 0; r < 16; ++r) Wf[crow(r, hi) * 64 + d * 32 + r32] = o[d][r] * rli[r];
    asm volatile("s_waitcnt lgkmcnt(0)" ::: "memory");
    u32x4 zq[4];
#pragma unroll
    for (int it = 0; it < 4; ++it) { const int idx = it * 64 + lane; zq[it] = *(const u32x4*)(Z + (size_t)(qtok0 + (idx >> 3)) * 1024 + 768 + h * 64 + (idx & 7) * 8); }
#pragma unroll
    for (int it = 0; it < 4; ++it) {
      const int idx = it * 64 + lane, row = idx >> 3, ch = idx & 7;
      const f32x4 a = *(const f32x4*)(Wf + row * 64 + ch * 8), c4 = *(const f32x4*)(Wf + row * 64 + ch * 8 + 4);
      const size_t gi = (size_t)(qtok0 + row) * 1024 + 768 + h * 64 + ch * 8;
      const u32x4 z = zq[it];
      u32x4 w;
      w[0] = cvtpk(a[0] * siluf(bflo(z[0])), a[1] * siluf(bfhi(z[0]))); w[1] = cvtpk(a[2] * siluf(bflo(z[1])), a[3] * siluf(bfhi(z[1])));
      w[2] = cvtpk(c4[0] * siluf(bflo(z[2])), c4[1] * siluf(bfhi(z[2]))); w[3] = cvtpk(c4[2] * siluf(bflo(z[3])), c4[3] * siluf(bfhi(z[3])));
      *(u32x4*)(Y + gi) = w;
    }
  }
  __syncthreads();
}

DEV void smA_partial(f32x16& p0, f32x16& p1, float& m_reg, float& alpha) {
  constexpr float C = SCALE * 1.4426950408889634f; constexpr float THRRAW = 8.0f / SCALE;
  float pmax = p0[0];
#pragma unroll
  for (int r = 1; r < 16; ++r) pmax = fmaxf(pmax, p0[r]);
#pragma unroll
  for (int r = 0; r < 16; ++r) pmax = fmaxf(pmax, p1[r]);
  { auto sw = __builtin_amdgcn_permlane32_swap(__float_as_uint(pmax), __float_as_uint(pmax), false, false);
    pmax = fmaxf(__uint_as_float(sw[0]), __uint_as_float(sw[1])); }
  float mn;
  if (__builtin_expect(__all(pmax - m_reg <= THRRAW), 1)) { mn = m_reg; alpha = 1.f; }
  else { mn = fmaxf(m_reg, pmax); alpha = __builtin_amdgcn_exp2f((m_reg - mn) * C); m_reg = mn; }
  const float mnC = -mn * C;
#pragma unroll
  for (int r = 0; r < 16; ++r) p0[r] = fmaf(p0[r], C, mnC);
#pragma unroll
  for (int r = 0; r < 16; ++r) p1[r] = fmaf(p1[r], C, mnC);
#pragma unroll
  for (int r = 0; r < 16; ++r) p0[r] = __builtin_amdgcn_exp2f(p0[r]);
}
DEV void smA_finish(f32x16& p0, f32x16& p1, float alpha, float& l_reg, bf16x8& pa0, bf16x8& pa1, bf16x8& pa2, bf16x8& pa3) {
#pragma unroll
  for (int r = 0; r < 16; ++r) p1[r] = __builtin_amdgcn_exp2f(p1[r]);
  float ps = 0.f;
#pragma unroll
  for (int r = 0; r < 16; ++r) ps += p0[r];
#pragma unroll
  for (int r = 0; r < 16; ++r) ps += p1[r];
  { auto sw = __builtin_amdgcn_permlane32_swap(__float_as_uint(ps), __float_as_uint(ps), false, false);
    ps = __uint_as_float(sw[0]) + __uint_as_float(sw[1]); }
  l_reg = l_reg * alpha + ps;
#define PK4(P, BASE, OUT) do { unsigned a0 = cvtpk(P[BASE + 0], P[BASE + 1]), a1 = cvtpk(P[BASE + 2], P[BASE + 3]); \
    unsigned b0_ = cvtpk(P[BASE + 4], P[BASE + 5]), b1_ = cvtpk(P[BASE + 6], P[BASE + 7]); \
    auto r0_ = __builtin_amdgcn_permlane32_swap(a0, b0_, false, false); auto r1_ = __builtin_amdgcn_permlane32_swap(a1, b1_, false, false); \
    u32x4 w_ = {r0_[0], r1_[0], r0_[1], r1_[1]}; OUT = *reinterpret_cast<bf16x8*>(&w_); } while (0)
  PK4(p0, 0, pa0); PK4(p0, 8, pa1); PK4(p1, 0, pa2); PK4(p1, 8, pa3);
#undef PK4
}

#define KSWZ_A2(row, colB) ((row) * 256 + ((colB) ^ (((row) & 15) << 4)))
DEV void attn_unit_A(const Params& p, int layer, int pair, int qb) {
  constexpr int SLOT = 32768;
  const int tid = ltid(), wid = __builtin_amdgcn_readfirstlane(tid >> 6), lane = tid & 63, r32 = lane & 31, hi = lane >> 5;
  LDSC* ldsb = (LDSC*)smem;
  float* wsc = (float*)(smem + 131072) + wid * 64; float* li_l = wsc; float* al_l = wsc + 32;
  const int b = pair >> 2, h = pair & 3;
  const int g4 = wid >> 1, cm = wid & 1, coff = cm * 64;
  const int qtok = b * SEQ + qb * 128 + g4 * 32 + r32;
  const bf16_t* Qp = (const bf16_t*)(p.ws + OFF_AQK) + (size_t)qtok * 512 + h * 128 + cm * 64;
  const char* Kg = p.ws + OFF_AK + (size_t)(b * 4 + h) * SEQ * 256;
  const char* Vg = p.ws + OFF_AV + (size_t)(b * 4 + h) * SEQ * 256;
  const float* kmxp = (const float*)(p.ws + OFF_KMX) + layer * 64 + b * 16 + h * 4 + cm * 2;
  constexpr int NT = 64;
  bf16x8 qr[4];
  float qsq = 0.f;
#pragma unroll
  for (int d0 = 0; d0 < 4; ++d0) {
    const u32x4 qw = *(const u32x4*)(Qp + d0 * 16 + hi * 8);
    u32x4 qs;
#pragma unroll
    for (int k = 0; k < 4; ++k) { const float lo = bflo(qw[k]), hh = bfhi(qw[k]); qsq += lo * lo + hh * hh; qs[k] = cvtpk(lo * (SCALE * 1.4426950408889634f), hh * (SCALE * 1.4426950408889634f)); }
    qr[d0] = *reinterpret_cast<bf16x8*>(&qs);
  }
  { auto sw = __builtin_amdgcn_permlane32_swap(__float_as_uint(qsq), __float_as_uint(qsq), false, false); qsq = __uint_as_float(sw[0]) + __uint_as_float(sw[1]); }
  const float kmax2 = kmxp[0] + kmxp[1];
  const float negm_s = -(sqrtf(qsq * kmax2) * (SCALE * 1.4426950408889634f) * 1.01f + 0.01f);
  f32x16 negm;
#pragma unroll
  for (int r = 0; r < 16; ++r) negm[r] = negm_s;
  unsigned kofs[2], vofs[2];
#pragma unroll
  for (int i = 0; i < 2; ++i) {
    const int q = i * 8 + wid;
    { const int row = q * 4 + (lane >> 4), pos = lane & 15; kofs[i] = (unsigned)(row * 256 + ((pos ^ (row & 15)) << 4)); }
    { const int st = q * 2 + (lane >> 5), kk = (st >> 2) * 8 + ((lane & 31) >> 2), c = (st & 3) * 32 + (lane & 3) * 8;
      const int k = (kk & ~0xC) | ((kk & 4) << 1) | ((kk & 8) >> 1); vofs[i] = (unsigned)(k * 256 + c * 2); }
  }
  const int vb0 = (int)(uintptr_t)smem + v_rd_base(lane);
  int kro[4];
#pragma unroll
  for (int d0 = 0; d0 < 4; ++d0) kro[d0] = KSWZ_A2(r32, (coff + d0 * 16 + hi * 8) * 2);
#define ISSUE(t) do { const char* kg_ = Kg + (size_t)(t) * (64 * 256); const char* vg_ = Vg + (size_t)(t) * (64 * 256); const int so_ = ((t) & 3) * SLOT; \
    _Pragma("unroll") for (int i_ = 0; i_ < 2; ++i_) { \
      __builtin_amdgcn_global_load_lds((const unsigned*)(vg_ + vofs[i_]), (__attribute__((address_space(3))) unsigned*)(ldsb + so_ + (i_ * 8 + wid) * 1024), 16, 0, 0); \
      __builtin_amdgcn_global_load_lds((const unsigned*)(kg_ + kofs[i_]), (__attribute__((address_space(3))) unsigned*)(ldsb + so_ + 16384 + (i_ * 8 + wid) * 1024), 16, 0, 0); } } while (0)
#define SBAR() __builtin_amdgcn_sched_barrier(0)
#define WAITV(n) asm volatile("s_waitcnt vmcnt(" #n ")" ::: "memory")
#define RBAR() do { asm volatile("" ::: "memory"); __builtin_amdgcn_s_barrier(); asm volatile("" ::: "memory"); } while (0)
#define KRD1(dst, addr, OFF) asm volatile("ds_read_b128 %0, %1 offset:" #OFF : "=&v"(dst) : "v"(addr) : "memory")
#define KREAD(t) do { const int kb_ = (int)(uintptr_t)smem + ((t) & 3) * SLOT; _Pragma("unroll") for (int d0 = 0; d0 < 4; ++d0) { const int ka_ = kb_ + kro[d0]; \
    KRD1(kf[2 * d0], ka_, 16384); KRD1(kf[2 * d0 + 1], ka_, 24576); } \
    asm volatile("s_waitcnt lgkmcnt(0)" ::: "memory"); SBAR(); } while (0)
#define VR1(D0, KS, vb_) vf[((D0) * 4 + (KS)) * 2] = tr_read<(D0) * 512 + (KS) * 4096>(vb_); vf[((D0) * 4 + (KS)) * 2 + 1] = tr_read<(D0) * 512 + (KS) * 4096 + 2048>(vb_);
#define VREAD_A(t) do { const int vb_ = vb0 + ((t) & 3) * SLOT; \
    VR1(0, 0, vb_) VR1(1, 0, vb_) VR1(2, 0, vb_) VR1(3, 0, vb_) VR1(0, 1, vb_) VR1(1, 1, vb_) VR1(2, 1, vb_) VR1(3, 1, vb_) } while (0)
#define VREAD_B(t) do { const int vb_ = vb0 + ((t) & 3) * SLOT; \
    VR1(0, 2, vb_) VR1(1, 2, vb_) VR1(2, 2, vb_) VR1(3, 2, vb_) VR1(0, 3, vb_) VR1(1, 3, vb_) VR1(2, 3, vb_) VR1(3, 3, vb_) } while (0)
#define PKV(i) (bf16x8){vf[2 * (i)][0], vf[2 * (i)][1], vf[2 * (i)][2], vf[2 * (i)][3], vf[2 * (i) + 1][0], vf[2 * (i) + 1][1], vf[2 * (i) + 1][2], vf[2 * (i) + 1][3]}
#define RESC(a) do { if (__any((a) < 1.f)) { if (hi == 0) al_l[r32] = (a); asm volatile("s_waitcnt lgkmcnt(0)" ::: "memory"); \
    _Pragma("unroll") for (int r = 0; r < 16; ++r) { const float af_ = al_l[crow(r, hi)]; o[0][r] *= af_; o[1][r] *= af_; o[2][r] *= af_; o[3][r] *= af_; } } } while (0)
  float l_reg = 0.f;
  f32x16 o[4] = {f32x16{}, f32x16{}, f32x16{}, f32x16{}};
  f32x16 p0, p1; bf16x8 pa[4]; bf16x8 kf[8]; s16x4 vf[32];
  ISSUE(0); ISSUE(1);
  if (wid >= 4) __builtin_amdgcn_s_setprio(1);
  long long seg_acc = 0;
#pragma unroll 1
  for (int J = 0; J < NT / 2; ++J) {
    WAITV(0); RBAR();
    if (J + 1 < NT / 2) { ISSUE(2 * J + 2); ISSUE(2 * J + 3); }
#pragma unroll
    for (int tt = 0; tt < 2; ++tt) {
      const int j = 2 * J + tt;
      KREAD(j);
      p0 = __builtin_amdgcn_mfma_f32_32x32x16_bf16(kf[0], qr[0], negm, 0, 0, 0);
      p1 = __builtin_amdgcn_mfma_f32_32x32x16_bf16(kf[1], qr[0], negm, 0, 0, 0);
#pragma unroll
      for (int d0 = 1; d0 < 4; ++d0) {
        p0 = __builtin_amdgcn_mfma_f32_32x32x16_bf16(kf[2 * d0], qr[d0], p0, 0, 0, 0);
        p1 = __builtin_amdgcn_mfma_f32_32x32x16_bf16(kf[2 * d0 + 1], qr[d0], p1, 0, 0, 0);
      }
      SBAR(); VREAD_A(j); SBAR();
      {
#pragma unroll
        for (int r = 0; r < 16; ++r) p0[r] = __builtin_amdgcn_exp2f(p0[r]);
#pragma unroll
        for (int r = 0; r < 16; ++r) p1[r] = __builtin_amdgcn_exp2f(p1[r]);
        float ps = 0.f;
#pragma unroll
        for (int r = 0; r < 16; ++r) ps += p0[r];
#pragma unroll
        for (int r = 0; r < 16; ++r) ps += p1[r];
        l_reg += ps;
#define PK4(P, BASE, OUT) do { unsigned a0 = cvtpk(P[BASE + 0], P[BASE + 1]), a1 = cvtpk(P[BASE + 2], P[BASE + 3]); \
    unsigned b0_ = cvtpk(P[BASE + 4], P[BASE + 5]), b1_ = cvtpk(P[BASE + 6], P[BASE + 7]); \
    auto r0_ = __builtin_amdgcn_permlane32_swap(a0, b0_, false, false); auto r1_ = __builtin_amdgcn_permlane32_swap(a1, b1_, false, false); \
    u32x4 w_ = {r0_[0], r1_[0], r0_[1], r1_[1]}; OUT = *reinterpret_cast<bf16x8*>(&w_); } while (0)
        PK4(p0, 0, pa[0]); PK4(p0, 8, pa[1]); PK4(p1, 0, pa[2]); PK4(p1, 8, pa[3]);
#undef PK4
      }
      asm volatile("s_waitcnt lgkmcnt(0)" ::: "memory"); SBAR();
      VREAD_B(j);
      SBAR();
#pragma unroll
      for (int ks = 0; ks < 2; ++ks)
#pragma unroll
        for (int d0 = 0; d0 < 4; ++d0) o[d0] = __builtin_amdgcn_mfma_f32_32x32x16_bf16(pa[ks], PKV(d0 * 4 + ks), o[d0], 0, 0, 0);
      SBAR();
      asm volatile("s_waitcnt lgkmcnt(0)" ::: "memory");
      SBAR();
#pragma unroll
      for (int ks = 2; ks < 4; ++ks)
#pragma unroll
        for (int d0 = 0; d0 < 4; ++d0) o[d0] = __builtin_amdgcn_mfma_f32_32x32x16_bf16(pa[ks], PKV(d0 * 4 + ks), o[d0], 0, 0, 0);
    }
  }
  __builtin_amdgcn_s_setprio(0);
  if (PROBE_SEG && blockIdx.x == 0 && tid == 0) atomicAdd((unsigned long long*)(p.ws + OFF_KMX + 1024), (unsigned long long)seg_acc);
  { auto sw = __builtin_amdgcn_permlane32_swap(__float_as_uint(l_reg), __float_as_uint(l_reg), false, false); l_reg = __uint_as_float(sw[0]) + __uint_as_float(sw[1]); }
#undef ISSUE
#undef KREAD
#undef KRD1
#undef VREAD_A
#undef VREAD_B
#undef VR1
#undef PKV
#undef RESC
#undef WAITV
#undef RBAR
  __syncthreads();
  if (hi == 0) li_l[r32] = l_reg;
  asm volatile("s_waitcnt lgkmcnt(0)" ::: "memory");
  float rli[16];
#pragma unroll
  for (int r = 0; r < 16; ++r) rli[r] = __builtin_amdgcn_rcpf(li_l[crow(r, hi)]);
  const int qtok0 = b * SEQ + qb * 128 + g4 * 32;
  float* X = (float*)smem + g4 * 4096;
  const float lam = ((const float*)(p.ws + OFF_LAM))[layer];
  u32x4 zq[4];
  { const bf16_t* Zp = (const bf16_t*)(p.ws + OFF_Z);
#pragma unroll
    for (int it = 0; it < 4; ++it) { const int idx = it * 128 + cm * 64 + lane; zq[it] = *(const u32x4*)(Zp + (size_t)(qtok0 + (idx >> 4)) * 1024 + h * 128 + (idx & 15) * 8); } }
  {
    float* Xw = X + cm * 16384;
    const float wgt = (cm == 1) ? -lam : 1.0f;
#pragma unroll
    for (int d = 0; d < 4; ++d)
#pragma unroll
      for (int r = 0; r < 16; ++r) Xw[crow(r, hi) * 128 + d * 32 + r32] = wgt * o[d][r] * rli[r];
  }
  __syncthreads();
  {
    const float li = 0.8f - 0.6f * __expf(-0.3f * (float)layer);
    const bf16_t* Z = (const bf16_t*)(p.ws + OFF_Z); bf16_t* Y = (bf16_t*)(p.ws + OFF_Y);
#pragma unroll
    for (int it = 0; it < 4; ++it) {
      const int idx = it * 128 + cm * 64 + lane, row = idx >> 4, ch = idx & 15;
      const f32x4 a = *(const f32x4*)(X + row * 128 + ch * 8) + *(const f32x4*)(X + 16384 + row * 128 + ch * 8), c4 = *(const f32x4*)(X + row * 128 + ch * 8 + 4) + *(const f32x4*)(X + 16384 + row * 128 + ch * 8 + 4);
      float ss = a[0] * a[0] + a[1] * a[1] + a[2] * a[2] + a[3] * a[3] + c4[0] * c4[0] + c4[1] * c4[1] + c4[2] * c4[2] + c4[3] * c4[3];
      ss += __shfl_xor(ss, 1); ss += __shfl_xor(ss, 2); ss += __shfl_xor(ss, 4); ss += __shfl_xor(ss, 8);
      const float rs = rsqrtf(ss * (1.0f / 128.0f) + RMS_EPS) * (1.0f - li);
      const f32x4 g0 = *(const f32x4*)(p.subln + layer * 128 + ch * 8), g1 = *(const f32x4*)(p.subln + layer * 128 + ch * 8 + 4);
      const size_t gi = (size_t)(qtok0 + row) * 1024 + h * 128 + ch * 8;
      const u32x4 z = zq[it];
      u32x4 w;
      w[0] = cvtpk(a[0] * rs * g0[0] * siluf(bflo(z[0])), a[1] * rs * g0[1] * siluf(bfhi(z[0])));
      w[1] = cvtpk(a[2] * rs * g0[2] * siluf(bflo(z[1])), a[3] * rs * g0[3] * siluf(bfhi(z[1])));
      w[2] = cvtpk(c4[0] * rs * g1[0] * siluf(bflo(z[2])), c4[1] * rs * g1[1] * siluf(bfhi(z[2])));
      w[3] = cvtpk(c4[2] * rs * g1[2] * siluf(bflo(z[3])), c4[3] * rs * g1[3] * siluf(bfhi(z[3])));
      *(u32x4*)(Y + gi) = w;
    }
  }
  __syncthreads();
}

DEV void attn_unit_B(const Params& p, int layer, int u) {
  constexpr float C = SCALE * 1.4426950408889634f;
  constexpr float THRRAW = 8.0f / SCALE;
  constexpr int VOFF = 49152;
  const int tid = ltid(), wid = __builtin_amdgcn_readfirstlane(tid >> 6), lane = tid & 63, r32 = lane & 31, hi = lane >> 5;
  LDSC* ldsb = (LDSC*)smem;
  float* wsc = (float*)(smem + 131072) + wid * 64; float* li_l = wsc; float* al_l = wsc + 32;
  const int b = u / 192; int rem = u % 192; const int h = rem / 48; rem %= 48; const int g = rem / 16, uu = rem % 16;
  const int rr = (g == 0) ? 1 : (g == 1 ? 4 : 16), Lsub = SEQ / rr, mres = uu % rr, blk = uu / rr;
  const int qn = blk * 256 + wid * 32 + r32;
  const int qtok = b * SEQ + qn * rr + mres;
  const bf16_t* Qp = (const bf16_t*)(p.ws + OFF_BQ) + (size_t)qtok * 768 + g * 256 + h * 64;
  const char* Kb = p.ws + OFF_BK + (size_t)(g * 256 + h * 64) * 2;
  const char* Vb = p.ws + OFF_BV + (size_t)(g * 256 + h * 64) * 2;
  const int tfirst = (blk == 0) ? 1 : 0; int tl = (Lsub - (blk * 256 - 64)) / 64 - 1; if (tl > 5) tl = 5; const int NT = tl + 1;
  bf16x8 qr[4];
#pragma unroll
  for (int d0 = 0; d0 < 4; ++d0) qr[d0] = *(const bf16x8*)(Qp + d0 * 16 + hi * 8);
  {
    const int krow = 8 * wid + (lane >> 3), kchunk = (lane & 7) ^ ((krow >> 1) & 7);
    const int kk = 8 * wid + ((lane & 31) >> 2), vk = (kk & ~0xC) | ((kk & 4) << 1) | ((kk & 8) >> 1), vc = (lane >> 5) * 32 + (lane & 3) * 8;
    const int n0 = blk * 256 - 64;
    for (int t = tfirst; t < NT; ++t) {
      const size_t ktok = (size_t)(b * SEQ + (n0 + 64 * t + krow) * rr + mres), vtok = (size_t)(b * SEQ + (n0 + 64 * t + vk) * rr + mres);
      __builtin_amdgcn_global_load_lds((const unsigned*)(Kb + ktok * 1536 + kchunk * 16), (__attribute__((address_space(3))) unsigned*)(ldsb + t * 8192 + wid * 1024), 16, 0, 0);
      __builtin_amdgcn_global_load_lds((const unsigned*)(Vb + vtok * 1536 + vc * 2), (__attribute__((address_space(3))) unsigned*)(ldsb + VOFF + t * 8192 + wid * 1024), 16, 0, 0);
    }
  }
  asm volatile("s_waitcnt vmcnt(0)" ::: "memory");
  __syncthreads();
  float m_reg = -1e30f, l_reg = 0.f;
  f32x16 o[2] = {f32x16{}, f32x16{}};
  const int vb0 = (int)(uintptr_t)smem + VOFF + v_rd_base(lane);
  int t0 = wid >> 1; if (t0 < tfirst) t0 = tfirst; int t1 = (wid >> 1) + 2; if (t1 > NT - 1) t1 = NT - 1;
  if (wid >= 4) __builtin_amdgcn_s_setprio(1);
  for (int t = t0; t <= t1; ++t) {
    f32x16 p0 = f32x16{}, p1 = f32x16{};
    const LDSC* Kt = ldsb + t * 8192;
#pragma unroll
    for (int d0 = 0; d0 < 4; ++d0) {
      const int cb = (d0 * 16 + hi * 8) * 2;
      const bf16x8 b0 = *(const __attribute__((address_space(3))) bf16x8*)(Kt + KSWZ_S(r32, cb)), b1 = *(const __attribute__((address_space(3))) bf16x8*)(Kt + KSWZ_S(32 + r32, cb));
      p0 = __builtin_amdgcn_mfma_f32_32x32x16_bf16(b0, qr[d0], p0, 0, 0, 0);
      p1 = __builtin_amdgcn_mfma_f32_32x32x16_bf16(b1, qr[d0], p1, 0, 0, 0);
    }
    { const int tn0 = blk * 256 - 64 + 64 * t;
#pragma unroll
      for (int r = 0; r < 16; ++r) {
        const int d0k = tn0 + crow(r, hi) - qn, d1k = d0k + 32;
        if (d0k > 64 || d0k < -64) p0[r] = -INFINITY;
        if (d1k > 64 || d1k < -64) p1[r] = -INFINITY;
      } }
    float pmax = p0[0];
#pragma unroll
    for (int r = 1; r < 16; ++r) pmax = fmaxf(pmax, p0[r]);
#pragma unroll
    for (int r = 0; r < 16; ++r) pmax = fmaxf(pmax, p1[r]);
    { auto sw = __builtin_amdgcn_permlane32_swap(__float_as_uint(pmax), __float_as_uint(pmax), false, false);
      pmax = fmaxf(__uint_as_float(sw[0]), __uint_as_float(sw[1])); }
    float mn, alpha;
    if (__all(pmax - m_reg <= THRRAW)) { mn = m_reg; alpha = 1.f; }
    else { mn = fmaxf(m_reg, pmax); alpha = __builtin_amdgcn_exp2f((m_reg - mn) * C); m_reg = mn; }
    const float mnC = -mn * C;
    float ps = 0.f;
#pragma unroll
    for (int r = 0; r < 16; ++r) { p0[r] = __builtin_amdgcn_exp2f(fmaf(p0[r], C, mnC)); ps += p0[r]; }
#pragma unroll
    for (int r = 0; r < 16; ++r) { p1[r] = __builtin_amdgcn_exp2f(fmaf(p1[r], C, mnC)); ps += p1[r]; }
    { auto sw = __builtin_amdgcn_permlane32_swap(__float_as_uint(ps), __float_as_uint(ps), false, false);
      ps = __uint_as_float(sw[0]) + __uint_as_float(sw[1]); }
    l_reg = l_reg * alpha + ps;
    bf16x8 pa0, pa1, pa2, pa3;
#define PK4(P, BASE, OUT) do { unsigned a0 = cvtpk(P[BASE + 0], P[BASE + 1]), a1 = cvtpk(P[BASE + 2], P[BASE + 3]); \
    unsigned b0_ = cvtpk(P[BASE + 4], P[BASE + 5]), b1_ = cvtpk(P[BASE + 6], P[BASE + 7]); \
    auto r0_ = __builtin_amdgcn_permlane32_swap(a0, b0_, false, false); auto r1_ = __builtin_amdgcn_permlane32_swap(a1, b1_, false, false); \
    u32x4 w_ = {r0_[0], r1_[0], r0_[1], r1_[1]}; OUT = *reinterpret_cast<bf16x8*>(&w_); } while (0)
    PK4(p0, 0, pa0); PK4(p0, 8, pa1); PK4(p1, 0, pa2); PK4(p1, 8, pa3);
#undef PK4
    if (__any(alpha < 1.f)) {
      if (hi == 0) al_l[r32] = alpha;
      asm volatile("s_waitcnt lgkmcnt(0)" ::: "memory");
#pragma unroll
      for (int r = 0; r < 16; ++r) { const float af = al_l[crow(r, hi)]; o[0][r] *= af; o[1][r] *= af; }
    }
    const int vb = vb0 + t * 8192;
    pv_one<64, 0>(o[0], vb, pa0, pa1, pa2, pa3);
    pv_one<64, 1>(o[1], vb, pa0, pa1, pa2, pa3);
  }
  __builtin_amdgcn_s_setprio(0);
  if (hi == 0) li_l[r32] = l_reg;
  asm volatile("s_waitcnt lgkmcnt(0)" ::: "memory");
  float rli[16];
#pragma unroll
  for (int r = 0; r < 16; ++r) rli[r] = __builtin_amdgcn_rcpf(li_l[crow(r, hi)]);
  bf16_t* OB = (bf16_t*)(p.ws + OFF_BQ);
  float* LSE = (float*)(p.ws + OFF_LSE);
  const int tokw = b * SEQ + (blk * 256 + wid * 32) * rr + mres;
  bf16_t* W = (bf16_t*)(smem + 98304) + wid * 2048;
#pragma unroll
  for (int d = 0; d < 2; ++d)
#pragma unroll
    for (int r = 0; r < 16; ++r) { const float y = o[d][r] * rli[r]; W[crow(r, hi) * 64 + d * 32 + r32] = (bf16_t)(cvtpk(y, y) & 0xffffu); }
  asm volatile("s_waitcnt lgkmcnt(0)" ::: "memory");
#pragma unroll
  for (int it = 0; it < 4; ++it) {
    const int idx = it * 64 + lane, row = idx >> 3, ch = idx & 7;
    const u32x4 w = *(const u32x4*)(W + row * 64 + ch * 8);
    *(u32x4*)(OB + (size_t)(tokw + row * rr) * 768 + g * 256 + h * 64 + ch * 8) = w;
  }
  if (hi == 0) LSE[((size_t)g * T + qtok) * 4 + h] = m_reg * SCALE + __logf(l_reg);
  __syncthreads();
}

DEV void phase_attn_A(const Params& p, int layer, int qsel) {
  for (int u = blockIdx.x; u < 512; u += gridDim.x) attn_unit_A(p, layer, ((u & 7) << 1) | ((u >> 8) & 1), (u >> 3) & 31);
}

DEV void phase_attn(const Params& p_in, int layer) {
  Params p = p_in; { size_t z_ = 0; asm volatile("" : "+s"(z_)); p.ws = p_in.ws + z_; }
  if (PROBE_DBL == 4) { for (int u = blockIdx.x; u < 256; u += gridDim.x) attn_unit<2>(p, layer, u); }
  phase_attn_A(p, layer, layer);
  if (PROBE_DBL == 1) phase_attn_A(p, layer, 2 + layer);
  for (int u = blockIdx.x; u < 768; u += gridDim.x) attn_unit_B(p, layer, u);
  for (int u = blockIdx.x; u < 256; u += gridDim.x) attn_unit<2>(p, layer, u);
}

__global__ void __launch_bounds__(512, 1) mk_forward(Params p) {
  cg::grid_group grid = cg::this_grid();
  unsigned* bar = (unsigned*)(p.ws + OFF_BAR);
  volatile LAS unsigned* st = (volatile LAS unsigned*)(LAS unsigned*)(smem + 131072 + 3968);
  if (threadIdx.x == 0) { st[0] = 0u; st[1] = 0u; }
  if (p.ws == nullptr) grid.sync();
  __syncthreads();
  XcdBarrier xb = xcd_barrier_post(bar, st);
  phase0(p);
  if (PROBE_DBL == 3) phase0(p);
  xcd_barrier(xb);
#pragma unroll 1
  for (int layer = 0; layer < 2; ++layer) {
    const float* xin = layer == 0 ? p.x : p.out;
    phase_norm(p, layer, xin);
    if (PROBE_DBL == 7) phase_norm(p, layer, xin);
    xcd_barrier(xb);
    phase_inproj(p, layer);
    if (PROBE_DBL == 2) phase_inproj(p, layer);
    xcd_barrier(xb);
    phase_attn(p, layer);
    xcd_barrier(xb);
    phase_gates(p);
    if (PROBE_DBL == 5) phase_gates(p);
    xcd_barrier(xb);
    phase_merge(p, layer);
    if (PROBE_DBL == 6) { xcd_barrier(xb); phase_merge(p, layer); }
    xcd_barrier(xb);
    phase_out(p, layer, xin);
    xcd_barrier(xb);
  }
  phase_final(p);
  if (PROBE_SEG && blockIdx.x == 0 && threadIdx.x == 0) {
    const unsigned long long cyc = __hip_atomic_load((unsigned long long*)(p.ws + OFF_KMX + 1024), __ATOMIC_RELAXED, __HIP_MEMORY_SCOPE_AGENT);
    const unsigned long long ticks = cyc / 40;
    const unsigned long long s0 = wall_clock64();
    while (wall_clock64() - s0 < ticks) __builtin_amdgcn_s_sleep(8);
  }
}

extern "C" void kernel_launch(void* const* d_in, const int* in_sizes, int n_in, void* d_out, int out_size, void* d_ws, size_t ws_size, hipStream_t stream) {
  static int grid_blocks = 0;
  if (ws_size < WS_NEED) { fprintf(stderr, "kernel_launch: workspace too small: %zu < %zu\n", ws_size, WS_NEED); return; }
  if (!grid_blocks) {
    int dev = 0, cus = 0, per_cu = 0;
    hipGetDevice(&dev);
    hipDeviceGetAttribute(&cus, hipDeviceAttributeMultiprocessorCount, dev);
    if (hipFuncSetAttribute((const void*)mk_forward, hipFuncAttributeMaxDynamicSharedMemorySize, LDS_BYTES) != hipSuccess) { fprintf(stderr, "kernel_launch: LDS attribute failed\n"); return; }
    hipOccupancyMaxActiveBlocksPerMultiprocessor(&per_cu, mk_forward, 512, LDS_BYTES);
    if (per_cu < 1) { fprintf(stderr, "kernel_launch: occupancy 0\n"); return; }
    grid_blocks = cus;
  }
  Params p{};
  p.x = (const float*)d_in[0]; p.c = (const float*)d_in[1]; p.pos = (const int*)d_in[2]; p.norm_gain = (const float*)d_in[3];
  p.w_ada = (const float*)d_in[4]; p.b_ada = (const float*)d_in[5]; p.w_in = (const float*)d_in[6]; p.diff_lambda = (const float*)d_in[7];
  p.subln = (const float*)d_in[8]; p.rpb = (const float*)d_in[9]; p.w_branch = (const float*)d_in[10]; p.w_out = (const float*)d_in[11];
  p.final_gain = (const float*)d_in[12]; p.out = (float*)d_out; p.ws = (char*)d_ws;
  void* args[] = {&p};
  if (hipMemsetAsync((char*)d_ws + OFF_BAR, 0, WS_NEED - OFF_BAR, stream) != hipSuccess) { fprintf(stderr, "kernel_launch: memset failed\n"); return; }
  hipError_t e = hipLaunchCooperativeKernel((void*)mk_forward, dim3(grid_blocks), dim3(512), args, LDS_BYTES, stream);
  if (e != hipSuccess) fprintf(stderr, "cooperative launch failed: %s (grid %d)\n", hipGetErrorString(e), grid_blocks);
}
```

```cpp
#include <hip/hip_runtime.h>
#include <hip/hip_cooperative_groups.h>
#include <cstdio>
#include <cstdint>
namespace cg = cooperative_groups;

#ifndef INPROJ_SKEW_TICKS
#define INPROJ_SKEW_TICKS 1500ull
#endif
#ifndef PROBE_SEG
#define PROBE_SEG 0
#endif
#ifndef PROBE_DBL
#define PROBE_DBL 0
#endif
#ifndef MK_MULTI
#define MK_MULTI 0
#endif

typedef unsigned short bf16_t;
typedef short bf16x8 __attribute__((ext_vector_type(8)));
typedef short s16x4 __attribute__((ext_vector_type(4)));
typedef float f32x4 __attribute__((ext_vector_type(4)));
typedef float f32x2 __attribute__((ext_vector_type(2)));
typedef float f32x16 __attribute__((ext_vector_type(16)));
typedef unsigned u32x4 __attribute__((ext_vector_type(4)));
typedef unsigned u32x2 __attribute__((ext_vector_type(2)));
#define DEV __device__ __forceinline__

constexpr int T = 16384, SEQ = 4096, DM = 1024, NB = 4;
constexpr int IN_COLS = 8704;
constexpr float RMS_EPS = 1e-6f;
constexpr float SCALE = 0.125f;

constexpr size_t SZ_T1024 = (size_t)T * 1024 * 2;
constexpr size_t OFF_AQK = 0;
constexpr size_t OFF_AK = OFF_AQK + (size_t)T * 512 * 2;
constexpr size_t OFF_AV = OFF_AQK + SZ_T1024;
constexpr size_t OFF_BK = OFF_AV + (size_t)T * 512 * 2;
constexpr size_t OFF_BV = OFF_BK + (size_t)T * 768 * 2;
constexpr size_t OFF_C = OFF_BV + (size_t)T * 768 * 2;
constexpr size_t OFF_BQ = OFF_C + (size_t)T * 768 * 2;
constexpr size_t OFF_Z = OFF_BQ + (size_t)T * 768 * 2;
constexpr size_t OFF_H = OFF_Z + SZ_T1024;
constexpr size_t OFF_Y = OFF_H + SZ_T1024;
constexpr size_t OFF_WIN = OFF_Y + SZ_T1024;
constexpr size_t OFF_WBR = OFF_WIN + (size_t)IN_COLS * 1024 * 2;
constexpr size_t OFF_WOUT = OFF_WBR + (size_t)2 * 1024 * 1024 * 2;
constexpr size_t OFF_LSE = OFF_WOUT + (size_t)2 * 1024 * 1024 * 2;
constexpr size_t OFF_ROPE = OFF_LSE + (size_t)3 * T * 4 * 4;
constexpr size_t OFF_MOD = OFF_ROPE + (size_t)T * 8 * 8;
constexpr size_t OFF_LAM = OFF_MOD + (size_t)2 * 4 * 3072 * 4;
constexpr size_t OFF_BAR = OFF_LAM + 256;
constexpr size_t OFF_CNT = OFF_BAR + 3456 * 4;
constexpr size_t OFF_KMX = OFF_CNT + 256 * 4;
constexpr size_t WS_NEED = OFF_KMX + 128 * 4 + 8192;
constexpr size_t OFF_G = OFF_AQK;

constexpr int LDS_BYTES = 131072 + 4096;

struct Params {
  const float* x; const float* c; const int* pos; const float* norm_gain; const float* w_ada; const float* b_ada; const float* w_in;
  const float* diff_lambda; const float* subln; const float* rpb; const float* w_branch; const float* w_out; const float* final_gain;
  float* out; char* ws;
};

extern __shared__ __attribute__((aligned(16))) char smem[];

DEV unsigned cvtpk(float lo, float hi) { unsigned r; asm volatile("v_cvt_pk_bf16_f32 %0, %1, %2" : "=v"(r) : "v"(lo), "v"(hi)); return r; }
DEV unsigned cvtpk_t(float lo, float hi) { unsigned r; asm volatile("s_nop 1\n\tv_cvt_pk_bf16_f32 %0, %1, %2" : "=v"(r) : "v"(lo), "v"(hi)); return r; }
DEV float bflo(unsigned w) { return __uint_as_float(w << 16); }
DEV float bfhi(unsigned w) { return __uint_as_float(w & 0xffff0000u); }
DEV float bf2f(bf16_t v) { return __uint_as_float(((unsigned)v) << 16); }
DEV float sigmoidf(float x) { return __builtin_amdgcn_rcpf(1.0f + __expf(-x)); }
DEV float sig2(float t) { return __builtin_amdgcn_rcpf(1.0f + __builtin_amdgcn_exp2f(t)); }
DEV float siluf(float x) { return x * __builtin_amdgcn_rcpf(1.0f + __expf(-x)); }
DEV int perm32(int rho) { const int n = rho >> 4, i = rho & 15; return 8 * (i >> 2) + 4 * n + (i & 3); }
DEV int ltid() { int t = threadIdx.x; asm volatile("" : "+v"(t)); return t; }
DEV int lbid() { int t = blockIdx.x; asm volatile("" : "+s"(t)); return t; }
DEV int crow(int r, int hi) { return (r & 3) + 8 * (r >> 2) + 4 * hi; }

#define XB_TMO      128
#define XB_XCNT(j)  (256  + 64 * (j))
#define XB_XSUB(j)  (1280 + 64 * (j))
#define XB_XGEN(j)  (2304 + 64 * (j))
#define XB_TOP      3328
#define XB_TOPGEN   3392
#define XCD_BAR_WORDS 3456
#define XB_SPIN_CAP (1u << 18)
#define LAS __attribute__((address_space(3)))
DEV unsigned xb_ld(unsigned* p) { return __hip_atomic_load(p, __ATOMIC_RELAXED, __HIP_MEMORY_SCOPE_AGENT); }
DEV unsigned xb_add(unsigned* p, unsigned v) { return __hip_atomic_fetch_add(p, v, __ATOMIC_RELAXED, __HIP_MEMORY_SCOPE_AGENT); }
DEV unsigned xb_xcc_id() { return (unsigned)__builtin_amdgcn_s_getreg((3 << 11) | 20) & 0xFu; }
#define XB_SPIN(cond, bar) do { unsigned _sp = 0; while (cond) { __builtin_amdgcn_s_sleep(1); \
    if ((++_sp & 255u) == 0u) { if (xb_ld(&(bar)[XB_TMO])) break; if (_sp > XB_SPIN_CAP) { atomicAdd(&(bar)[XB_TMO], 1u); break; } } } } while (0)
struct XcdBarrier { unsigned* bar; unsigned x; volatile LAS unsigned* st; };
DEV XcdBarrier xcd_barrier_post(unsigned* bar, volatile LAS unsigned* st) {
  XcdBarrier b; b.bar = bar; b.x = xb_xcc_id(); b.st = st;
  if (threadIdx.x == 0) (void)xb_add(&bar[XB_XCNT(b.x)], 1u);
  return b;
}
DEV void xcd_barrier_complete(unsigned* bar, unsigned x, unsigned& nloc, unsigned& nx) {
  const unsigned G = gridDim.x * gridDim.y * gridDim.z;
  unsigned sum, cnt, mine, sp = 0u;
  for (;;) {
    sum = 0u; cnt = 0u; mine = 0u;
#pragma unroll
    for (unsigned j = 0; j < 16; ++j) { const unsigned c = xb_ld(&bar[XB_XCNT(j)]); sum += c; cnt += (c > 0u) ? 1u : 0u; mine = (j == x) ? c : mine; }
    if (sum == G) break;
    __builtin_amdgcn_s_sleep(1);
    if ((++sp & 255u) == 0u) { if (xb_ld(&bar[XB_TMO])) break; if (sp > XB_SPIN_CAP) { atomicAdd(&bar[XB_TMO], 1u); break; } }
  }
  nloc = mine > 0u ? mine : 1u; nx = cnt > 0u ? cnt : 1u;
}
DEV void xcd_barrier(const XcdBarrier& b) {
  asm volatile("s_waitcnt vmcnt(0)" ::: "memory");
  __syncthreads();
  if (threadIdx.x == 0) {
    size_t bz_ = 0; unsigned bx = b.x;
    asm volatile("" : "+s"(bz_), "+s"(bx));
    unsigned* bar = b.bar + bz_;
    __builtin_amdgcn_s_waitcnt(0);
    unsigned nloc = b.st[0], nx = b.st[1];
    if (nloc == 0u) { xcd_barrier_complete(bar, bx, nloc, nx); b.st[0] = nloc; b.st[1] = nx; }
    const unsigned old = xb_add(&bar[XB_XSUB(bx)], 1u);
    const unsigned gen = old / nloc;
    if (old + 1u == (gen + 1u) * nloc) {
      __builtin_amdgcn_fence(__ATOMIC_RELEASE, "agent");
      asm volatile("s_waitcnt vmcnt(0)" ::: "memory");
      const unsigned og = xb_add(&bar[XB_TOP], 1u);
      const unsigned tg = og / nx;
      if (og + 1u == (tg + 1u) * nx) xb_add(&bar[XB_TOPGEN], 1u);
      else XB_SPIN(xb_ld(&bar[XB_TOPGEN]) == tg, bar);
      __builtin_amdgcn_fence(__ATOMIC_ACQUIRE, "agent");
      xb_add(&bar[XB_XGEN(bx)], 1u);
      asm volatile("s_waitcnt vmcnt(0)" ::: "memory");
    } else {
      XB_SPIN(xb_ld(&bar[XB_XGEN(bx)]) == gen, bar);
      __builtin_amdgcn_fence(__ATOMIC_ACQUIRE, "agent");
      asm volatile("s_waitcnt vmcnt(0)" ::: "memory");
    }
  }
  __syncthreads();
}

DEV int win_src_col(int j) {
  const int c = (j & ~31) + perm32(j & 31);
  int orig; bool rope;
  if (c < 1024) { orig = c; rope = true; }
  else if (c < 1536) { orig = c; rope = false; }
  else if (c < 2304) { orig = 2304 + (c - 1536); rope = true; }
  else if (c < 3072) { orig = 3072 + (c - 2304); rope = false; }
  else if (c < 3840) { orig = 3840 + (c - 3072); rope = false; }
  else if (c < 4608) { orig = 1536 + (c - 3840); rope = true; }
  else { orig = c; rope = false; }
  if (rope) { int p = orig & 63; if (p < 16) { const int i = p >> 1; p = (p & 1) ? i + 8 : i; orig = (orig & ~63) + p; } }
  return orig;
}

struct CvtTile { const float* src; int ld; bf16_t* dst; int j0, k0, o0; bool win; };
DEV void cvt_decode(const Params& p, int layer, int t, CvtTile& c) {
  if (t < 2176) { const int kt = t & 15, nt = t >> 4; c.src = p.w_in + (size_t)layer * 1024 * IN_COLS; c.ld = IN_COLS; c.dst = (bf16_t*)(p.ws + OFF_WIN); c.j0 = nt * 64; c.k0 = kt * 64; c.o0 = win_src_col(c.j0) & ~63; c.win = true; }
  else { const int tt0 = t - 2176, mat = tt0 >> 8, tt = tt0 & 255, kt = tt & 15, nt = tt >> 4, l = mat & 1;
    c.src = (mat < 2 ? p.w_branch : p.w_out) + (size_t)l * 1024 * 1024; c.ld = 1024; c.dst = (bf16_t*)(p.ws + (mat < 2 ? OFF_WBR : OFF_WOUT)) + (size_t)l * 1024 * 1024; c.j0 = nt * 64; c.k0 = kt * 64; c.o0 = c.j0; c.win = false; }
}
DEV void cvt_range(const Params& p, int layer, int tbeg, int tend) {
  float* l = (float*)smem;
  const int tid = ltid();
  int t = tbeg + blockIdx.x;
  if (t >= tend) return;
  CvtTile c; cvt_decode(p, layer, t, c);
  f32x4 v0, v1;
  { const int kr = tid >> 4, c4 = (tid & 15) * 4;
    v0 = *(const f32x4*)(c.src + (size_t)(c.k0 + kr) * c.ld + c.o0 + c4); v1 = *(const f32x4*)(c.src + (size_t)(c.k0 + 32 + kr) * c.ld + c.o0 + c4); }
  for (;;) {
    { const int kr = tid >> 4, c4 = (tid & 15) * 4;
      l[kr * 65 + c4 + 0] = v0[0]; l[kr * 65 + c4 + 1] = v0[1]; l[kr * 65 + c4 + 2] = v0[2]; l[kr * 65 + c4 + 3] = v0[3];
      l[(kr + 32) * 65 + c4 + 0] = v1[0]; l[(kr + 32) * 65 + c4 + 1] = v1[1]; l[(kr + 32) * 65 + c4 + 2] = v1[2]; l[(kr + 32) * 65 + c4 + 3] = v1[3]; }
    __syncthreads();
    const int tn = t + gridDim.x; CvtTile cn;
    if (tn < tend) { cvt_decode(p, layer, tn, cn); const int kr = tid >> 4, c4 = (tid & 15) * 4;
      v0 = *(const f32x4*)(cn.src + (size_t)(cn.k0 + kr) * cn.ld + cn.o0 + c4); v1 = *(const f32x4*)(cn.src + (size_t)(cn.k0 + 32 + kr) * cn.ld + cn.o0 + c4); }
    const int jj = tid >> 3, kc = (tid & 7) * 8, j = c.j0 + jj;
    const int oc = (c.win ? win_src_col(j) : ((j & ~31) + perm32(j & 31))) - c.o0;
    const float ws_ = (c.win && j >= 5632) ? -1.4426950408889634f : 1.0f;
    u32x4 w;
    w[0] = cvtpk(l[(kc + 0) * 65 + oc] * ws_, l[(kc + 1) * 65 + oc] * ws_);
    w[1] = cvtpk(l[(kc + 2) * 65 + oc] * ws_, l[(kc + 3) * 65 + oc] * ws_);
    w[2] = cvtpk(l[(kc + 4) * 65 + oc] * ws_, l[(kc + 5) * 65 + oc] * ws_);
    w[3] = cvtpk(l[(kc + 6) * 65 + oc] * ws_, l[(kc + 7) * 65 + oc] * ws_);
    *(u32x4*)(c.dst + (size_t)j * 1024 + c.k0 + kc) = w;
    __syncthreads();
    if (tn >= tend) break;
    t = tn; c = cn;
  }
}
DEV void cvt_win_layer(const Params& p, int layer) { cvt_range(p, layer, 0, 2176); }

DEV void phase0(const Params& p_in) {
  Params p = p_in; { size_t z_ = 0; asm volatile("" : "+s"(z_)); p.ws = p_in.ws + z_; }
  const int tid = ltid();
  cvt_range(p, 0, 0, 3200);
  float* mod = (float*)(p.ws + OFF_MOD);
  if (blockIdx.x < 192) {
    float* cact = (float*)smem; float* l4 = (float*)(smem + 16384);
    for (int i = tid; i < 4096; i += 512) cact[i] = siluf(p.c[i]);
    __syncthreads();
    for (int it = blockIdx.x; it < 192; it += gridDim.x) {
      const int l = it / 96, j0 = (it % 96) * 32, w = tid >> 6, lane = tid & 63, cl = lane & 31, kh = w * 2 + (lane >> 5);
      const float* wa = p.w_ada + (size_t)l * 1024 * 3072 + j0 + cl;
      float a0 = 0.f, a1 = 0.f, a2 = 0.f, a3 = 0.f;
      for (int k = kh * 64; k < kh * 64 + 64; k += 16) {
        float wv[16];
#pragma unroll
        for (int q = 0; q < 16; ++q) wv[q] = wa[(size_t)(k + q) * 3072];
#pragma unroll
        for (int q = 0; q < 16; ++q) { a0 += cact[k + q] * wv[q]; a1 += cact[1024 + k + q] * wv[q]; a2 += cact[2048 + k + q] * wv[q]; a3 += cact[3072 + k + q] * wv[q]; }
      }
      l4[(kh * 4 + 0) * 32 + cl] = a0; l4[(kh * 4 + 1) * 32 + cl] = a1; l4[(kh * 4 + 2) * 32 + cl] = a2; l4[(kh * 4 + 3) * 32 + cl] = a3;
      __syncthreads();
      if (tid < 128) {
        const int b = tid >> 5, c2 = tid & 31; float s = 0.f;
        for (int q = 0; q < 16; ++q) s += l4[(q * 4 + b) * 32 + c2];
        mod[((size_t)l * 4 + b) * 3072 + j0 + c2] = s + p.b_ada[l * 3072 + j0 + c2];
      }
      __syncthreads();
    }
  }
  f32x2* rope = (f32x2*)(p.ws + OFF_ROPE);
  for (int i = blockIdx.x * 512 + tid; i < T * 8; i += gridDim.x * 512) {
    const int tok = i >> 3, fi = i & 7;
    float inv;
    switch (fi) { case 0: inv = 1.0f; break; case 1: inv = 0.1939227432012558f; break; case 2: inv = 0.03760603070259094f; break; case 3: inv = 0.007292664609849453f; break;
                  case 4: inv = 0.0014142135623842478f; break; case 5: inv = 0.00027424818836152554f; break; case 6: inv = 5.318296098266728e-05f; break; default: inv = 1.0313386155758053e-05f; break; }
    const float angf = (float)p.pos[tok] * inv;
    const double a = (double)angf;
    const double q = rint(a * 0.63661977236758134308);
    double r = fma(-q, 1.57079632679489655800, a); r = fma(-q, 6.12323399573676603587e-17, r);
    const int n = ((int)q) & 3;
    const double r2 = r * r;
    const double sn = r + r * r2 * (-1.0 / 6 + r2 * (1.0 / 120 + r2 * (-1.0 / 5040 + r2 * (1.0 / 362880 - r2 * (1.0 / 39916800)))));
    const double cs = 1.0 + r2 * (-0.5 + r2 * (1.0 / 24 + r2 * (-1.0 / 720 + r2 * (1.0 / 40320 + r2 * (-1.0 / 3628800 + r2 * (1.0 / 479001600))))));
    double co, si;
    if (n == 0) { co = cs; si = sn; } else if (n == 1) { co = -sn; si = cs; } else if (n == 2) { co = -cs; si = -sn; } else { co = sn; si = -cs; }
    rope[i] = (f32x2){(float)co, (float)si};
  }
  if (blockIdx.x == 0 && tid < 2) {
    const float* dl = p.diff_lambda + tid * 256;
    float s1 = 0.f, s2 = 0.f;
    for (int i = 0; i < 64; ++i) { s1 += dl[i] * dl[64 + i]; s2 += dl[128 + i] * dl[192 + i]; }
    const float li = 0.8f - 0.6f * expf(-0.3f * (float)tid);
    ((float*)(p.ws + OFF_LAM))[tid] = expf(s1) - expf(s2) + li;
  }
}

DEV void phase_norm(const Params& p_in, int layer, const float* __restrict__ xin) {
  Params p = p_in; { size_t z_ = 0; asm volatile("" : "+s"(z_)); p.ws = p_in.ws + z_; }
  const int tid_ = ltid(); const int wid = tid_ >> 6, lane = tid_ & 63;
  const float* mod = (const float*)(p.ws + OFF_MOD) + (size_t)layer * 4 * 3072;
  const float* gain = p.norm_gain + layer * 1024;
  bf16_t* H = (bf16_t*)(p.ws + OFF_H);
  for (int row = blockIdx.x * 8 + wid; row < T; row += gridDim.x * 16) {
    const int rowB = row + gridDim.x * 8; const bool hasB = rowB < T;
    const float* xr = xin + (size_t)row * 1024; const float* xrB = xin + (size_t)(hasB ? rowB : row) * 1024;
    f32x4 v[4], vB[4]; float ss = 0.f, ssB = 0.f;
#pragma unroll
    for (int i = 0; i < 4; ++i) { v[i] = *(const f32x4*)(xr + i * 256 + lane * 4); vB[i] = *(const f32x4*)(xrB + i * 256 + lane * 4); }
#pragma unroll
    for (int i = 0; i < 4; ++i) { ss += v[i][0] * v[i][0] + v[i][1] * v[i][1] + v[i][2] * v[i][2] + v[i][3] * v[i][3]; ssB += vB[i][0] * vB[i][0] + vB[i][1] * vB[i][1] + vB[i][2] * vB[i][2] + vB[i][3] * vB[i][3]; }
#pragma unroll
    for (int o = 32; o > 0; o >>= 1) { ss += __shfl_xor(ss, o); ssB += __shfl_xor(ssB, o); }
    const float rstd = rsqrtf(ss * (1.0f / 1024.0f) + RMS_EPS), rstdB = rsqrtf(ssB * (1.0f / 1024.0f) + RMS_EPS);
    const int b = row >> 12, bB = (hasB ? rowB : row) >> 12;
#pragma unroll
    for (int i = 0; i < 4; ++i) {
      const int c = i * 256 + lane * 4;
      const f32x4 g = *(const f32x4*)(gain + c);
      { const f32x4 sh = *(const f32x4*)(mod + b * 3072 + c), sc = *(const f32x4*)(mod + b * 3072 + 1024 + c);
        float h0 = v[i][0] * rstd * g[0] * (1.f + sc[0]) + sh[0], h1 = v[i][1] * rstd * g[1] * (1.f + sc[1]) + sh[1];
        float h2 = v[i][2] * rstd * g[2] * (1.f + sc[2]) + sh[2], h3 = v[i][3] * rstd * g[3] * (1.f + sc[3]) + sh[3];
        u32x2 w; w[0] = cvtpk(h0, h1); w[1] = cvtpk(h2, h3);
        *(u32x2*)(H + (size_t)row * 1024 + c) = w; }
      if (hasB) { const f32x4 sh = *(const f32x4*)(mod + bB * 3072 + c), sc = *(const f32x4*)(mod + bB * 3072 + 1024 + c);
        float h0 = vB[i][0] * rstdB * g[0] * (1.f + sc[0]) + sh[0], h1 = vB[i][1] * rstdB * g[1] * (1.f + sc[1]) + sh[1];
        float h2 = vB[i][2] * rstdB * g[2] * (1.f + sc[2]) + sh[2], h3 = vB[i][3] * rstdB * g[3] * (1.f + sc[3]) + sh[3];
        u32x2 w; w[0] = cvtpk(h0, h1); w[1] = cvtpk(h2, h3);
        *(u32x2*)(H + (size_t)rowB * 1024 + c) = w; }
    }
  }
}

DEV void phase_final(const Params& p_in) {
  Params p = p_in; { size_t z_ = 0; asm volatile("" : "+s"(z_)); p.ws = p_in.ws + z_; }
  const int tid_ = ltid(); const int wid = tid_ >> 6, lane = tid_ & 63;
  for (int row = blockIdx.x * 8 + wid; row < T; row += gridDim.x * 8) {
    float* xr = p.out + (size_t)row * 1024;
    f32x4 v[4]; float ss = 0.f;
#pragma unroll
    for (int i = 0; i < 4; ++i) { v[i] = *(const f32x4*)(xr + i * 256 + lane * 4); ss += v[i][0] * v[i][0] + v[i][1] * v[i][1] + v[i][2] * v[i][2] + v[i][3] * v[i][3]; }
#pragma unroll
    for (int o = 32; o > 0; o >>= 1) ss += __shfl_xor(ss, o);
    const float rstd = rsqrtf(ss * (1.0f / 1024.0f) + RMS_EPS);
#pragma unroll
    for (int i = 0; i < 4; ++i) {
      const int c = i * 256 + lane * 4;
      const f32x4 g = *(const f32x4*)(p.final_gain + c);
      f32x4 o; o[0] = v[i][0] * rstd * g[0]; o[1] = v[i][1] * rstd * g[1]; o[2] = v[i][2] * rstd * g[2]; o[3] = v[i][3] * rstd * g[3];
      *(f32x4*)(xr + c) = o;
    }
  }
}

constexpr int HALF = 128, BK = 64, HT = HALF * BK;
DEV int lds_byte(int r, int c) { const int st = (r >> 4) * 2 + (c >> 5), rr = r & 15, cc = c & 31, ob = rr * 64 + cc * 2; return st * 1024 + (ob ^ (((ob >> 9) & 1) << 5)); }
DEV void stage_rc(int b, int& R, int& C) { const int st = b / 1024, sb = b % 1024, swz = sb ^ (((sb >> 9) & 1) << 5); R = (st >> 1) * 16 + swz / 64; C = (st & 1) * 32 + (swz % 64) / 2; }

DEV bool gemm_next(int i, int nM, int nN, int& pm, int& pn) {
  const int nwg = nM * nN; const long L = (long)i * gridDim.x + blockIdx.x; if (L >= nwg) return false;
  int wgid = (int)L; { const int q = nwg / 8, r = nwg % 8, xcd = wgid % 8, off = wgid / 8; wgid = (xcd < r ? xcd * (q + 1) : r * (q + 1) + (xcd - r) * q) + off; }
  const int nig = 8 * nN, gid = wgid / nig, fm = gid * 8, gsz = (nM - fm) < 8 ? (nM - fm) : 8;
  pm = fm + ((wgid % nig) % gsz); pn = (wgid % nig) / gsz; return true;
}

struct GUnit { const char* a; const char* b; int nt, pm, pn, s; };
typedef __attribute__((address_space(3))) unsigned char LDSC;
template <class Next, class Epi>
DEV void gemm_stream(Next&& next, Epi&& epi) {
  LDSC* lds = (LDSC*)smem;
  const int tid = ltid(), wid = __builtin_amdgcn_readfirstlane(tid >> 6), lane = tid & 63, wr = wid >> 2, wc = wid & 3, fr = lane & 15, fq = lane >> 4;
  unsigned voff[2];
#pragma unroll
  for (int i = 0; i < 2; ++i) { int R, C; stage_rc(tid * 16 + i * 8192, R, C); voff[i] = (unsigned)(R * 1024 + C) * 2u; }
  constexpr size_t kstep = 128, hstep = (size_t)128 * 1024 * 2;
  constexpr int HTB = 128 * 64 * 2;
  const unsigned ldsw = (unsigned)wid * 1024u;
  const int aoff = lds_byte(wr * 64 + fr, fq * 8), boff = lds_byte(wc * 32 + fr, fq * 8);
#define G_SA(b, h) (((b) * 2 + (h)) * HTB)
#define G_SB(b, h) ((4 + (b) * 2 + (h)) * HTB)
#define G_STAGE(bufoff, gbase) do { _Pragma("unroll") for (int _i = 0; _i < 2; ++_i) \
    __builtin_amdgcn_global_load_lds((const unsigned*)((const char*)(gbase) + voff[_i]), (__attribute__((address_space(3))) unsigned*)(lds + (bufoff) + ldsw + _i * 8192), 16, 0, 0); } while (0)
#define G_LDA(dst, b, h) do { _Pragma("unroll") for (int m = 0; m < 4; ++m) _Pragma("unroll") for (int k = 0; k < 2; ++k) dst[m][k] = *(const __attribute__((address_space(3))) bf16x8*)(lds + G_SA(b, h) + aoff + m * 2048 + k * 1024); } while (0)
#define G_LDB(dst, b, h) do { _Pragma("unroll") for (int n = 0; n < 2; ++n) _Pragma("unroll") for (int k = 0; k < 2; ++k) dst[n][k] = *(const __attribute__((address_space(3))) bf16x8*)(lds + G_SB(b, h) + boff + n * 2048 + k * 1024); } while (0)
#define G_MMA(ai, bj, At, Bf) do { __builtin_amdgcn_s_setprio(1); _Pragma("unroll") for (int m = 0; m < 4; ++m) _Pragma("unroll") for (int n = 0; n < 2; ++n) _Pragma("unroll") for (int k = 0; k < 2; ++k) \
    acc[ai][bj][m][n] = __builtin_amdgcn_mfma_f32_16x16x32_bf16(Bf[n][k], At[m][k], acc[ai][bj][m][n], 0, 0, 0); __builtin_amdgcn_s_setprio(0); } while (0)
#define G_WAIT_V(n) asm volatile("s_waitcnt vmcnt(" #n ")" ::: "memory")
#define G_WAIT_L(n) asm volatile("s_waitcnt lgkmcnt(" #n ")" ::: "memory")
#define G_BAR __builtin_amdgcn_s_barrier()
#define G_SCHED __builtin_amdgcn_sched_barrier(0)
  GUnit cur, nxt; int ui = 0;
  if (!next(0, cur)) return;
  f32x4 acc[2][2][4][2];
#pragma unroll
  for (int a = 0; a < 2; ++a)
#pragma unroll
    for (int b = 0; b < 2; ++b)
#pragma unroll
      for (int m = 0; m < 4; ++m)
#pragma unroll
        for (int n = 0; n < 2; ++n) acc[a][b][m][n] = (f32x4){0.f, 0.f, 0.f, 0.f};
  bf16x8 At[4][2], B0[2][2], B1[2][2];
  const char* cA = cur.a; const char* cB = cur.b;
  G_STAGE(G_SB(0, 0), cB); G_STAGE(G_SA(0, 0), cA); G_STAGE(G_SB(0, 1), cB + hstep); G_STAGE(G_SA(0, 1), cA + hstep);
  if (wr == 1) G_BAR;
  G_WAIT_V(4); G_BAR;
  G_STAGE(G_SB(1, 0), cB + kstep); G_STAGE(G_SA(1, 0), cA + kstep); G_STAGE(G_SB(1, 1), cB + hstep + kstep);
  G_WAIT_V(6); G_BAR;
  for (;;) {
    const bool has_next = next(ui + 1, nxt);
    const char* nA = has_next ? nxt.a : cA; const char* nB = has_next ? nxt.b : cB;
    const int nt = cur.nt;
    for (int t = 0; t < nt; t += 2) {
      const bool last = (t == nt - 2);
      const char* a1 = cA + (size_t)(t + 1) * kstep;
      const char* a2 = last ? nA : cA + (size_t)(t + 2) * kstep; const char* b2 = last ? nB : cB + (size_t)(t + 2) * kstep;
      const char* a3 = a2 + kstep; const char* b3 = b2 + kstep;
      G_LDB(B0, 0, 0); G_SCHED; G_LDA(At, 0, 0); G_STAGE(G_SA(1, 1), a1 + hstep);
      G_WAIT_L(8); G_BAR; G_WAIT_L(0); G_MMA(0, 0, At, B0); G_BAR; G_SCHED;
      G_LDB(B1, 0, 1); G_STAGE(G_SB(0, 0), b2);
      G_BAR; G_WAIT_L(0); G_MMA(0, 1, At, B1); G_BAR;
      G_LDA(At, 0, 1); G_STAGE(G_SA(0, 0), a2);
      G_BAR; G_WAIT_L(0); G_MMA(1, 0, At, B0); G_BAR; G_SCHED;
      G_STAGE(G_SB(0, 1), b2 + hstep);
      G_WAIT_V(6); G_BAR; G_MMA(1, 1, At, B1); G_BAR;
      G_LDB(B0, 1, 0); G_SCHED; G_LDA(At, 1, 0); G_STAGE(G_SA(0, 1), a2 + hstep);
      G_WAIT_L(8); G_BAR; G_WAIT_L(0); G_MMA(0, 0, At, B0); G_BAR; G_SCHED;
      G_LDB(B1, 1, 1); G_STAGE(G_SB(1, 0), b3);
      G_BAR; G_WAIT_L(0); G_MMA(0, 1, At, B1); G_BAR;
      G_LDA(At, 1, 1); G_STAGE(G_SA(1, 0), a3);
      G_BAR; G_WAIT_L(0); G_MMA(1, 0, At, B0); G_BAR; G_SCHED;
      G_STAGE(G_SB(1, 1), b3 + hstep);
      G_WAIT_V(6); G_BAR; G_MMA(1, 1, At, B1); G_BAR;
    }
    epi(acc, cur, wr, wc, fr, fq);
    if (!has_next) break;
#pragma unroll
    for (int a = 0; a < 2; ++a)
#pragma unroll
      for (int b = 0; b < 2; ++b)
#pragma unroll
        for (int m = 0; m < 4; ++m)
#pragma unroll
          for (int n = 0; n < 2; ++n) acc[a][b][m][n] = (f32x4){0.f, 0.f, 0.f, 0.f};
    cur = nxt; cA = nA; cB = nB; ++ui;
  }
  G_WAIT_V(0);
  if (wr == 0) G_BAR;
  G_BAR;
#undef G_SA
#undef G_SB
#undef G_STAGE
#undef G_LDA
#undef G_LDB
#undef G_MMA
}

DEV void phase_inproj(const Params& p_in, int layer) {
  Params p = p_in; { size_t z_ = 0; asm volatile("" : "+s"(z_)); p.ws = p_in.ws + z_; }
  const char* H = p.ws + OFF_H;
  const char* W = p.ws + OFF_WIN;
  const f32x4* rope = (const f32x4*)(p.ws + OFF_ROPE);
  char* ws = p.ws;
  if (5 * (int)gridDim.x + (int)blockIdx.x >= 1408) { __builtin_amdgcn_s_sleep(127); __builtin_amdgcn_s_sleep(127); __builtin_amdgcn_s_sleep(127); __builtin_amdgcn_s_sleep(127); }
  __syncthreads();
  gemm_stream([&](int i, GUnit& u) -> bool {
      int pm, pn; if (!gemm_next(i, 64, 22, pm, pn)) return false;
      u.a = H + (size_t)pm * 256 * 2048; u.b = W + (size_t)pn * 256 * 2048; u.nt = 16; u.pm = pm; u.pn = pn; u.s = 0; return true; },
    [&](f32x4 (&acc)[2][2][4][2], const GUnit& u, int wr, int wc, int fr, int fq) {
      const int c0 = u.pn * 256;
      size_t base; int ld, lc; bool rp;
      const int akv = (c0 >= 512 && c0 < 1536) ? 1 : 0;
      if (c0 < 512) { base = OFF_AQK; ld = 512; lc = c0; rp = true; }
      else if (c0 < 1024) { base = OFF_AK; ld = 128; lc = 0; rp = true; }
      else if (c0 < 1536) { base = OFF_AV; ld = 128; lc = 0; rp = false; }
      else if (c0 < 2304) { base = OFF_BK; ld = 768; lc = c0 - 1536; rp = true; }
      else if (c0 < 3072) { base = OFF_BV; ld = 768; lc = c0 - 2304; rp = false; }
      else if (c0 < 3840) { base = OFF_C; ld = 768; lc = c0 - 3072; rp = false; }
      else if (c0 < 4608) { base = OFF_BQ; ld = 768; lc = c0 - 3840; rp = true; }
      else { base = OFF_Z; ld = 1024; lc = c0 - 4608; rp = false; }
      bf16_t* dst = (bf16_t*)(ws + base);
      const bool dorope = rp && ((wc & 1) == 0) && (fq < 2);
      const bool isk = (c0 >= 512 && c0 < 1024);
      const int head0 = ((c0 >> 8) & 1) * 2;
      float kmx0 = 0.f, kmx1 = 0.f;
      const bool ropewave = rp && ((wc & 1) == 0);
#pragma unroll
      for (int ai = 0; ai < 2; ++ai) {
        f32x4 csA[4], csB[4];
        if (ropewave) {
#pragma unroll
          for (int m = 0; m < 4; ++m) { const size_t ri = (size_t)(u.pm * 256 + ai * 128 + wr * 64 + m * 16 + fr) * 4 + (fq & 1) * 2; csA[m] = rope[ri]; csB[m] = rope[ri + 1]; }
          asm volatile("" ::: "memory");
        }
#pragma unroll
        for (int m = 0; m < 4; ++m) {
          const int row = u.pm * 256 + ai * 128 + wr * 64 + m * 16 + fr;
          f32x4 cs0 = {1.f, 0.f, 1.f, 0.f}, cs1 = {1.f, 0.f, 1.f, 0.f};
          if (dorope) { cs0 = csA[m]; cs1 = csB[m]; }
#pragma unroll
          for (int bj = 0; bj < 2; ++bj) {
            f32x4 v0 = acc[ai][bj][m][0], v1 = acc[ai][bj][m][1];
            if (dorope) {
              f32x4 a, b;
              a[0] = v0[0] * cs0[0] - v0[1] * cs0[1]; a[1] = v0[1] * cs0[0] + v0[0] * cs0[1];
              a[2] = v0[2] * cs0[2] - v0[3] * cs0[3]; a[3] = v0[3] * cs0[2] + v0[2] * cs0[3];
              b[0] = v1[0] * cs1[0] - v1[1] * cs1[1]; b[1] = v1[1] * cs1[0] + v1[0] * cs1[1];
              b[2] = v1[2] * cs1[2] - v1[3] * cs1[3]; b[3] = v1[3] * cs1[2] + v1[2] * cs1[3];
              v0 = a; v1 = b;
            }
            u32x4 w; w[0] = cvtpk(v0[0], v0[1]); w[1] = cvtpk(v0[2], v0[3]); w[2] = cvtpk(v1[0], v1[1]); w[3] = cvtpk(v1[2], v1[3]);
            if (akv) *(u32x4*)(dst + ((size_t)(((row >> 12) * 4 + head0 + bj) * SEQ + (row & 4095))) * 128 + wc * 32 + fq * 8) = w;
            else *(u32x4*)(dst + (size_t)row * ld + lc + bj * 128 + wc * 32 + fq * 8) = w;
            if (isk) {
              float s = v0[0] * v0[0] + v0[1] * v0[1] + v0[2] * v0[2] + v0[3] * v0[3] + v1[0] * v1[0] + v1[1] * v1[1] + v1[2] * v1[2] + v1[3] * v1[3];
              s += __shfl_xor(s, 16); s += __shfl_xor(s, 32);
              if (bj == 0) kmx0 = fmaxf(kmx0, s); else kmx1 = fmaxf(kmx1, s);
            }
          }
        }
      }
      if (isk) {
#pragma unroll
        for (int o_ = 1; o_ < 16; o_ <<= 1) { kmx0 = fmaxf(kmx0, __shfl_xor(kmx0, o_)); kmx1 = fmaxf(kmx1, __shfl_xor(kmx1, o_)); }
        if ((threadIdx.x & 63) == 0) {
          unsigned* kmx = (unsigned*)(ws + OFF_KMX) + layer * 64 + (u.pm >> 4) * 16 + (wc >> 1) * 2 + (wc & 1);
          atomicMax(kmx + (head0 + 0) * 4, __float_as_uint(kmx0));
          atomicMax(kmx + (head0 + 1) * 4, __float_as_uint(kmx1));
        }
      }
    });
}

DEV void phase_gates(const Params& p_in) {
  Params p = p_in; { size_t z_ = 0; asm volatile("" : "+s"(z_)); p.ws = p_in.ws + z_; }
  const char* H = p.ws + OFF_H;
  const char* W = p.ws + OFF_WIN + (size_t)5632 * 2048;
  bf16_t* G = (bf16_t*)(p.ws + OFF_G);
  __syncthreads();
  gemm_stream([&](int i, GUnit& u) -> bool {
      int pm, pn; if (!gemm_next(i, 64, 12, pm, pn)) return false;
      u.a = H + (size_t)pm * 256 * 2048; u.b = W + (size_t)pn * 256 * 2048; u.nt = 16; u.pm = pm; u.pn = pn; u.s = 0; return true; },
    [&](f32x4 (&acc)[2][2][4][2], const GUnit& u, int wr, int wc, int fr, int fq) {
#pragma unroll
      for (int ai = 0; ai < 2; ++ai)
#pragma unroll
        for (int m = 0; m < 4; ++m) {
          const int row = u.pm * 256 + ai * 128 + wr * 64 + m * 16 + fr;
#pragma unroll
          for (int bj = 0; bj < 2; ++bj) {
            const f32x4 v0 = acc[ai][bj][m][0], v1 = acc[ai][bj][m][1];
            u32x4 w; w[0] = cvtpk_t(sig2(v0[0]), sig2(v0[1])); w[1] = cvtpk_t(sig2(v0[2]), sig2(v0[3]));
            w[2] = cvtpk_t(sig2(v1[0]), sig2(v1[1])); w[3] = cvtpk_t(sig2(v1[2]), sig2(v1[3]));
            *(u32x4*)(G + (size_t)row * 3072 + u.pn * 256 + bj * 128 + wc * 32 + fq * 8) = w;
          }
        }
    });
  __syncthreads();
  {
    const bf16_t* OB = (const bf16_t*)(p.ws + OFF_BQ);
    const float* LSE = (const float*)(p.ws + OFF_LSE);
    const bf16_t* Z = (const bf16_t*)(p.ws + OFF_Z);
    bf16_t* Y = (bf16_t*)(p.ws + OFF_Y);
    const int i0 = blockIdx.x * 512 + ltid(), istep = gridDim.x * 512;
    for (int ib = i0; ib < T * 32; ib += 4 * istep) {
      float l0[4], l1[4], l2[4]; u32x4 a[4], b[4], c[4], z[4];
#pragma unroll
      for (int k = 0; k < 4; ++k) {
        const int i = ib + k * istep;
        if (i < T * 32) {
          const int tok = i >> 5, hs = (i >> 3) & 3, dc = (i & 7) * 8;
          l0[k] = LSE[((size_t)0 * T + tok) * 4 + hs]; l1[k] = LSE[((size_t)1 * T + tok) * 4 + hs]; l2[k] = LSE[((size_t)2 * T + tok) * 4 + hs];
          a[k] = *(const u32x4*)(OB + (size_t)tok * 768 + 0 * 256 + hs * 64 + dc);
          b[k] = *(const u32x4*)(OB + (size_t)tok * 768 + 1 * 256 + hs * 64 + dc);
          c[k] = *(const u32x4*)(OB + (size_t)tok * 768 + 2 * 256 + hs * 64 + dc);
          z[k] = *(const u32x4*)(Z + (size_t)tok * 1024 + 512 + hs * 64 + dc);
        }
      }
#pragma unroll
      for (int k = 0; k < 4; ++k) {
        const int i = ib + k * istep;
        if (i < T * 32) {
          const int tok = i >> 5, hs = (i >> 3) & 3, dc = (i & 7) * 8;
          const float mx = fmaxf(l0[k], fmaxf(l1[k], l2[k]));
          float e0 = __expf(l0[k] - mx), e1 = __expf(l1[k] - mx), e2 = __expf(l2[k] - mx);
          const float inv = __builtin_amdgcn_rcpf(e0 + e1 + e2); e0 *= inv; e1 *= inv; e2 *= inv;
          u32x4 w;
#pragma unroll
          for (int q = 0; q < 4; ++q) {
            const float lo = (e0 * bflo(a[k][q]) + e1 * bflo(b[k][q]) + e2 * bflo(c[k][q])) * siluf(bflo(z[k][q]));
            const float hi = (e0 * bfhi(a[k][q]) + e1 * bfhi(b[k][q]) + e2 * bfhi(c[k][q])) * siluf(bfhi(z[k][q]));
            w[q] = cvtpk(lo, hi);
          }
          *(u32x4*)(Y + (size_t)tok * 1024 + 512 + hs * 64 + dc) = w;
        }
      }
    }
  }
}

DEV void phase_merge(const Params& p_in, int layer) {
  Params p = p_in; { size_t z_ = 0; asm volatile("" : "+s"(z_)); p.ws = p_in.ws + z_; }
  const char* Y = p.ws + OFF_Y;
  const char* W = p.ws + OFF_WBR + (size_t)layer * 1024 * 2048;
  const bf16_t* G = (const bf16_t*)(p.ws + OFF_G);
  bf16_t* M = (bf16_t*)(p.ws + OFF_H);
  __syncthreads();
  gemm_stream([&](int i, GUnit& u) -> bool {
      const int uu = i / 3, s = i - uu * 3;
      int pm, pn; if (!gemm_next(uu, 64, 4, pm, pn)) return false;
      const int koff = (s == 0) ? 0 : (s == 1 ? 512 : 768);
      u.a = Y + (size_t)pm * 256 * 2048 + koff * 2; u.b = W + (size_t)pn * 256 * 2048 + koff * 2; u.nt = (s == 0) ? 8 : 4; u.pm = pm; u.pn = pn; u.s = s; return true; },
    [&](f32x4 (&acc)[2][2][4][2], const GUnit& u, int wr, int wc, int fr, int fq) {
      const int s = u.s;
#pragma unroll
      for (int ai = 0; ai < 2; ++ai) {
        u32x4 gq[4][2], oq[4][2];
#pragma unroll
        for (int m = 0; m < 4; ++m)
#pragma unroll
          for (int bj = 0; bj < 2; ++bj) {
            const int row = u.pm * 256 + ai * 128 + wr * 64 + m * 16 + fr, col = u.pn * 256 + bj * 128 + wc * 32 + fq * 8;
            gq[m][bj] = *(const u32x4*)(G + (size_t)row * 3072 + s * 1024 + col);
            oq[m][bj] = (u32x4){0u, 0u, 0u, 0u};
            if (s > 0) oq[m][bj] = *(const u32x4*)(M + (size_t)row * 1024 + col);
          }
        asm volatile("" ::: "memory");
#pragma unroll
        for (int m = 0; m < 4; ++m)
#pragma unroll
          for (int bj = 0; bj < 2; ++bj) {
            const int row = u.pm * 256 + ai * 128 + wr * 64 + m * 16 + fr, col = u.pn * 256 + bj * 128 + wc * 32 + fq * 8;
            const u32x4 g = gq[m][bj], old = oq[m][bj];
            const f32x4 v0 = acc[ai][bj][m][0], v1 = acc[ai][bj][m][1];
            u32x4 w;
            w[0] = cvtpk(bflo(old[0]) + bflo(g[0]) * v0[0], bfhi(old[0]) + bfhi(g[0]) * v0[1]);
            w[1] = cvtpk(bflo(old[1]) + bflo(g[1]) * v0[2], bfhi(old[1]) + bfhi(g[1]) * v0[3]);
            w[2] = cvtpk(bflo(old[2]) + bflo(g[2]) * v1[0], bfhi(old[2]) + bfhi(g[2]) * v1[1]);
            w[3] = cvtpk(bflo(old[3]) + bflo(g[3]) * v1[2], bfhi(old[3]) + bfhi(g[3]) * v1[3]);
            *(u32x4*)(M + (size_t)row * 1024 + col) = w;
          }
      }
    });
}

DEV void phase_out(const Params& p_in, int layer, const float* __restrict__ xin) {
  Params p = p_in; { size_t z_ = 0; asm volatile("" : "+s"(z_)); p.ws = p_in.ws + z_; }
  const char* M = p.ws + OFF_H;
  const char* W = p.ws + OFF_WOUT + (size_t)layer * 1024 * 2048;
  const float* mod = (const float*)(p.ws + OFF_MOD) + (size_t)layer * 4 * 3072 + 2048;
  float* out = p.out;
  __syncthreads();
  gemm_stream([&](int i, GUnit& u) -> bool {
      int pm, pn; if (!gemm_next(i, 64, 4, pm, pn)) return false;
      u.a = M + (size_t)pm * 256 * 2048; u.b = W + (size_t)pn * 256 * 2048; u.nt = 16; u.pm = pm; u.pn = pn; u.s = 0; return true; },
    [&](f32x4 (&acc)[2][2][4][2], const GUnit& u, int wr, int wc, int fr, int fq) {
      const int b = u.pm >> 4;
#pragma unroll
      for (int bj = 0; bj < 2; ++bj) {
        const int col = u.pn * 256 + bj * 128 + wc * 32 + fq * 8;
        const f32x4 g0 = *(const f32x4*)(mod + b * 3072 + col), g1 = *(const f32x4*)(mod + b * 3072 + col + 4);
#pragma unroll
        for (int ai = 0; ai < 2; ++ai)
#pragma unroll
          for (int m = 0; m < 4; ++m) {
            const int row = u.pm * 256 + ai * 128 + wr * 64 + m * 16 + fr;
            const f32x4 x0 = *(const f32x4*)(xin + (size_t)row * 1024 + col), x1 = *(const f32x4*)(xin + (size_t)row * 1024 + col + 4);
            *(f32x4*)(out + (size_t)row * 1024 + col) = x0 + g0 * acc[ai][bj][m][0];
            *(f32x4*)(out + (size_t)row * 1024 + col + 4) = x1 + g1 * acc[ai][bj][m][1];
          }
      }
    });
  __syncthreads();
  if (layer == 0) cvt_win_layer(p, 1);
}

#define KSWZ_A(row, colB) ((row) * 256 + ((colB) ^ (((row) & 7) << 4)))
#define KSWZ_S(row, colB) ((row) * 128 + ((colB) ^ ((((row) >> 1) & 7) << 4)))
template <int DV> DEV int v_st(int k, int c) { const int kk = (k & ~0xC) | ((k & 4) << 1) | ((k & 8) >> 1); return ((kk >> 3) * (DV / 32) + (c >> 5)) * 512 + ((kk & 7) * 32 + (c & 31)) * 2; }
DEV int v_rd_base(int lane) { return ((lane & 3) << 3) | (((lane >> 2) & 3) << 6) | (((lane >> 4) & 1) << 5) | (((lane >> 5) & 1) << 8); }
template <int OFF> DEV s16x4 tr_read(int vb) { s16x4 r; asm volatile("ds_read_b64_tr_b16 %0, %1 offset:%2" : "=&v"(r) : "v"(vb), "i"(OFF) : "memory"); return r; }
template <int DV, int D0> DEV void pv_one(f32x16& od, int vb, bf16x8 pa0, bf16x8 pa1, bf16x8 pa2, bf16x8 pa3) {
  constexpr int KS = (DV / 32) * 1024, HF = (DV / 32) * 512;
  const s16x4 l0 = tr_read<D0 * 512 + 0 * KS>(vb), h0 = tr_read<D0 * 512 + 0 * KS + HF>(vb), l1 = tr_read<D0 * 512 + 1 * KS>(vb), h1 = tr_read<D0 * 512 + 1 * KS + HF>(vb);
  const s16x4 l2 = tr_read<D0 * 512 + 2 * KS>(vb), h2 = tr_read<D0 * 512 + 2 * KS + HF>(vb), l3 = tr_read<D0 * 512 + 3 * KS>(vb), h3 = tr_read<D0 * 512 + 3 * KS + HF>(vb);
  asm volatile("s_waitcnt lgkmcnt(0)" ::: "memory"); __builtin_amdgcn_sched_barrier(0);
#define PK(L, H) (bf16x8){L[0], L[1], L[2], L[3], H[0], H[1], H[2], H[3]}
  od = __builtin_amdgcn_mfma_f32_32x32x16_bf16(pa0, PK(l0, h0), od, 0, 0, 0);
  od = __builtin_amdgcn_mfma_f32_32x32x16_bf16(pa1, PK(l1, h1), od, 0, 0, 0);
  od = __builtin_amdgcn_mfma_f32_32x32x16_bf16(pa2, PK(l2, h2), od, 0, 0, 0);
  od = __builtin_amdgcn_mfma_f32_32x32x16_bf16(pa3, PK(l3, h3), od, 0, 0, 0);
#undef PK
}

template <int MODE>
DEV void attn_unit(const Params& p, int layer, int u) {
  constexpr int DV = (MODE == 0) ? 128 : 64, ND = DV / 32;
  constexpr int TB = (MODE == 0) ? 16384 : 8192;
  constexpr float C = SCALE * 1.4426950408889634f;
  constexpr float THRRAW = 8.0f / SCALE;
  const int tid = ltid(), wid = __builtin_amdgcn_readfirstlane(tid >> 6), lane = tid & 63, r32 = lane & 31, hi = lane >> 5;
  char* V_lds = smem; char* K_lds = smem + 2 * TB;
  float* wsc = (float*)(smem + 131072) + wid * 64; float* li_l = wsc; float* al_l = wsc + 32;
  float* rpb_l = (float*)(smem + 131072 + 2048);

  int b = 0, h = 0, NT = 0, tfirst = 0;
  int g = 0, rr = 1, mres = 0, blk = 0, Lsub = 0;
  int r0 = 0, row_lo = 0, qrow = 0, qcol = 0, rs = 0, cs = 0;
  const bf16_t *Qp, *Kb, *Vb; int ldkv;
  int qtok;
  int coff = 0;
  if (MODE == 0) {
    const int pair = ((u & 7) << 1) | (u >> 8), qb = (u >> 3) & 31; b = pair >> 2; h = pair & 3;
    const int g4 = wid >> 1, cm = wid & 1; coff = cm * 64;
    qtok = b * SEQ + qb * 128 + g4 * 32 + r32;
    Qp = (const bf16_t*)(p.ws + OFF_AQK) + (size_t)qtok * 1024 + h * 128 + cm * 64;
    Kb = (const bf16_t*)(p.ws + OFF_AQK) + 512 + h * 128; Vb = (const bf16_t*)(p.ws + OFF_AV) + h * 128; ldkv = 0;
    NT = 64; tfirst = 0;
  } else if (MODE == 1) {
    b = u / 192; int rem = u % 192; h = rem / 48; rem %= 48; g = rem / 16; const int uu = rem % 16;
    rr = (g == 0) ? 1 : (g == 1 ? 4 : 16); Lsub = SEQ / rr; mres = uu % rr; blk = uu / rr;
    const int qn = blk * 256 + wid * 32 + r32;
    qtok = b * SEQ + qn * rr + mres;
    Qp = (const bf16_t*)(p.ws + OFF_BQ) + (size_t)qtok * 768 + g * 256 + h * 64;
    Kb = (const bf16_t*)(p.ws + OFF_BK) + g * 256 + h * 64; Vb = (const bf16_t*)(p.ws + OFF_BV) + g * 256 + h * 64; ldkv = 768;
    tfirst = (blk == 0) ? 1 : 0; int tl = (Lsub - (blk * 256 - 64)) / 64 - 1; if (tl > 5) tl = 5; NT = tl + 1;
  } else {
    b = u >> 6; h = (u >> 4) & 3; r0 = (u & 15) * 4;
    qrow = r0 + (wid >> 1); qcol = (wid & 1) * 32 + r32;
    qtok = b * SEQ + qrow * 64 + qcol;
    Qp = (const bf16_t*)(p.ws + OFF_C) + (size_t)qtok * 768 + h * 64;
    Kb = (const bf16_t*)(p.ws + OFF_C) + 256 + h * 64; Vb = (const bf16_t*)(p.ws + OFF_C) + 512 + h * 64; ldkv = 768;
    row_lo = r0 - 4; if (row_lo < 0) row_lo = 0; if (row_lo > 56) row_lo = 56;
    int rl3 = r0 + 3 - 4; if (rl3 < 0) rl3 = 0; if (rl3 > 56) rl3 = 56;
    NT = rl3 + 8 - row_lo; tfirst = 0;
    rs = qrow - 4; if (rs < 0) rs = 0; if (rs > 56) rs = 56;
    cs = qcol - 8; if (cs < 0) cs = 0; if (cs > 48) cs = 48;
    const float* rp = p.rpb + ((size_t)layer * 4 + h) * 465;
    if (tid < 465) rpb_l[tid] = rp[tid] * (1.0f / SCALE);
  }
  (void)ldkv;

  bf16x8 qr[4];
#pragma unroll
  for (int d0 = 0; d0 < 4; ++d0) qr[d0] = *(const bf16x8*)(Qp + d0 * 16 + hi * 8);

  bf16x8 st0, st1, st2, st3;
  auto key_tok = [&](int t, int i) -> int {
    if (MODE == 0) return b * SEQ + t * 64 + i;
    if (MODE == 1) return b * SEQ + (blk * 256 - 64 + 64 * t + i) * rr + mres;
    return b * SEQ + (row_lo + t) * 64 + i;
  };
  auto sload = [&](int t) {
    if (MODE == 0) {
      const int sr = tid >> 4, sc = (tid & 15) * 8;
      const size_t k0 = (size_t)key_tok(t, sr), k1 = (size_t)key_tok(t, 32 + sr);
      st0 = *(const bf16x8*)(Vb + k0 * 512 + sc); st1 = *(const bf16x8*)(Vb + k1 * 512 + sc);
      st2 = *(const bf16x8*)(Kb + k0 * 1024 + sc); st3 = *(const bf16x8*)(Kb + k1 * 1024 + sc);
    } else {
      const int sr = tid >> 3, sc = (tid & 7) * 8;
      const size_t k0 = (size_t)key_tok(t, sr);
      st0 = *(const bf16x8*)(Vb + k0 * 768 + sc); st2 = *(const bf16x8*)(Kb + k0 * 768 + sc);
    }
  };
  auto swrite = [&](int buf) {
    if (MODE == 0) {
      const int sr = tid >> 4, sc = (tid & 15) * 8;
      *(bf16x8*)(V_lds + buf * TB + v_st<128>(sr, sc)) = st0; *(bf16x8*)(V_lds + buf * TB + v_st<128>(32 + sr, sc)) = st1;
      *(bf16x8*)(K_lds + buf * TB + KSWZ_A(sr, sc * 2)) = st2; *(bf16x8*)(K_lds + buf * TB + KSWZ_A(32 + sr, sc * 2)) = st3;
    } else {
      const int sr = tid >> 3, sc = (tid & 7) * 8;
      *(bf16x8*)(V_lds + buf * TB + v_st<64>(sr, sc)) = st0;
      *(bf16x8*)(K_lds + buf * TB + KSWZ_S(sr, sc * 2)) = st2;
    }
  };

  float m_reg = -1e30f, l_reg = 0.f;
  f32x16 o[ND];
#pragma unroll
  for (int d = 0; d < ND; ++d) o[d] = f32x16{};
  const int vb0 = (int)(uintptr_t)V_lds + v_rd_base(lane);

  sload(tfirst); swrite(0);
  __syncthreads();
  if (wid >= 4) __builtin_amdgcn_s_setprio(1);
  for (int t = tfirst, it = 0; t < NT; ++t, ++it) {
    const int buf = it & 1;
    const bool more = (t + 1 < NT);
    if (more) sload(t + 1);
    bool active = true;
    if (MODE == 1) { const int tn0 = blk * 256 - 64 + 64 * t, qa = blk * 256 + wid * 32; active = (tn0 + 63 >= qa - 64) && (tn0 <= qa + 31 + 64); }
    if (MODE == 2) { const int kr = row_lo + t; active = (kr >= rs) && (kr < rs + 8); }
    if (active) {
      f32x16 p0 = f32x16{}, p1 = f32x16{};
      const char* Kt = K_lds + buf * TB;
#pragma unroll
      for (int d0 = 0; d0 < 4; ++d0) {
        const int cb = (coff + d0 * 16 + hi * 8) * 2;
        bf16x8 b0, b1;
        if (MODE == 0) { b0 = *(const bf16x8*)(Kt + KSWZ_A(r32, cb)); b1 = *(const bf16x8*)(Kt + KSWZ_A(32 + r32, cb)); }
        else { b0 = *(const bf16x8*)(Kt + KSWZ_S(r32, cb)); b1 = *(const bf16x8*)(Kt + KSWZ_S(32 + r32, cb)); }
        p0 = __builtin_amdgcn_mfma_f32_32x32x16_bf16(b0, qr[d0], p0, 0, 0, 0);
        p1 = __builtin_amdgcn_mfma_f32_32x32x16_bf16(b1, qr[d0], p1, 0, 0, 0);
      }
      if (MODE == 1) {
        const int tn0 = blk * 256 - 64 + 64 * t, qn = blk * 256 + wid * 32 + r32;
#pragma unroll
        for (int r = 0; r < 16; ++r) {
          const int d0k = tn0 + crow(r, hi) - qn, d1k = d0k + 32;
          if (d0k > 64 || d0k < -64) p0[r] = -INFINITY;
          if (d1k > 64 || d1k < -64) p1[r] = -INFINITY;
        }
      }
      if (MODE == 2) {
        const int kr = row_lo + t; const int rb = (kr - qrow + 7) * 31;
#pragma unroll
        for (int r = 0; r < 16; ++r) {
          const int kc0 = crow(r, hi), kc1 = kc0 + 32;
          int dc0 = kc0 - qcol + 15, dc1 = kc1 - qcol + 15;
          dc0 = dc0 < 0 ? 0 : (dc0 > 30 ? 30 : dc0); dc1 = dc1 < 0 ? 0 : (dc1 > 30 ? 30 : dc1);
          const float b0 = rpb_l[rb + dc0], b1 = rpb_l[rb + dc1];
          p0[r] = (kc0 >= cs && kc0 < cs + 16) ? p0[r] + b0 : -INFINITY;
          p1[r] = (kc1 >= cs && kc1 < cs + 16) ? p1[r] + b1 : -INFINITY;
        }
      }
      float pmax = p0[0];
#pragma unroll
      for (int r = 1; r < 16; ++r) pmax = fmaxf(pmax, p0[r]);
#pragma unroll
      for (int r = 0; r < 16; ++r) pmax = fmaxf(pmax, p1[r]);
      { auto sw = __builtin_amdgcn_permlane32_swap(__float_as_uint(pmax), __float_as_uint(pmax), false, false);
        pmax = fmaxf(__uint_as_float(sw[0]), __uint_as_float(sw[1])); }
      float mn, alpha;
      if (__all(pmax - m_reg <= THRRAW)) { mn = m_reg; alpha = 1.f; }
      else { mn = fmaxf(m_reg, pmax); alpha = __builtin_amdgcn_exp2f((m_reg - mn) * C); m_reg = mn; }
      const float mnC = -mn * C;
      float ps = 0.f;
#pragma unroll
      for (int r = 0; r < 16; ++r) { p0[r] = __builtin_amdgcn_exp2f(fmaf(p0[r], C, mnC)); ps += p0[r]; }
#pragma unroll
      for (int r = 0; r < 16; ++r) { p1[r] = __builtin_amdgcn_exp2f(fmaf(p1[r], C, mnC)); ps += p1[r]; }
      { auto sw = __builtin_amdgcn_permlane32_swap(__float_as_uint(ps), __float_as_uint(ps), false, false);
        ps = __uint_as_float(sw[0]) + __uint_as_float(sw[1]); }
      l_reg = l_reg * alpha + ps;
      bf16x8 pa0, pa1, pa2, pa3;
#define PK4(P, BASE, OUT) do { unsigned a0 = cvtpk(P[BASE + 0], P[BASE + 1]), a1 = cvtpk(P[BASE + 2], P[BASE + 3]); \
    unsigned b0_ = cvtpk(P[BASE + 4], P[BASE + 5]), b1_ = cvtpk(P[BASE + 6], P[BASE + 7]); \
    auto r0_ = __builtin_amdgcn_permlane32_swap(a0, b0_, false, false); auto r1_ = __builtin_amdgcn_permlane32_swap(a1, b1_, false, false); \
    u32x4 w_ = {r0_[0], r1_[0], r0_[1], r1_[1]}; OUT = *reinterpret_cast<bf16x8*>(&w_); } while (0)
      PK4(p0, 0, pa0); PK4(p0, 8, pa1); PK4(p1, 0, pa2); PK4(p1, 8, pa3);
#undef PK4
      if (__any(alpha < 1.f)) {
        if (hi == 0) al_l[r32] = alpha;
        asm volatile("s_waitcnt lgkmcnt(0)" ::: "memory");
        float af[16];
#pragma unroll
        for (int r = 0; r < 16; ++r) af[r] = al_l[crow(r, hi)];
#pragma unroll
        for (int d = 0; d < ND; ++d)
#pragma unroll
          for (int r = 0; r < 16; ++r) o[d][r] *= af[r];
      }
      const int vb = vb0 + buf * TB;
      pv_one<DV, 0>(o[0], vb, pa0, pa1, pa2, pa3);
      pv_one<DV, 1>(o[1], vb, pa0, pa1, pa2, pa3);
      if (DV == 128) { pv_one<DV, 2>(o[ND - 2], vb, pa0, pa1, pa2, pa3); pv_one<DV, 3>(o[ND - 1], vb, pa0, pa1, pa2, pa3); }
    }
    if (more) swrite(buf ^ 1);
    __syncthreads();
  }

  __builtin_amdgcn_s_setprio(0);
  if (hi == 0) li_l[r32] = l_reg;
  asm volatile("s_waitcnt lgkmcnt(0)" ::: "memory");
  float rli[16];
#pragma unroll
  for (int r = 0; r < 16; ++r) rli[r] = __builtin_amdgcn_rcpf(li_l[crow(r, hi)]);
  const int qtok0 = __shfl(qtok, 0);
  if (MODE == 0) {
    const int g4 = wid >> 1, cm = wid & 1;
    float* X = (float*)smem + g4 * 4096;
    const float lam = ((const float*)(p.ws + OFF_LAM))[layer];
    if (cm == 1) {
#pragma unroll
      for (int d = 0; d < ND; ++d)
#pragma unroll
        for (int r = 0; r < 16; ++r) X[crow(r, hi) * 128 + d * 32 + r32] = -lam * o[d][r] * rli[r];
    }
    __syncthreads();
    if (cm == 0) {
      float ss[16];
#pragma unroll
      for (int r = 0; r < 16; ++r) ss[r] = 0.f;
#pragma unroll
      for (int d = 0; d < ND; ++d)
#pragma unroll
        for (int r = 0; r < 16; ++r) { const float dv = o[d][r] * rli[r] + X[crow(r, hi) * 128 + d * 32 + r32]; o[d][r] = dv; ss[r] += dv * dv; }
#pragma unroll
      for (int r = 0; r < 16; ++r) {
        float s = ss[r];
        s += __shfl_xor(s, 1); s += __shfl_xor(s, 2); s += __shfl_xor(s, 4); s += __shfl_xor(s, 8); s += __shfl_xor(s, 16);
        const float li = 0.8f - 0.6f * __expf(-0.3f * (float)layer);
        ss[r] = rsqrtf(s * (1.0f / 128.0f) + RMS_EPS) * (1.0f - li);
      }
      const bf16_t* Z = (const bf16_t*)(p.ws + OFF_Z); bf16_t* Y = (bf16_t*)(p.ws + OFF_Y);
#pragma unroll
      for (int d = 0; d < ND; ++d) {
        const float gn = p.subln[layer * 128 + d * 32 + r32];
#pragma unroll
        for (int r = 0; r < 16; ++r) {
          const size_t idx = (size_t)(qtok0 + crow(r, hi)) * 1024 + h * 128 + d * 32 + r32;
          const float y = o[d][r] * ss[r] * gn * siluf(bf2f(Z[idx]));
          Y[idx] = (bf16_t)(cvtpk(y, y) & 0xffffu);
        }
      }
    }
  } else if (MODE == 1) {
    bf16_t* OB = (bf16_t*)(p.ws + OFF_BQ);
    float* LSE = (float*)(p.ws + OFF_LSE);
    const int tokw = b * SEQ + (blk * 256 + wid * 32) * rr + mres;
#pragma unroll
    for (int d = 0; d < ND; ++d)
#pragma unroll
      for (int r = 0; r < 16; ++r) {
        const size_t idx = (size_t)(tokw + crow(r, hi) * rr) * 768 + g * 256 + h * 64 + d * 32 + r32;
        const float y = o[d][r] * rli[r];
        OB[idx] = (bf16_t)(cvtpk(y, y) & 0xffffu);
      }
    if (hi == 0) LSE[((size_t)g * T + qtok) * 4 + h] = m_reg * SCALE + __logf(l_reg);
  } else {
    const bf16_t* Z = (const bf16_t*)(p.ws + OFF_Z); bf16_t* Y = (bf16_t*)(p.ws + OFF_Y);
    float* Wf = (float*)(smem + 65536) + wid * 2048;
#pragma unroll
    for (int d = 0; d < ND; ++d)
#pragma unroll
      for (int r = 0; r < 16; ++r) Wf[crow(r, hi) * 64 + d * 32 + r32] = o[d][r] * rli[r];
    asm volatile("s_waitcnt lgkmcnt(0)" ::: "memory");
    u32x4 zq[4];
#pragma unroll
    for (int it = 0; it < 4; ++it) { const int idx = it * 64 + lane; zq[it] = *(const u32x4*)(Z + (size_t)(qtok0 + (idx >> 3)) * 1024 + 768 + h * 64 + (idx & 7) * 8); }
#pragma unroll
    for (int it = 0; it < 4; ++it) {
      const int idx = it * 64 + lane, row = idx >> 3, ch = idx & 7;
      const f32x4 a = *(const f32x4*)(Wf + row * 64 + ch * 8), c4 = *(const f32x4*)(Wf + row * 64 + ch * 8 + 4);
      const size_t gi = (size_t)(qtok0 + row) * 1024 + 768 + h * 64 + ch * 8;
      const u32x4 z = zq[it];
      u32x4 w;
      w[0] = cvtpk(a[0] * siluf(bflo(z[0])), a[1] * siluf(bfhi(z[0]))); w[1] = cvtpk(a[2] * siluf(bflo(z[1])), a[3] * siluf(bfhi(z[1])));
      w[2] = cvtpk(c4[0] * siluf(bflo(z[2])), c4[1] * siluf(bfhi(z[2]))); w[3] = cvtpk(c4[2] * siluf(bflo(z[3])), c4[3] * siluf(bfhi(z[3])));
      *(u32x4*)(Y + gi) = w;
    }
  }
  __syncthreads();
}

DEV void smA_partial(f32x16& p0, f32x16& p1, float& m_reg, float& alpha) {
  constexpr float C = SCALE * 1.4426950408889634f; constexpr float THRRAW = 8.0f / SCALE;
  float pmax = p0[0];
#pragma unroll
  for (int r = 1; r < 16; ++r) pmax = fmaxf(pmax, p0[r]);
#pragma unroll
  for (int r = 0; r < 16; ++r) pmax = fmaxf(pmax, p1[r]);
  { auto sw = __builtin_amdgcn_permlane32_swap(__float_as_uint(pmax), __float_as_uint(pmax), false, false);
    pmax = fmaxf(__uint_as_float(sw[0]), __uint_as_float(sw[1])); }
  float mn;
  if (__builtin_expect(__all(pmax - m_reg <= THRRAW), 1)) { mn = m_reg; alpha = 1.f; }
  else { mn = fmaxf(m_reg, pmax); alpha = __builtin_amdgcn_exp2f((m_reg - mn) * C); m_reg = mn; }
  const float mnC = -mn * C;
#pragma unroll
  for (int r = 0; r < 16; ++r) p0[r] = fmaf(p0[r], C, mnC);
#pragma unroll
  for (int r = 0; r < 16; ++r) p1[r] = fmaf(p1[r], C, mnC);
#pragma unroll
  for (int r = 0; r < 16; ++r) p0[r] = __builtin_amdgcn_exp2f(p0[r]);
}
DEV void smA_finish(f32x16& p0, f32x16& p1, float alpha, float& l_reg, bf16x8& pa0, bf16x8& pa1, bf16x8& pa2, bf16x8& pa3) {
#pragma unroll
  for (int r = 0; r < 16; ++r) p1[r] = __builtin_amdgcn_exp2f(p1[r]);
  float ps = 0.f;
#pragma unroll
  for (int r = 0; r < 16; ++r) ps += p0[r];
#pragma unroll
  for (int r = 0; r < 16; ++r) ps += p1[r];
  { auto sw = __builtin_amdgcn_permlane32_swap(__float_as_uint(ps), __float_as_uint(ps), false, false);
    ps = __uint_as_float(sw[0]) + __uint_as_float(sw[1]); }
  l_reg = l_reg * alpha + ps;
#define PK4(P, BASE, OUT) do { unsigned a0 = cvtpk(P[BASE + 0], P[BASE + 1]), a1 = cvtpk(P[BASE + 2], P[BASE + 3]); \
    unsigned b0_ = cvtpk(P[BASE + 4], P[BASE + 5]), b1_ = cvtpk(P[BASE + 6], P[BASE + 7]); \
    auto r0_ = __builtin_amdgcn_permlane32_swap(a0, b0_, false, false); auto r1_ = __builtin_amdgcn_permlane32_swap(a1, b1_, false, false); \
    u32x4 w_ = {r0_[0], r1_[0], r0_[1], r1_[1]}; OUT = *reinterpret_cast<bf16x8*>(&w_); } while (0)
  PK4(p0, 0, pa0); PK4(p0, 8, pa1); PK4(p1, 0, pa2); PK4(p1, 8, pa3);
#undef PK4
}

#define KSWZ_A2(row, colB) ((row) * 256 + ((colB) ^ (((row) & 15) << 4)))
DEV void attn_unit_A(const Params& p, int layer, int pair, int qb) {
  constexpr int SLOT = 32768;
  const int tid = ltid(), wid = __builtin_amdgcn_readfirstlane(tid >> 6), lane = tid & 63, r32 = lane & 31, hi = lane >> 5;
  LDSC* ldsb = (LDSC*)smem;
  float* wsc = (float*)(smem + 131072) + wid * 64; float* li_l = wsc; float* al_l = wsc + 32;
  const int b = pair >> 2, h = pair & 3;
  const int g4 = wid >> 1, cm = wid & 1, coff = cm * 64;
  const int qtok = b * SEQ + qb * 128 + g4 * 32 + r32;
  const bf16_t* Qp = (const bf16_t*)(p.ws + OFF_AQK) + (size_t)qtok * 512 + h * 128 + cm * 64;
  const char* Kg = p.ws + OFF_AK + (size_t)(b * 4 + h) * SEQ * 256;
  const char* Vg = p.ws + OFF_AV + (size_t)(b * 4 + h) * SEQ * 256;
  const float* kmxp = (const float*)(p.ws + OFF_KMX) + layer * 64 + b * 16 + h * 4 + cm * 2;
  constexpr int NT = 64;
  bf16x8 qr[4];
  float qsq = 0.f;
#pragma unroll
  for (int d0 = 0; d0 < 4; ++d0) {
    const u32x4 qw = *(const u32x4*)(Qp + d0 * 16 + hi * 8);
    u32x4 qs;
#pragma unroll
    for (int k = 0; k < 4; ++k) { const float lo = bflo(qw[k]), hh = bfhi(qw[k]); qsq += lo * lo + hh * hh; qs[k] = cvtpk(lo * (SCALE * 1.4426950408889634f), hh * (SCALE * 1.4426950408889634f)); }
    qr[d0] = *reinterpret_cast<bf16x8*>(&qs);
  }
  { auto sw = __builtin_amdgcn_permlane32_swap(__float_as_uint(qsq), __float_as_uint(qsq), false, false); qsq = __uint_as_float(sw[0]) + __uint_as_float(sw[1]); }
  const float kmax2 = kmxp[0] + kmxp[1];
  const float negm_s = -(sqrtf(qsq * kmax2) * (SCALE * 1.4426950408889634f) * 1.01f + 0.01f);
  f32x16 negm;
#pragma unroll
  for (int r = 0; r < 16; ++r) negm[r] = negm_s;
  unsigned kofs[2], vofs[2];
#pragma unroll
  for (int i = 0; i < 2; ++i) {
    const int q = i * 8 + wid;
    { const int row = q * 4 + (lane >> 4), pos = lane & 15; kofs[i] = (unsigned)(row * 256 + ((pos ^ (row & 15)) << 4)); }
    { const int st = q * 2 + (lane >> 5), kk = (st >> 2) * 8 + ((lane & 31) >> 2), c = (st & 3) * 32 + (lane & 3) * 8;
      const int k = (kk & ~0xC) | ((kk & 4) << 1) | ((kk & 8) >> 1); vofs[i] = (unsigned)(k * 256 + c * 2); }
  }
  const int vb0 = (int)(uintptr_t)smem + v_rd_base(lane);
  int kro[4];
#pragma unroll
  for (int d0 = 0; d0 < 4; ++d0) kro[d0] = KSWZ_A2(r32, (coff + d0 * 16 + hi * 8) * 2);
#define ISSUE(t) do { const char* kg_ = Kg + (size_t)(t) * (64 * 256); const char* vg_ = Vg + (size_t)(t) * (64 * 256); const int so_ = ((t) & 3) * SLOT; \
    _Pragma("unroll") for (int i_ = 0; i_ < 2; ++i_) { \
      __builtin_amdgcn_global_load_lds((const unsigned*)(vg_ + vofs[i_]), (__attribute__((address_space(3))) unsigned*)(ldsb + so_ + (i_ * 8 + wid) * 1024), 16, 0, 0); \
      __builtin_amdgcn_global_load_lds((const unsigned*)(kg_ + kofs[i_]), (__attribute__((address_space(3))) unsigned*)(ldsb + so_ + 16384 + (i_ * 8 + wid) * 1024), 16, 0, 0); } } while (0)
#define SBAR() __builtin_amdgcn_sched_barrier(0)
#define WAITV(n) asm volatile("s_waitcnt vmcnt(" #n ")" ::: "memory")
#define RBAR() do { asm volatile("" ::: "memory"); __builtin_amdgcn_s_barrier(); asm volatile("" ::: "memory"); } while (0)
#define KRD1(dst, addr, OFF) asm volatile("ds_read_b128 %0, %1 offset:" #OFF : "=&v"(dst) : "v"(addr) : "memory")
#define KREAD(t) do { const int kb_ = (int)(uintptr_t)smem + ((t) & 3) * SLOT; _Pragma("unroll") for (int d0 = 0; d0 < 4; ++d0) { const int ka_ = kb_ + kro[d0]; \
    KRD1(kf[2 * d0], ka_, 16384); KRD1(kf[2 * d0 + 1], ka_, 24576); } \
    asm volatile("s_waitcnt lgkmcnt(0)" ::: "memory"); SBAR(); } while (0)
#define VR1(D0, KS, vb_) vf[((D0) * 4 + (KS)) * 2] = tr_read<(D0) * 512 + (KS) * 4096>(vb_); vf[((D0) * 4 + (KS)) * 2 + 1] = tr_read<(D0) * 512 + (KS) * 4096 + 2048>(vb_);
#define VREAD_A(t) do { const int vb_ = vb0 + ((t) & 3) * SLOT; \
    VR1(0, 0, vb_) VR1(1, 0, vb_) VR1(2, 0, vb_) VR1(3, 0, vb_) VR1(0, 1, vb_) VR1(1, 1, vb_) VR1(2, 1, vb_) VR1(3, 1, vb_) } while (0)
#define VREAD_B(t) do { const int vb_ = vb0 + ((t) & 3) * SLOT; \
    VR1(0, 2, vb_) VR1(1, 2, vb_) VR1(2, 2, vb_) VR1(3, 2, vb_) VR1(0, 3, vb_) VR1(1, 3, vb_) VR1(2, 3, vb_) VR1(3, 3, vb_) } while (0)
#define PKV(i) (bf16x8){vf[2 * (i)][0], vf[2 * (i)][1], vf[2 * (i)][2], vf[2 * (i)][3], vf[2 * (i) + 1][0], vf[2 * (i) + 1][1], vf[2 * (i) + 1][2], vf[2 * (i) + 1][3]}
#define RESC(a) do { if (__any((a) < 1.f)) { if (hi == 0) al_l[r32] = (a); asm volatile("s_waitcnt lgkmcnt(0)" ::: "memory"); \
    _Pragma("unroll") for (int r = 0; r < 16; ++r) { const float af_ = al_l[crow(r, hi)]; o[0][r] *= af_; o[1][r] *= af_; o[2][r] *= af_; o[3][r] *= af_; } } } while (0)
  float l_reg = 0.f;
  f32x16 o[4] = {f32x16{}, f32x16{}, f32x16{}, f32x16{}};
  f32x16 p0, p1; bf16x8 pa[4]; bf16x8 kf[8]; s16x4 vf[32];
  ISSUE(0); ISSUE(1);
  if (wid >= 4) __builtin_amdgcn_s_setprio(1);
  long long seg_acc = 0;
#pragma unroll 1
  for (int J = 0; J < NT / 2; ++J) {
    WAITV(0); RBAR();
    if (J + 1 < NT / 2) { ISSUE(2 * J + 2); ISSUE(2 * J + 3); }
#pragma unroll
    for (int tt = 0; tt < 2; ++tt) {
      const int j = 2 * J + tt;
      KREAD(j);
      p0 = __builtin_amdgcn_mfma_f32_32x32x16_bf16(kf[0], qr[0], negm, 0, 0, 0);
      p1 = __builtin_amdgcn_mfma_f32_32x32x16_bf16(kf[1], qr[0], negm, 0, 0, 0);
#pragma unroll
      for (int d0 = 1; d0 < 4; ++d0) {
        p0 = __builtin_amdgcn_mfma_f32_32x32x16_bf16(kf[2 * d0], qr[d0], p0, 0, 0, 0);
        p1 = __builtin_amdgcn_mfma_f32_32x32x16_bf16(kf[2 * d0 + 1], qr[d0], p1, 0, 0, 0);
      }
      SBAR(); VREAD_A(j); SBAR();
      {
#pragma unroll
        for (int r = 0; r < 16; ++r) p0[r] = __builtin_amdgcn_exp2f(p0[r]);
#pragma unroll
        for (int r = 0; r < 16; ++r) p1[r] = __builtin_amdgcn_exp2f(p1[r]);
        float ps = 0.f;
#pragma unroll
        for (int r = 0; r < 16; ++r) ps += p0[r];
#pragma unroll
        for (int r = 0; r < 16; ++r) ps += p1[r];
        l_reg += ps;
#define PK4(P, BASE, OUT) do { unsigned a0 = cvtpk(P[BASE + 0], P[BASE + 1]), a1 = cvtpk(P[BASE + 2], P[BASE + 3]); \
    unsigned b0_ = cvtpk(P[BASE + 4], P[BASE + 5]), b1_ = cvtpk(P[BASE + 6], P[BASE + 7]); \
    auto r0_ = __builtin_amdgcn_permlane32_swap(a0, b0_, false, false); auto r1_ = __builtin_amdgcn_permlane32_swap(a1, b1_, false, false); \
    u32x4 w_ = {r0_[0], r1_[0], r0_[1], r1_[1]}; OUT = *reinterpret_cast<bf16x8*>(&w_); } while (0)
        PK4(p0, 0, pa[0]); PK4(p0, 8, pa[1]); PK4(p1, 0, pa[2]); PK4(p1, 8, pa[3]);
#undef PK4
      }
      asm volatile("s_waitcnt lgkmcnt(0)" ::: "memory"); SBAR();
      VREAD_B(j);
      SBAR();
#pragma unroll
      for (int ks = 0; ks < 2; ++ks)
#pragma unroll
        for (int d0 = 0; d0 < 4; ++d0) o[d0] = __builtin_amdgcn_mfma_f32_32x32x16_bf16(pa[ks], PKV(d0 * 4 + ks), o[d0], 0, 0, 0);
      SBAR();
      asm volatile("s_waitcnt lgkmcnt(0)" ::: "memory");
      SBAR();
#pragma unroll
      for (int ks = 2; ks < 4; ++ks)
#pragma unroll
        for (int d0 = 0; d0 < 4; ++d0) o[d0] = __builtin_amdgcn_mfma_f32_32x32x16_bf16(pa[ks], PKV(d0 * 4 + ks), o[d0], 0, 0, 0);
    }
  }
  __builtin_amdgcn_s_setprio(0);
  if (PROBE_SEG && blockIdx.x == 0 && tid == 0) atomicAdd((unsigned long long*)(p.ws + OFF_KMX + 1024), (unsigned long long)seg_acc);
  { auto sw = __builtin_amdgcn_permlane32_swap(__float_as_uint(l_reg), __float_as_uint(l_reg), false, false); l_reg = __uint_as_float(sw[0]) + __uint_as_float(sw[1]); }
#undef ISSUE
#undef KREAD
#undef KRD1
#undef VREAD_A
#undef VREAD_B
#undef VR1
#undef PKV
#undef RESC
#undef WAITV
#undef RBAR
  __syncthreads();
  if (hi == 0) li_l[r32] = l_reg;
  asm volatile("s_waitcnt lgkmcnt(0)" ::: "memory");
  float rli[16];
#pragma unroll
  for (int r = 0; r < 16; ++r) rli[r] = __builtin_amdgcn_rcpf(li_l[crow(r, hi)]);
  const int qtok0 = b * SEQ + qb * 128 + g4 * 32;
  float* X = (float*)smem + g4 * 4096;
  const float lam = ((const float*)(p.ws + OFF_LAM))[layer];
  u32x4 zq[4];
  { const bf16_t* Zp = (const bf16_t*)(p.ws + OFF_Z);
#pragma unroll
    for (int it = 0; it < 4; ++it) { const int idx = it * 128 + cm * 64 + lane; zq[it] = *(const u32x4*)(Zp + (size_t)(qtok0 + (idx >> 4)) * 1024 + h * 128 + (idx & 15) * 8); } }
  {
    float* Xw = X + cm * 16384;
    const float wgt = (cm == 1) ? -lam : 1.0f;
#pragma unroll
    for (int d = 0; d < 4; ++d)
#pragma unroll
      for (int r = 0; r < 16; ++r) Xw[crow(r, hi) * 128 + d * 32 + r32] = wgt * o[d][r] * rli[r];
  }
  __syncthreads();
  {
    const float li = 0.8f - 0.6f * __expf(-0.3f * (float)layer);
    const bf16_t* Z = (const bf16_t*)(p.ws + OFF_Z); bf16_t* Y = (bf16_t*)(p.ws + OFF_Y);
#pragma unroll
    for (int it = 0; it < 4; ++it) {
      const int idx = it * 128 + cm * 64 + lane, row = idx >> 4, ch = idx & 15;
      const f32x4 a = *(const f32x4*)(X + row * 128 + ch * 8) + *(const f32x4*)(X + 16384 + row * 128 + ch * 8), c4 = *(const f32x4*)(X + row * 128 + ch * 8 + 4) + *(const f32x4*)(X + 16384 + row * 128 + ch * 8 + 4);
      float ss = a[0] * a[0] + a[1] * a[1] + a[2] * a[2] + a[3] * a[3] + c4[0] * c4[0] + c4[1] * c4[1] + c4[2] * c4[2] + c4[3] * c4[3];
      ss += __shfl_xor(ss, 1); ss += __shfl_xor(ss, 2); ss += __shfl_xor(ss, 4); ss += __shfl_xor(ss, 8);
      const float rs = rsqrtf(ss * (1.0f / 128.0f) + RMS_EPS) * (1.0f - li);
      const f32x4 g0 = *(const f32x4*)(p.subln + layer * 128 + ch * 8), g1 = *(const f32x4*)(p.subln + layer * 128 + ch * 8 + 4);
      const size_t gi = (size_t)(qtok0 + row) * 1024 + h * 128 + ch * 8;
      const u32x4 z = zq[it];
      u32x4 w;
      w[0] = cvtpk(a[0] * rs * g0[0] * siluf(bflo(z[0])), a[1] * rs * g0[1] * siluf(bfhi(z[0])));
      w[1] = cvtpk(a[2] * rs * g0[2] * siluf(bflo(z[1])), a[3] * rs * g0[3] * siluf(bfhi(z[1])));
      w[2] = cvtpk(c4[0] * rs * g1[0] * siluf(bflo(z[2])), c4[1] * rs * g1[1] * siluf(bfhi(z[2])));
      w[3] = cvtpk(c4[2] * rs * g1[2] * siluf(bflo(z[3])), c4[3] * rs * g1[3] * siluf(bfhi(z[3])));
      *(u32x4*)(Y + gi) = w;
    }
  }
  __syncthreads();
}

DEV void attn_unit_B(const Params& p, int layer, int u) {
  constexpr float C = SCALE * 1.4426950408889634f;
  constexpr float THRRAW = 8.0f / SCALE;
  constexpr int VOFF = 49152;
  const int tid = ltid(), wid = __builtin_amdgcn_readfirstlane(tid >> 6), lane = tid & 63, r32 = lane & 31, hi = lane >> 5;
  LDSC* ldsb = (LDSC*)smem;
  float* wsc = (float*)(smem + 131072) + wid * 64; float* li_l = wsc; float* al_l = wsc + 32;
  const int b = u / 192; int rem = u % 192; const int h = rem / 48; rem %= 48; const int g = rem / 16, uu = rem % 16;
  const int rr = (g == 0) ? 1 : (g == 1 ? 4 : 16), Lsub = SEQ / rr, mres = uu % rr, blk = uu / rr;
  const int qn = blk * 256 + wid * 32 + r32;
  const int qtok = b * SEQ + qn * rr + mres;
  const bf16_t* Qp = (const bf16_t*)(p.ws + OFF_BQ) + (size_t)qtok * 768 + g * 256 + h * 64;
  const char* Kb = p.ws + OFF_BK + (size_t)(g * 256 + h * 64) * 2;
  const char* Vb = p.ws + OFF_BV + (size_t)(g * 256 + h * 64) * 2;
  const int tfirst = (blk == 0) ? 1 : 0; int tl = (Lsub - (blk * 256 - 64)) / 64 - 1; if (tl > 5) tl = 5; const int NT = tl + 1;
  bf16x8 qr[4];
#pragma unroll
  for (int d0 = 0; d0 < 4; ++d0) qr[d0] = *(const bf16x8*)(Qp + d0 * 16 + hi * 8);
  {
    const int krow = 8 * wid + (lane >> 3), kchunk = (lane & 7) ^ ((krow >> 1) & 7);
    const int kk = 8 * wid + ((lane & 31) >> 2), vk = (kk & ~0xC) | ((kk & 4) << 1) | ((kk & 8) >> 1), vc = (lane >> 5) * 32 + (lane & 3) * 8;
    const int n0 = blk * 256 - 64;
    for (int t = tfirst; t < NT; ++t) {
      const size_t ktok = (size_t)(b * SEQ + (n0 + 64 * t + krow) * rr + mres), vtok = (size_t)(b * SEQ + (n0 + 64 * t + vk) * rr + mres);
      __builtin_amdgcn_global_load_lds((const unsigned*)(Kb + ktok * 1536 + kchunk * 16), (__attribute__((address_space(3))) unsigned*)(ldsb + t * 8192 + wid * 1024), 16, 0, 0);
      __builtin_amdgcn_global_load_lds((const unsigned*)(Vb + vtok * 1536 + vc * 2), (__attribute__((address_space(3))) unsigned*)(ldsb + VOFF + t * 8192 + wid * 1024), 16, 0, 0);
    }
  }
  asm volatile("s_waitcnt vmcnt(0)" ::: "memory");
  __syncthreads();
  float m_reg = -1e30f, l_reg = 0.f;
  f32x16 o[2] = {f32x16{}, f32x16{}};
  const int vb0 = (int)(uintptr_t)smem + VOFF + v_rd_base(lane);
  int t0 = wid >> 1; if (t0 < tfirst) t0 = tfirst; int t1 = (wid >> 1) + 2; if (t1 > NT - 1) t1 = NT - 1;
  if (wid >= 4) __builtin_amdgcn_s_setprio(1);
  for (int t = t0; t <= t1; ++t) {
    f32x16 p0 = f32x16{}, p1 = f32x16{};
    const LDSC* Kt = ldsb + t * 8192;
#pragma unroll
    for (int d0 = 0; d0 < 4; ++d0) {
      const int cb = (d0 * 16 + hi * 8) * 2;
      const bf16x8 b0 = *(const __attribute__((address_space(3))) bf16x8*)(Kt + KSWZ_S(r32, cb)), b1 = *(const __attribute__((address_space(3))) bf16x8*)(Kt + KSWZ_S(32 + r32, cb));
      p0 = __builtin_amdgcn_mfma_f32_32x32x16_bf16(b0, qr[d0], p0, 0, 0, 0);
      p1 = __builtin_amdgcn_mfma_f32_32x32x16_bf16(b1, qr[d0], p1, 0, 0, 0);
    }
    { const int tn0 = blk * 256 - 64 + 64 * t;
#pragma unroll
      for (int r = 0; r < 16; ++r) {
        const int d0k = tn0 + crow(r, hi) - qn, d1k = d0k + 32;
        if (d0k > 64 || d0k < -64) p0[r] = -INFINITY;
        if (d1k > 64 || d1k < -64) p1[r] = -INFINITY;
      } }
    float pmax = p0[0];
#pragma unroll
    for (int r = 1; r < 16; ++r) pmax = fmaxf(pmax, p0[r]);
#pragma unroll
    for (int r = 0; r < 16; ++r) pmax = fmaxf(pmax, p1[r]);
    { auto sw = __builtin_amdgcn_permlane32_swap(__float_as_uint(pmax), __float_as_uint(pmax), false, false);
      pmax = fmaxf(__uint_as_float(sw[0]), __uint_as_float(sw[1])); }
    float mn, alpha;
    if (__all(pmax - m_reg <= THRRAW)) { mn = m_reg; alpha = 1.f; }
    else { mn = fmaxf(m_reg, pmax); alpha = __builtin_amdgcn_exp2f((m_reg - mn) * C); m_reg = mn; }
    const float mnC = -mn * C;
    float ps = 0.f;
#pragma unroll
    for (int r = 0; r < 16; ++r) { p0[r] = __builtin_amdgcn_exp2f(fmaf(p0[r], C, mnC)); ps += p0[r]; }
#pragma unroll
    for (int r = 0; r < 16; ++r) { p1[r] = __builtin_amdgcn_exp2f(fmaf(p1[r], C, mnC)); ps += p1[r]; }
    { auto sw = __builtin_amdgcn_permlane32_swap(__float_as_uint(ps), __float_as_uint(ps), false, false);
      ps = __uint_as_float(sw[0]) + __uint_as_float(sw[1]); }
    l_reg = l_reg * alpha + ps;
    bf16x8 pa0, pa1, pa2, pa3;
#define PK4(P, BASE, OUT) do { unsigned a0 = cvtpk(P[BASE + 0], P[BASE + 1]), a1 = cvtpk(P[BASE + 2], P[BASE + 3]); \
    unsigned b0_ = cvtpk(P[BASE + 4], P[BASE + 5]), b1_ = cvtpk(P[BASE + 6], P[BASE + 7]); \
    auto r0_ = __builtin_amdgcn_permlane32_swap(a0, b0_, false, false); auto r1_ = __builtin_amdgcn_permlane32_swap(a1, b1_, false, false); \
    u32x4 w_ = {r0_[0], r1_[0], r0_[1], r1_[1]}; OUT = *reinterpret_cast<bf16x8*>(&w_); } while (0)
    PK4(p0, 0, pa0); PK4(p0, 8, pa1); PK4(p1, 0, pa2); PK4(p1, 8, pa3);
#undef PK4
    if (__any(alpha < 1.f)) {
      if (hi == 0) al_l[r32] = alpha;
      asm volatile("s_waitcnt lgkmcnt(0)" ::: "memory");
#pragma unroll
      for (int r = 0; r < 16; ++r) { const float af = al_l[crow(r, hi)]; o[0][r] *= af; o[1][r] *= af; }
    }
    const int vb = vb0 + t * 8192;
    pv_one<64, 0>(o[0], vb, pa0, pa1, pa2, pa3);
    pv_one<64, 1>(o[1], vb, pa0, pa1, pa2, pa3);
  }
  __builtin_amdgcn_s_setprio(0);
  if (hi == 0) li_l[r32] = l_reg;
  asm volatile("s_waitcnt lgkmcnt(0)" ::: "memory");
  float rli[16];
#pragma unroll
  for (int r = 0; r < 16; ++r) rli[r] = __builtin_amdgcn_rcpf(li_l[crow(r, hi)]);
  bf16_t* OB = (bf16_t*)(p.ws + OFF_BQ);
  float* LSE = (float*)(p.ws + OFF_LSE);
  const int tokw = b * SEQ + (blk * 256 + wid * 32) * rr + mres;
  bf16_t* W = (bf16_t*)(smem + 98304) + wid * 2048;
#pragma unroll
  for (int d = 0; d < 2; ++d)
#pragma unroll
    for (int r = 0; r < 16; ++r) { const float y = o[d][r] * rli[r]; W[crow(r, hi) * 64 + d * 32 + r32] = (bf16_t)(cvtpk(y, y) & 0xffffu); }
  asm volatile("s_waitcnt lgkmcnt(0)" ::: "memory");
#pragma unroll
  for (int it = 0; it < 4; ++it) {
    const int idx = it * 64 + lane, row = idx >> 3, ch = idx & 7;
    const u32x4 w = *(const u32x4*)(W + row * 64 + ch * 8);
    *(u32x4*)(OB + (size_t)(tokw + row * rr) * 768 + g * 256 + h * 64 + ch * 8) = w;
  }
  if (hi == 0) LSE[((size_t)g * T + qtok) * 4 + h] = m_reg * SCALE + __logf(l_reg);
  __syncthreads();
}

DEV void phase_attn_A(const Params& p, int layer, int qsel) {
  for (int u = blockIdx.x; u < 512; u += gridDim.x) attn_unit_A(p, layer, ((u & 7) << 1) | ((u >> 8) & 1), (u >> 3) & 31);
}

DEV void phase_attn(const Params& p_in, int layer) {
  Params p = p_in; { size_t z_ = 0; asm volatile("" : "+s"(z_)); p.ws = p_in.ws + z_; }
  if (PROBE_DBL == 4) { for (int u = blockIdx.x; u < 256; u += gridDim.x) attn_unit<2>(p, layer, u); }
  phase_attn_A(p, layer, layer);
  if (PROBE_DBL == 1) phase_attn_A(p, layer, 2 + layer);
  for (int u = blockIdx.x; u < 768; u += gridDim.x) attn_unit_B(p, layer, u);
  for (int u = blockIdx.x; u < 256; u += gridDim.x) attn_unit<2>(p, layer, u);
}

__global__ void __launch_bounds__(512, 1) mk_forward(Params p) {
  cg::grid_group grid = cg::this_grid();
  unsigned* bar = (unsigned*)(p.ws + OFF_BAR);
  volatile LAS unsigned* st = (volatile LAS unsigned*)(LAS unsigned*)(smem + 131072 + 3968);
  if (threadIdx.x == 0) { st[0] = 0u; st[1] = 0u; }
  if (p.ws == nullptr) grid.sync();
  __syncthreads();
  XcdBarrier xb = xcd_barrier_post(bar, st);
  phase0(p);
  if (PROBE_DBL == 3) phase0(p);
  xcd_barrier(xb);
#pragma unroll 1
  for (int layer = 0; layer < 2; ++layer) {
    const float* xin = layer == 0 ? p.x : p.out;
    phase_norm(p, layer, xin);
    if (PROBE_DBL == 7) phase_norm(p, layer, xin);
    xcd_barrier(xb);
    phase_inproj(p, layer);
    if (PROBE_DBL == 2) phase_inproj(p, layer);
    xcd_barrier(xb);
    phase_attn(p, layer);
    xcd_barrier(xb);
    phase_gates(p);
    if (PROBE_DBL == 5) phase_gates(p);
    xcd_barrier(xb);
    phase_merge(p, layer);
    if (PROBE_DBL == 6) { xcd_barrier(xb); phase_merge(p, layer); }
    xcd_barrier(xb);
    phase_out(p, layer, xin);
    xcd_barrier(xb);
  }
  phase_final(p);
  if (PROBE_SEG && blockIdx.x == 0 && threadIdx.x == 0) {
    const unsigned long long cyc = __hip_atomic_load((unsigned long long*)(p.ws + OFF_KMX + 1024), __ATOMIC_RELAXED, __HIP_MEMORY_SCOPE_AGENT);
    const unsigned long long ticks = cyc / 40;
    const unsigned long long s0 = wall_clock64();
    while (wall_clock64() - s0 < ticks) __builtin_amdgcn_s_sleep(8);
  }
}

extern "C" void kernel_launch(void* const* d_in, const int* in_sizes, int n_in, void* d_out, int out_size, void* d_ws, size_t ws_size, hipStream_t stream) {
  static int grid_blocks = 0;
  if (ws_size < WS_NEED) { fprintf(stderr, "kernel_launch: workspace too small: %zu < %zu\n", ws_size, WS_NEED); return; }
  if (!grid_blocks) {
    int dev = 0, cus = 0, per_cu = 0;
    hipGetDevice(&dev);
    hipDeviceGetAttribute(&cus, hipDeviceAttributeMultiprocessorCount, dev);
    if (hipFuncSetAttribute((const void*)mk_forward, hipFuncAttributeMaxDynamicSharedMemorySize, LDS_BYTES) != hipSuccess) { fprintf(stderr, "kernel_launch: LDS attribute failed\n"); return; }
    hipOccupancyMaxActiveBlocksPerMultiprocessor(&per_cu, mk_forward, 512, LDS_BYTES);
    if (per_cu < 1) { fprintf(stderr, "kernel_launch: occupancy 0\n"); return; }
    grid_blocks = cus;
  }
  Params p{};
  p.x = (const float*)d_in[0]; p.c = (const float*)d_in[1]; p.pos = (const int*)d_in[2]; p.norm_gain = (const float*)d_in[3];
  p.w_ada = (const float*)d_in[4]; p.b_ada = (const float*)d_in[5]; p.w_in = (const float*)d_in[6]; p.diff_lambda = (const float*)d_in[7];
  p.subln = (const float*)d_in[8]; p.rpb = (const float*)d_in[9]; p.w_branch = (const float*)d_in[10]; p.w_out = (const float*)d_in[11];
  p.final_gain = (const float*)d_in[12]; p.out = (float*)d_out; p.ws = (char*)d_ws;
  void* args[] = {&p};
  if (hipMemsetAsync((char*)d_ws + OFF_BAR, 0, WS_NEED - OFF_BAR, stream) != hipSuccess) { fprintf(stderr, "kernel_launch: memset failed\n"); return; }
  hipError_t e = hipLaunchCooperativeKernel((void*)mk_forward, dim3(grid_blocks), dim3(512), args, LDS_BYTES, stream);
  if (e != hipSuccess) fprintf(stderr, "cooperative launch failed: %s (grid %d)\n", hipGetErrorString(e), grid_blocks);
}
```

```cpp
#include <hip/hip_runtime.h>
#include <hip/hip_cooperative_groups.h>
#include <cstdio>
#include <cstdint>
namespace cg = cooperative_groups;

#ifndef INPROJ_SKEW_TICKS
#define INPROJ_SKEW_TICKS 1500ull
#endif
#ifndef PROBE_SEG
#define PROBE_SEG 0
#endif
#ifndef PROBE_DBL
#define PROBE_DBL 0
#endif
#ifndef MK_MULTI
#define MK_MULTI 0
#endif

typedef unsigned short bf16_t;
typedef short bf16x8 __attribute__((ext_vector_type(8)));
typedef short s16x4 __attribute__((ext_vector_type(4)));
typedef float f32x4 __attribute__((ext_vector_type(4)));
typedef float f32x2 __attribute__((ext_vector_type(2)));
typedef float f32x16 __attribute__((ext_vector_type(16)));
typedef unsigned u32x4 __attribute__((ext_vector_type(4)));
typedef unsigned u32x2 __attribute__((ext_vector_type(2)));
#define DEV __device__ __forceinline__

constexpr int T = 16384, SEQ = 4096, DM = 1024, NB = 4;
constexpr int IN_COLS = 8704;
constexpr float RMS_EPS = 1e-6f;
constexpr float SCALE = 0.125f;

constexpr size_t SZ_T1024 = (size_t)T * 1024 * 2;
constexpr size_t OFF_AQK = 0;
constexpr size_t OFF_AK = OFF_AQK + (size_t)T * 512 * 2;
constexpr size_t OFF_AV = OFF_AQK + SZ_T1024;
constexpr size_t OFF_BK = OFF_AV + (size_t)T * 512 * 2;
constexpr size_t OFF_BV = OFF_BK + (size_t)T * 768 * 2;
constexpr size_t OFF_C = OFF_BV + (size_t)T * 768 * 2;
constexpr size_t OFF_BQ = OFF_C + (size_t)T * 768 * 2;
constexpr size_t OFF_Z = OFF_BQ + (size_t)T * 768 * 2;
constexpr size_t OFF_H = OFF_Z + SZ_T1024;
constexpr size_t OFF_Y = OFF_H + SZ_T1024;
constexpr size_t OFF_WIN = OFF_Y + SZ_T1024;
constexpr size_t OFF_WBR = OFF_WIN + (size_t)IN_COLS * 1024 * 2;
constexpr size_t OFF_WOUT = OFF_WBR + (size_t)2 * 1024 * 1024 * 2;
constexpr size_t OFF_LSE = OFF_WOUT + (size_t)2 * 1024 * 1024 * 2;
constexpr size_t OFF_ROPE = OFF_LSE + (size_t)3 * T * 4 * 4;
constexpr size_t OFF_MOD = OFF_ROPE + (size_t)T * 8 * 8;
constexpr size_t OFF_LAM = OFF_MOD + (size_t)2 * 4 * 3072 * 4;
constexpr size_t OFF_BAR = OFF_LAM + 256;
constexpr size_t OFF_CNT = OFF_BAR + 3456 * 4;
constexpr size_t OFF_KMX = OFF_CNT + 256 * 4;
constexpr size_t WS_NEED = OFF_KMX + 128 * 4 + 8192;
constexpr size_t OFF_G = OFF_AQK;

constexpr int LDS_BYTES = 131072 + 4096;

struct Params {
  const float* x; const float* c; const int* pos; const float* norm_gain; const float* w_ada; const float* b_ada; const float* w_in;
  const float* diff_lambda; const float* subln; const float* rpb; const float* w_branch; const float* w_out; const float* final_gain;
  float* out; char* ws;
};

extern __shared__ __attribute__((aligned(16))) char smem[];

DEV unsigned cvtpk(float lo, float hi) { unsigned r; asm volatile("v_cvt_pk_bf16_f32 %0, %1, %2" : "=v"(r) : "v"(lo), "v"(hi)); return r; }
DEV unsigned cvtpk_t(float lo, float hi) { unsigned r; asm volatile("s_nop 1\n\tv_cvt_pk_bf16_f32 %0, %1, %2" : "=v"(r) : "v"(lo), "v"(hi)); return r; }
DEV float bflo(unsigned w) { return __uint_as_float(w << 16); }
DEV float bfhi(unsigned w) { return __uint_as_float(w & 0xffff0000u); }
DEV float bf2f(bf16_t v) { return __uint_as_float(((unsigned)v) << 16); }
DEV float sigmoidf(float x) { return __builtin_amdgcn_rcpf(1.0f + __expf(-x)); }
DEV float sig2(float t) { return __builtin_amdgcn_rcpf(1.0f + __builtin_amdgcn_exp2f(t)); }
DEV float siluf(float x) { return x * __builtin_amdgcn_rcpf(1.0f + __expf(-x)); }
DEV int perm32(int rho) { const int n = rho >> 4, i = rho & 15; return 8 * (i >> 2) + 4 * n + (i & 3); }
DEV int ltid() { int t = threadIdx.x; asm volatile("" : "+v"(t)); return t; }
DEV int lbid() { int t = blockIdx.x; asm volatile("" : "+s"(t)); return t; }
DEV int crow(int r, int hi) { return (r & 3) + 8 * (r >> 2) + 4 * hi; }

#define XB_TMO      128
#define XB_XCNT(j)  (256  + 64 * (j))
#define XB_XSUB(j)  (1280 + 64 * (j))
#define XB_XGEN(j)  (2304 + 64 * (j))
#define XB_TOP      3328
#define XB_TOPGEN   3392
#define XCD_BAR_WORDS 3456
#define XB_SPIN_CAP (1u << 18)
#define LAS __attribute__((address_space(3)))
DEV unsigned xb_ld(unsigned* p) { return __hip_atomic_load(p, __ATOMIC_RELAXED, __HIP_MEMORY_SCOPE_AGENT); }
DEV unsigned xb_add(unsigned* p, unsigned v) { return __hip_atomic_fetch_add(p, v, __ATOMIC_RELAXED, __HIP_MEMORY_SCOPE_AGENT); }
DEV unsigned xb_xcc_id() { return (unsigned)__builtin_amdgcn_s_getreg((3 << 11) | 20) & 0xFu; }
#define XB_SPIN(cond, bar) do { unsigned _sp = 0; while (cond) { __builtin_amdgcn_s_sleep(1); \
    if ((++_sp & 255u) == 0u) { if (xb_ld(&(bar)[XB_TMO])) break; if (_sp > XB_SPIN_CAP) { atomicAdd(&(bar)[XB_TMO], 1u); break; } } } } while (0)
struct XcdBarrier { unsigned* bar; unsigned x; volatile LAS unsigned* st; };
DEV XcdBarrier xcd_barrier_post(unsigned* bar, volatile LAS unsigned* st) {
  XcdBarrier b; b.bar = bar; b.x = xb_xcc_id(); b.st = st;
  if (threadIdx.x == 0) (void)xb_add(&bar[XB_XCNT(b.x)], 1u);
  return b;
}
DEV void xcd_barrier_complete(unsigned* bar, unsigned x, unsigned& nloc, unsigned& nx) {
  const unsigned G = gridDim.x * gridDim.y * gridDim.z;
  unsigned sum, cnt, mine, sp = 0u;
  for (;;) {
    sum = 0u; cnt = 0u; mine = 0u;
#pragma unroll
    for (unsigned j = 0; j < 16; ++j) { const unsigned c = xb_ld(&bar[XB_XCNT(j)]); sum += c; cnt += (c > 0u) ? 1u : 0u; mine = (j == x) ? c : mine; }
    if (sum == G) break;
    __builtin_amdgcn_s_sleep(1);
    if ((++sp & 255u) == 0u) { if (xb_ld(&bar[XB_TMO])) break; if (sp > XB_SPIN_CAP) { atomicAdd(&bar[XB_TMO], 1u); break; } }
  }
  nloc = mine > 0u ? mine : 1u; nx = cnt > 0u ? cnt : 1u;
}
DEV void xcd_barrier(const XcdBarrier& b) {
  asm volatile("s_waitcnt vmcnt(0)" ::: "memory");
  __syncthreads();
  if (threadIdx.x == 0) {
    size_t bz_ = 0; unsigned bx = b.x;
    asm volatile("" : "+s"(bz_), "+s"(bx));
    unsigned* bar = b.bar + bz_;
    __builtin_amdgcn_s_waitcnt(0);
    unsigned nloc = b.st[0], nx = b.st[1];
    if (nloc == 0u) { xcd_barrier_complete(bar, bx, nloc, nx); b.st[0] = nloc; b.st[1] = nx; }
    const unsigned old = xb_add(&bar[XB_XSUB(bx)], 1u);
    const unsigned gen = old / nloc;
    if (old + 1u == (gen + 1u) * nloc) {
      __builtin_amdgcn_fence(__ATOMIC_RELEASE, "agent");
      asm volatile("s_waitcnt vmcnt(0)" ::: "memory");
      const unsigned og = xb_add(&bar[XB_TOP], 1u);
      const unsigned tg = og / nx;
      if (og + 1u == (tg + 1u) * nx) xb_add(&bar[XB_TOPGEN], 1u);
      else XB_SPIN(xb_ld(&bar[XB_TOPGEN]) == tg, bar);
      __builtin_amdgcn_fence(__ATOMIC_ACQUIRE, "agent");
      xb_add(&bar[XB_XGEN(bx)], 1u);
      asm volatile("s_waitcnt vmcnt(0)" ::: "memory");
    } else {
      XB_SPIN(xb_ld(&bar[XB_XGEN(bx)]) == gen, bar);
      __builtin_amdgcn_fence(__ATOMIC_ACQUIRE, "agent");
      asm volatile("s_waitcnt vmcnt(0)" ::: "memory");
    }
  }
  __syncthreads();
}

DEV int win_src_col(int j) {
  const int c = (j & ~31) + perm32(j & 31);
  int orig; bool rope;
  if (c < 1024) { orig = c; rope = true; }
  else if (c < 1536) { orig = c; rope = false; }
  else if (c < 2304) { orig = 2304 + (c - 1536); rope = true; }
  else if (c < 3072) { orig = 3072 + (c - 2304); rope = false; }
  else if (c < 3840) { orig = 3840 + (c - 3072); rope = false; }
  else if (c < 4608) { orig = 1536 + (c - 3840); rope = true; }
  else { orig = c; rope = false; }
  if (rope) { int p = orig & 63; if (p < 16) { const int i = p >> 1; p = (p & 1) ? i + 8 : i; orig = (orig & ~63) + p; } }
  return orig;
}

struct CvtTile { const float* src; int ld; bf16_t* dst; int j0, k0, o0; bool win; };
DEV void cvt_decode(const Params& p, int layer, int t, CvtTile& c) {
  if (t < 2176) { const int kt = t & 15, nt = t >> 4; c.src = p.w_in + (size_t)layer * 1024 * IN_COLS; c.ld = IN_COLS; c.dst = (bf16_t*)(p.ws + OFF_WIN); c.j0 = nt * 64; c.k0 = kt * 64; c.o0 = win_src_col(c.j0) & ~63; c.win = true; }
  else { const int tt0 = t - 2176, mat = tt0 >> 8, tt = tt0 & 255, kt = tt & 15, nt = tt >> 4, l = mat & 1;
    c.src = (mat < 2 ? p.w_branch : p.w_out) + (size_t)l * 1024 * 1024; c.ld = 1024; c.dst = (bf16_t*)(p.ws + (mat < 2 ? OFF_WBR : OFF_WOUT)) + (size_t)l * 1024 * 1024; c.j0 = nt * 64; c.k0 = kt * 64; c.o0 = c.j0; c.win = false; }
}
DEV void cvt_range(const Params& p, int layer, int tbeg, int tend) {
  float* l = (float*)smem;
  const int tid = ltid();
  int t = tbeg + blockIdx.x;
  if (t >= tend) return;
  CvtTile c; cvt_decode(p, layer, t, c);
  f32x4 v0, v1;
  { const int kr = tid >> 4, c4 = (tid & 15) * 4;
    v0 = *(const f32x4*)(c.src + (size_t)(c.k0 + kr) * c.ld + c.o0 + c4); v1 = *(const f32x4*)(c.src + (size_t)(c.k0 + 32 + kr) * c.ld + c.o0 + c4); }
  for (;;) {
    { const int kr = tid >> 4, c4 = (tid & 15) * 4;
      l[kr * 65 + c4 + 0] = v0[0]; l[kr * 65 + c4 + 1] = v0[1]; l[kr * 65 + c4 + 2] = v0[2]; l[kr * 65 + c4 + 3] = v0[3];
      l[(kr + 32) * 65 + c4 + 0] = v1[0]; l[(kr + 32) * 65 + c4 + 1] = v1[1]; l[(kr + 32) * 65 + c4 + 2] = v1[2]; l[(kr + 32) * 65 + c4 + 3] = v1[3]; }
    __syncthreads();
    const int tn = t + gridDim.x; CvtTile cn;
    if (tn < tend) { cvt_decode(p, layer, tn, cn); const int kr = tid >> 4, c4 = (tid & 15) * 4;
      v0 = *(const f32x4*)(cn.src + (size_t)(cn.k0 + kr) * cn.ld + cn.o0 + c4); v1 = *(const f32x4*)(cn.src + (size_t)(cn.k0 + 32 + kr) * cn.ld + cn.o0 + c4); }
    const int jj = tid >> 3, kc = (tid & 7) * 8, j = c.j0 + jj;
    const int oc = (c.win ? win_src_col(j) : ((j & ~31) + perm32(j & 31))) - c.o0;
    const float ws_ = (c.win && j >= 5632) ? -1.4426950408889634f : 1.0f;
    u32x4 w;
    w[0] = cvtpk(l[(kc + 0) * 65 + oc] * ws_, l[(kc + 1) * 65 + oc] * ws_);
    w[1] = cvtpk(l[(kc + 2) * 65 + oc] * ws_, l[(kc + 3) * 65 + oc] * ws_);
    w[2] = cvtpk(l[(kc + 4) * 65 + oc] * ws_, l[(kc + 5) * 65 + oc] * ws_);
    w[3] = cvtpk(l[(kc + 6) * 65 + oc] * ws_, l[(kc + 7) * 65 + oc] * ws_);
    *(u32x4*)(c.dst + (size_t)j * 1024 + c.k0 + kc) = w;
    __syncthreads();
    if (tn >= tend) break;
    t = tn; c = cn;
  }
}
DEV void cvt_win_layer(const Params& p, int layer) { cvt_range(p, layer, 0, 2176); }

DEV void phase0(const Params& p_in) {
  Params p = p_in; { size_t z_ = 0; asm volatile("" : "+s"(z_)); p.ws = p_in.ws + z_; }
  const int tid = ltid();
  cvt_range(p, 0, 0, 3200);
  float* mod = (float*)(p.ws + OFF_MOD);
  if (blockIdx.x < 192) {
    float* cact = (float*)smem; float* l4 = (float*)(smem + 16384);
    for (int i = tid; i < 4096; i += 512) cact[i] = siluf(p.c[i]);
    __syncthreads();
    for (int it = blockIdx.x; it < 192; it += gridDim.x) {
      const int l = it / 96, j0 = (it % 96) * 32, w = tid >> 6, lane = tid & 63, cl = lane & 31, kh = w * 2 + (lane >> 5);
      const float* wa = p.w_ada + (size_t)l * 1024 * 3072 + j0 + cl;
      float a0 = 0.f, a1 = 0.f, a2 = 0.f, a3 = 0.f;
      for (int k = kh * 64; k < kh * 64 + 64; k += 16) {
        float wv[16];
#pragma unroll
        for (int q = 0; q < 16; ++q) wv[q] = wa[(size_t)(k + q) * 3072];
#pragma unroll
        for (int q = 0; q < 16; ++q) { a0 += cact[k + q] * wv[q]; a1 += cact[1024 + k + q] * wv[q]; a2 += cact[2048 + k + q] * wv[q]; a3 += cact[3072 + k + q] * wv[q]; }
      }
      l4[(kh * 4 + 0) * 32 + cl] = a0; l4[(kh * 4 + 1) * 32 + cl] = a1; l4[(kh * 4 + 2) * 32 + cl] = a2; l4[(kh * 4 + 3) * 32 + cl] = a3;
      __syncthreads();
      if (tid < 128) {
        const int b = tid >> 5, c2 = tid & 31; float s = 0.f;
        for (int q = 0; q < 16; ++q) s += l4[(q * 4 + b) * 32 + c2];
        mod[((size_t)l * 4 + b) * 3072 + j0 + c2] = s + p.b_ada[l * 3072 + j0 + c2];
      }
      __syncthreads();
    }
  }
  f32x2* rope = (f32x2*)(p.ws + OFF_ROPE);
  for (int i = blockIdx.x * 512 + tid; i < T * 8; i += gridDim.x * 512) {
    const int tok = i >> 3, fi = i & 7;
    float inv;
    switch (fi) { case 0: inv = 1.0f; break; case 1: inv = 0.1939227432012558f; break; case 2: inv = 0.03760603070259094f; break; case 3: inv = 0.007292664609849453f; break;
                  case 4: inv = 0.0014142135623842478f; break; case 5: inv = 0.00027424818836152554f; break; case 6: inv = 5.318296098266728e-05f; break; default: inv = 1.0313386155758053e-05f; break; }
    const float angf = (float)p.pos[tok] * inv;
    const double a = (double)angf;
    const double q = rint(a * 0.63661977236758134308);
    double r = fma(-q, 1.57079632679489655800, a); r = fma(-q, 6.12323399573676603587e-17, r);
    const int n = ((int)q) & 3;
    const double r2 = r * r;
    const double sn = r + r * r2 * (-1.0 / 6 + r2 * (1.0 / 120 + r2 * (-1.0 / 5040 + r2 * (1.0 / 362880 - r2 * (1.0 / 39916800)))));
    const double cs = 1.0 + r2 * (-0.5 + r2 * (1.0 / 24 + r2 * (-1.0 / 720 + r2 * (1.0 / 40320 + r2 * (-1.0 / 3628800 + r2 * (1.0 / 479001600))))));
    double co, si;
    if (n == 0) { co = cs; si = sn; } else if (n == 1) { co = -sn; si = cs; } else if (n == 2) { co = -cs; si = -sn; } else { co = sn; si = -cs; }
    rope[i] = (f32x2){(float)co, (float)si};
  }
  if (blockIdx.x == 0 && tid < 2) {
    const float* dl = p.diff_lambda + tid * 256;
    float s1 = 0.f, s2 = 0.f;
    for (int i = 0; i < 64; ++i) { s1 += dl[i] * dl[64 + i]; s2 += dl[128 + i] * dl[192 + i]; }
    const float li = 0.8f - 0.6f * expf(-0.3f * (float)tid);
    ((float*)(p.ws + OFF_LAM))[tid] = expf(s1) - expf(s2) + li;
  }
}

DEV void phase_norm(const Params& p_in, int layer, const float* __restrict__ xin) {
  Params p = p_in; { size_t z_ = 0; asm volatile("" : "+s"(z_)); p.ws = p_in.ws + z_; }
  const int tid_ = ltid(); const int wid = tid_ >> 6, lane = tid_ & 63;
  const float* mod = (const float*)(p.ws + OFF_MOD) + (size_t)layer * 4 * 3072;
  const float* gain = p.norm_gain + layer * 1024;
  bf16_t* H = (bf16_t*)(p.ws + OFF_H);
  for (int row = blockIdx.x * 8 + wid; row < T; row += gridDim.x * 16) {
    const int rowB = row + gridDim.x * 8; const bool hasB = rowB < T;
    const float* xr = xin + (size_t)row * 1024; const float* xrB = xin + (size_t)(hasB ? rowB : row) * 1024;
    f32x4 v[4], vB[4]; float ss = 0.f, ssB = 0.f;
#pragma unroll
    for (int i = 0; i < 4; ++i) { v[i] = *(const f32x4*)(xr + i * 256 + lane * 4); vB[i] = *(const f32x4*)(xrB + i * 256 + lane * 4); }
#pragma unroll
    for (int i = 0; i < 4; ++i) { ss += v[i][0] * v[i][0] + v[i][1] * v[i][1] + v[i][2] * v[i][2] + v[i][3] * v[i][3]; ssB += vB[i][0] * vB[i][0] + vB[i][1] * vB[i][1] + vB[i][2] * vB[i][2] + vB[i][3] * vB[i][3]; }
#pragma unroll
    for (int o = 32; o > 0; o >>= 1) { ss += __shfl_xor(ss, o); ssB += __shfl_xor(ssB, o); }
    const float rstd = rsqrtf(ss * (1.0f / 1024.0f) + RMS_EPS), rstdB = rsqrtf(ssB * (1.0f / 1024.0f) + RMS_EPS);
    const int b = row >> 12, bB = (hasB ? rowB : row) >> 12;
#pragma unroll
    for (int i = 0; i < 4; ++i) {
      const int c = i * 256 + lane * 4;
      const f32x4 g = *(const f32x4*)(gain + c);
      { const f32x4 sh = *(const f32x4*)(mod + b * 3072 + c), sc = *(const f32x4*)(mod + b * 3072 + 1024 + c);
        float h0 = v[i][0] * rstd * g[0] * (1.f + sc[0]) + sh[0], h1 = v[i][1] * rstd * g[1] * (1.f + sc[1]) + sh[1];
        float h2 = v[i][2] * rstd * g[2] * (1.f + sc[2]) + sh[2], h3 = v[i][3] * rstd * g[3] * (1.f + sc[3]) + sh[3];
        u32x2 w; w[0] = cvtpk(h0, h1); w[1] = cvtpk(h2, h3);
        *(u32x2*)(H + (size_t)row * 1024 + c) = w; }
      if (hasB) { const f32x4 sh = *(const f32x4*)(mod + bB * 3072 + c), sc = *(const f32x4*)(mod + bB * 3072 + 1024 + c);
        float h0 = vB[i][0] * rstdB * g[0] * (1.f + sc[0]) + sh[0], h1 = vB[i][1] * rstdB * g[1] * (1.f + sc[1]) + sh[1];
        float h2 = vB[i][2] * rstdB * g[2] * (1.f + sc[2]) + sh[2], h3 = vB[i][3] * rstdB * g[3] * (1.f + sc[3]) + sh[3];
        u32x2 w; w[0] = cvtpk(h0, h1); w[1] = cvtpk(h2, h3);
        *(u32x2*)(H + (size_t)rowB * 1024 + c) = w; }
    }
  }
}

DEV void phase_final(const Params& p_in) {
  Params p = p_in; { size_t z_ = 0; asm volatile("" : "+s"(z_)); p.ws = p_in.ws + z_; }
  const int tid_ = ltid(); const int wid = tid_ >> 6, lane = tid_ & 63;
  for (int row = blockIdx.x * 8 + wid; row < T; row += gridDim.x * 8) {
    float* xr = p.out + (size_t)row * 1024;
    f32x4 v[4]; float ss = 0.f;
#pragma unroll
    for (int i = 0; i < 4; ++i) { v[i] = *(const f32x4*)(xr + i * 256 + lane * 4); ss += v[i][0] * v[i][0] + v[i][1] * v[i][1] + v[i][2] * v[i][2] + v[i][3] * v[i][3]; }
#pragma unroll
    for (int o = 32; o > 0; o >>= 1) ss += __shfl_xor(ss, o);
    const float rstd = rsqrtf(ss * (1.0f / 1024.0f) + RMS_EPS);
#pragma unroll
    for (int i = 0; i < 4; ++i) {
      const int c = i * 256 + lane * 4;
      const f32x4 g = *(const f32x4*)(p.final_gain + c);
      f32x4 o; o[0] = v[i][0] * rstd * g[0]; o[1] = v[i][1] * rstd * g[1]; o[2] = v[i][2] * rstd * g[2]; o[3] = v[i][3] * rstd * g[3];
      *(f32x4*)(xr + c) = o;
    }
  }
}

constexpr int HALF = 128, BK = 64, HT = HALF * BK;
DEV int lds_byte(int r, int c) { const int st = (r >> 4) * 2 + (c >> 5), rr = r & 15, cc = c & 31, ob = rr * 64 + cc * 2; return st * 1024 + (ob ^ (((ob >> 9) & 1) << 5)); }
DEV void stage_rc(int b, int& R, int& C) { const int st = b / 1024, sb = b % 1024, swz = sb ^ (((sb >> 9) & 1) << 5); R = (st >> 1) * 16 + swz / 64; C = (st & 1) * 32 + (swz % 64) / 2; }

DEV bool gemm_next(int i, int nM, int nN, int& pm, int& pn) {
  const int nwg = nM * nN; const long L = (long)i * gridDim.x + blockIdx.x; if (L >= nwg) return false;
  int wgid = (int)L; { const int q = nwg / 8, r = nwg % 8, xcd = wgid % 8, off = wgid / 8; wgid = (xcd < r ? xcd * (q + 1) : r * (q + 1) + (xcd - r) * q) + off; }
  const int nig = 8 * nN, gid = wgid / nig, fm = gid * 8, gsz = (nM - fm) < 8 ? (nM - fm) : 8;
  pm = fm + ((wgid % nig) % gsz); pn = (wgid % nig) / gsz; return true;
}

struct GUnit { const char* a; const char* b; int nt, pm, pn, s; };
typedef __attribute__((address_space(3))) unsigned char LDSC;
template <class Next, class Epi>
DEV void gemm_stream(Next&& next, Epi&& epi) {
  LDSC* lds = (LDSC*)smem;
  const int tid = ltid(), wid = __builtin_amdgcn_readfirstlane(tid >> 6), lane = tid & 63, wr = wid >> 2, wc = wid & 3, fr = lane & 15, fq = lane >> 4;
  unsigned voff[2];
#pragma unroll
  for (int i = 0; i < 2; ++i) { int R, C; stage_rc(tid * 16 + i * 8192, R, C); voff[i] = (unsigned)(R * 1024 + C) * 2u; }
  constexpr size_t kstep = 128, hstep = (size_t)128 * 1024 * 2;
  constexpr int HTB = 128 * 64 * 2;
  const unsigned ldsw = (unsigned)wid * 1024u;
  const int aoff = lds_byte(wr * 64 + fr, fq * 8), boff = lds_byte(wc * 32 + fr, fq * 8);
#define G_SA(b, h) (((b) * 2 + (h)) * HTB)
#define G_SB(b, h) ((4 + (b) * 2 + (h)) * HTB)
#define G_STAGE(bufoff, gbase) do { _Pragma("unroll") for (int _i = 0; _i < 2; ++_i) \
    __builtin_amdgcn_global_load_lds((const unsigned*)((const char*)(gbase) + voff[_i]), (__attribute__((address_space(3))) unsigned*)(lds + (bufoff) + ldsw + _i * 8192), 16, 0, 0); } while (0)
#define G_LDA(dst, b, h) do { _Pragma("unroll") for (int m = 0; m < 4; ++m) _Pragma("unroll") for (int k = 0; k < 2; ++k) dst[m][k] = *(const __attribute__((address_space(3))) bf16x8*)(lds + G_SA(b, h) + aoff + m * 2048 + k * 1024); } while (0)
#define G_LDB(dst, b, h) do { _Pragma("unroll") for (int n = 0; n < 2; ++n) _Pragma("unroll") for (int k = 0; k < 2; ++k) dst[n][k] = *(const __attribute__((address_space(3))) bf16x8*)(lds + G_SB(b, h) + boff + n * 2048 + k * 1024); } while (0)
#define G_MMA(ai, bj, At, Bf) do { __builtin_amdgcn_s_setprio(1); _Pragma("unroll") for (int m = 0; m < 4; ++m) _Pragma("unroll") for (int n = 0; n < 2; ++n) _Pragma("unroll") for (int k = 0; k < 2; ++k) \
    acc[ai][bj][m][n] = __builtin_amdgcn_mfma_f32_16x16x32_bf16(Bf[n][k], At[m][k], acc[ai][bj][m][n], 0, 0, 0); __builtin_amdgcn_s_setprio(0); } while (0)
#define G_WAIT_V(n) asm volatile("s_waitcnt vmcnt(" #n ")" ::: "memory")
#define G_WAIT_L(n) asm volatile("s_waitcnt lgkmcnt(" #n ")" ::: "memory")
#define G_BAR __builtin_amdgcn_s_barrier()
#define G_SCHED __builtin_amdgcn_sched_barrier(0)
  GUnit cur, nxt; int ui = 0;
  if (!next(0, cur)) return;
  f32x4 acc[2][2][4][2];
#pragma unroll
  for (int a = 0; a < 2; ++a)
#pragma unroll
    for (int b = 0; b < 2; ++b)
#pragma unroll
      for (int m = 0; m < 4; ++m)
#pragma unroll
        for (int n = 0; n < 2; ++n) acc[a][b][m][n] = (f32x4){0.f, 0.f, 0.f, 0.f};
  bf16x8 At[4][2], B0[2][2], B1[2][2];
  const char* cA = cur.a; const char* cB = cur.b;
  G_STAGE(G_SB(0, 0), cB); G_STAGE(G_SA(0, 0), cA); G_STAGE(G_SB(0, 1), cB + hstep); G_STAGE(G_SA(0, 1), cA + hstep);
  if (wr == 1) G_BAR;
  G_WAIT_V(4); G_BAR;
  G_STAGE(G_SB(1, 0), cB + kstep); G_STAGE(G_SA(1, 0), cA + kstep); G_STAGE(G_SB(1, 1), cB + hstep + kstep);
  G_WAIT_V(6); G_BAR;
  for (;;) {
    const bool has_next = next(ui + 1, nxt);
    const char* nA = has_next ? nxt.a : cA; const char* nB = has_next ? nxt.b : cB;
    const int nt = cur.nt;
    for (int t = 0; t < nt; t += 2) {
      const bool last = (t == nt - 2);
      const char* a1 = cA + (size_t)(t + 1) * kstep;
      const char* a2 = last ? nA : cA + (size_t)(t + 2) * kstep; const char* b2 = last ? nB : cB + (size_t)(t + 2) * kstep;
      const char* a3 = a2 + kstep; const char* b3 = b2 + kstep;
      G_LDB(B0, 0, 0); G_SCHED; G_LDA(At, 0, 0); G_STAGE(G_SA(1, 1), a1 + hstep);
      G_WAIT_L(8); G_BAR; G_WAIT_L(0); G_MMA(0, 0, At, B0); G_BAR; G_SCHED;
      G_LDB(B1, 0, 1); G_STAGE(G_SB(0, 0), b2);
      G_BAR; G_WAIT_L(0); G_MMA(0, 1, At, B1); G_BAR;
      G_LDA(At, 0, 1); G_STAGE(G_SA(0, 0), a2);
      G_BAR; G_WAIT_L(0); G_MMA(1, 0, At, B0); G_BAR; G_SCHED;
      G_STAGE(G_SB(0, 1), b2 + hstep);
      G_WAIT_V(6); G_BAR; G_MMA(1, 1, At, B1); G_BAR;
      G_LDB(B0, 1, 0); G_SCHED; G_LDA(At, 1, 0); G_STAGE(G_SA(0, 1), a2 + hstep);
      G_WAIT_L(8); G_BAR; G_WAIT_L(0); G_MMA(0, 0, At, B0); G_BAR; G_SCHED;
      G_LDB(B1, 1, 1); G_STAGE(G_SB(1, 0), b3);
      G_BAR; G_WAIT_L(0); G_MMA(0, 1, At, B1); G_BAR;
      G_LDA(At, 1, 1); G_STAGE(G_SA(1, 0), a3);
      G_BAR; G_WAIT_L(0); G_MMA(1, 0, At, B0); G_BAR; G_SCHED;
      G_STAGE(G_SB(1, 1), b3 + hstep);
      G_WAIT_V(6); G_BAR; G_MMA(1, 1, At, B1); G_BAR;
    }
    epi(acc, cur, wr, wc, fr, fq);
    if (!has_next) break;
#pragma unroll
    for (int a = 0; a < 2; ++a)
#pragma unroll
      for (int b = 0; b < 2; ++b)
#pragma unroll
        for (int m = 0; m < 4; ++m)
#pragma unroll
          for (int n = 0; n < 2; ++n) acc[a][b][m][n] = (f32x4){0.f, 0.f, 0.f, 0.f};
    cur = nxt; cA = nA; cB = nB; ++ui;
  }
  G_WAIT_V(0);
  if (wr == 0) G_BAR;
  G_BAR;
#undef G_SA
#undef G_SB
#undef G_STAGE
#undef G_LDA
#undef G_LDB
#undef G_MMA
}

DEV void phase_inproj(const Params& p_in, int layer) {
  Params p = p_in; { size_t z_ = 0; asm volatile("" : "+s"(z_)); p.ws = p_in.ws + z_; }
  const char* H = p.ws + OFF_H;
  const char* W = p.ws + OFF_WIN;
  const f32x4* rope = (const f32x4*)(p.ws + OFF_ROPE);
  char* ws = p.ws;
  if (5 * (int)gridDim.x + (int)blockIdx.x >= 1408) { __builtin_amdgcn_s_sleep(127); __builtin_amdgcn_s_sleep(127); __builtin_amdgcn_s_sleep(127); __builtin_amdgcn_s_sleep(127); }
  __syncthreads();
  gemm_stream([&](int i, GUnit& u) -> bool {
      int pm, pn; if (!gemm_next(i, 64, 22, pm, pn)) return false;
      u.a = H + (size_t)pm * 256 * 2048; u.b = W + (size_t)pn * 256 * 2048; u.nt = 16; u.pm = pm; u.pn = pn; u.s = 0; return true; },
    [&](f32x4 (&acc)[2][2][4][2], const GUnit& u, int wr, int wc, int fr, int fq) {
      const int c0 = u.pn * 256;
      size_t base; int ld, lc; bool rp;
      const int akv = (c0 >= 512 && c0 < 1536) ? 1 : 0;
      if (c0 < 512) { base = OFF_AQK; ld = 512; lc = c0; rp = true; }
      else if (c0 < 1024) { base = OFF_AK; ld = 128; lc = 0; rp = true; }
      else if (c0 < 1536) { base = OFF_AV; ld = 128; lc = 0; rp = false; }
      else if (c0 < 2304) { base = OFF_BK; ld = 768; lc = c0 - 1536; rp = true; }
      else if (c0 < 3072) { base = OFF_BV; ld = 768; lc = c0 - 2304; rp = false; }
      else if (c0 < 3840) { base = OFF_C; ld = 768; lc = c0 - 3072; rp = false; }
      else if (c0 < 4608) { base = OFF_BQ; ld = 768; lc = c0 - 3840; rp = true; }
      else { base = OFF_Z; ld = 1024; lc = c0 - 4608; rp = false; }
      bf16_t* dst = (bf16_t*)(ws + base);
      const bool dorope = rp && ((wc & 1) == 0) && (fq < 2);
      const bool isk = (c0 >= 512 && c0 < 1024);
      const int head0 = ((c0 >> 8) & 1) * 2;
      float kmx0 = 0.f, kmx1 = 0.f;
      const bool ropewave = rp && ((wc & 1) == 0);
#pragma unroll
      for (int ai = 0; ai < 2; ++ai) {
        f32x4 csA[4], csB[4];
        if (ropewave) {
#pragma unroll
          for (int m = 0; m < 4; ++m) { const size_t ri = (size_t)(u.pm * 256 + ai * 128 + wr * 64 + m * 16 + fr) * 4 + (fq & 1) * 2; csA[m] = rope[ri]; csB[m] = rope[ri + 1]; }
          asm volatile("" ::: "memory");
        }
#pragma unroll
        for (int m = 0; m < 4; ++m) {
          const int row = u.pm * 256 + ai * 128 + wr * 64 + m * 16 + fr;
          f32x4 cs0 = {1.f, 0.f, 1.f, 0.f}, cs1 = {1.f, 0.f, 1.f, 0.f};
          if (dorope) { cs0 = csA[m]; cs1 = csB[m]; }
#pragma unroll
          for (int bj = 0; bj < 2; ++bj) {
            f32x4 v0 = acc[ai][bj][m][0], v1 = acc[ai][bj][m][1];
            if (dorope) {
              f32x4 a, b;
              a[0] = v0[0] * cs0[0] - v0[1] * cs0[1]; a[1] = v0[1] * cs0[0] + v0[0] * cs0[1];
              a[2] = v0[2] * cs0[2] - v0[3] * cs0[3]; a[3] = v0[3] * cs0[2] + v0[2] * cs0[3];
              b[0] = v1[0] * cs1[0] - v1[1] * cs1[1]; b[1] = v1[1] * cs1[0] + v1[0] * cs1[1];
              b[2] = v1[2] * cs1[2] - v1[3] * cs1[3]; b[3] = v1[3] * cs1[2] + v1[2] * cs1[3];
              v0 = a; v1 = b;
            }
            u32x4 w; w[0] = cvtpk(v0[0], v0[1]); w[1] = cvtpk(v0[2], v0[3]); w[2] = cvtpk(v1[0], v1[1]); w[3] = cvtpk(v1[2], v1[3]);
            if (akv) *(u32x4*)(dst + ((size_t)(((row >> 12) * 4 + head0 + bj) * SEQ + (row & 4095))) * 128 + wc * 32 + fq * 8) = w;
            else *(u32x4*)(dst + (size_t)row * ld + lc + bj * 128 + wc * 32 + fq * 8) = w;
            if (isk) {
              float s = v0[0] * v0[0] + v0[1] * v0[1] + v0[2] * v0[2] + v0[3] * v0[3] + v1[0] * v1[0] + v1[1] * v1[1] + v1[2] * v1[2] + v1[3] * v1[3];
              s += __shfl_xor(s, 16); s += __shfl_xor(s, 32);
              if (bj == 0) kmx0 = fmaxf(kmx0, s); else kmx1 = fmaxf(kmx1, s);
            }
          }
        }
      }
      if (isk) {
#pragma unroll
        for (int o_ = 1; o_ < 16; o_ <<= 1) { kmx0 = fmaxf(kmx0, __shfl_xor(kmx0, o_)); kmx1 = fmaxf(kmx1, __shfl_xor(kmx1, o_)); }
        if ((threadIdx.x & 63) == 0) {
          unsigned* kmx = (unsigned*)(ws + OFF_KMX) + layer * 64 + (u.pm >> 4) * 16 + (wc >> 1) * 2 + (wc & 1);
          atomicMax(kmx + (head0 + 0) * 4, __float_as_uint(kmx0));
          atomicMax(kmx + (head0 + 1) * 4, __float_as_uint(kmx1));
        }
      }
    });
}

DEV void phase_gates(const Params& p_in) {
  Params p = p_in; { size_t z_ = 0; asm volatile("" : "+s"(z_)); p.ws = p_in.ws + z_; }
  {
    const bf16_t* OB = (const bf16_t*)(p.ws + OFF_BQ);
    const float* LSE = (const float*)(p.ws + OFF_LSE);
    const bf16_t* Z = (const bf16_t*)(p.ws + OFF_Z);
    bf16_t* Y = (bf16_t*)(p.ws + OFF_Y);
    const int i0 = blockIdx.x * 512 + ltid(), istep = gridDim.x * 512;
    for (int ib = i0; ib < T * 32; ib += 4 * istep) {
      float l0[4], l1[4], l2[4]; u32x4 a[4], b[4], c[4], z[4];
#pragma unroll
      for (int k = 0; k < 4; ++k) {
        const int i = ib + k * istep;
        if (i < T * 32) {
          const int tok = i >> 5, hs = (i >> 3) & 3, dc = (i & 7) * 8;
          l0[k] = LSE[((size_t)0 * T + tok) * 4 + hs]; l1[k] = LSE[((size_t)1 * T + tok) * 4 + hs]; l2[k] = LSE[((size_t)2 * T + tok) * 4 + hs];
          a[k] = *(const u32x4*)(OB + (size_t)tok * 768 + 0 * 256 + hs * 64 + dc);
          b[k] = *(const u32x4*)(OB + (size_t)tok * 768 + 1 * 256 + hs * 64 + dc);
          c[k] = *(const u32x4*)(OB + (size_t)tok * 768 + 2 * 256 + hs * 64 + dc);
          z[k] = *(const u32x4*)(Z + (size_t)tok * 1024 + 512 + hs * 64 + dc);
        }
      }
#pragma unroll
      for (int k = 0; k < 4; ++k) {
        const int i = ib + k * istep;
        if (i < T * 32) {
          const int tok = i >> 5, hs = (i >> 3) & 3, dc = (i & 7) * 8;
          const float mx = fmaxf(l0[k], fmaxf(l1[k], l2[k]));
          float e0 = __expf(l0[k] - mx), e1 = __expf(l1[k] - mx), e2 = __expf(l2[k] - mx);
          const float inv = __builtin_amdgcn_rcpf(e0 + e1 + e2); e0 *= inv; e1 *= inv; e2 *= inv;
          u32x4 w;
#pragma unroll
          for (int q = 0; q < 4; ++q) {
            const float lo = (e0 * bflo(a[k][q]) + e1 * bflo(b[k][q]) + e2 * bflo(c[k][q])) * siluf(bflo(z[k][q]));
            const float hi = (e0 * bfhi(a[k][q]) + e1 * bfhi(b[k][q]) + e2 * bfhi(c[k][q])) * siluf(bfhi(z[k][q]));
            w[q] = cvtpk(lo, hi);
          }
          *(u32x4*)(Y + (size_t)tok * 1024 + 512 + hs * 64 + dc) = w;
        }
      }
    }
  }
  const char* H = p.ws + OFF_H;
  const char* W = p.ws + OFF_WIN + (size_t)5632 * 2048;
  bf16_t* G = (bf16_t*)(p.ws + OFF_G);
  __syncthreads();
  gemm_stream([&](int i, GUnit& u) -> bool {
      int pm, pn; if (!gemm_next(i, 64, 12, pm, pn)) return false;
      u.a = H + (size_t)pm * 256 * 2048; u.b = W + (size_t)pn * 256 * 2048; u.nt = 16; u.pm = pm; u.pn = pn; u.s = 0; return true; },
    [&](f32x4 (&acc)[2][2][4][2], const GUnit& u, int wr, int wc, int fr, int fq) {
#pragma unroll
      for (int ai = 0; ai < 2; ++ai)
#pragma unroll
        for (int m = 0; m < 4; ++m) {
          const int row = u.pm * 256 + ai * 128 + wr * 64 + m * 16 + fr;
#pragma unroll
          for (int bj = 0; bj < 2; ++bj) {
            const f32x4 v0 = acc[ai][bj][m][0], v1 = acc[ai][bj][m][1];
            u32x4 w; w[0] = cvtpk_t(sig2(v0[0]), sig2(v0[1])); w[1] = cvtpk_t(sig2(v0[2]), sig2(v0[3]));
            w[2] = cvtpk_t(sig2(v1[0]), sig2(v1[1])); w[3] = cvtpk_t(sig2(v1[2]), sig2(v1[3]));
            *(u32x4*)(G + (size_t)row * 3072 + u.pn * 256 + bj * 128 + wc * 32 + fq * 8) = w;
          }
        }
    });
}

DEV void phase_merge(const Params& p_in, int layer) {
  Params p = p_in; { size_t z_ = 0; asm volatile("" : "+s"(z_)); p.ws = p_in.ws + z_; }
  const char* Y = p.ws + OFF_Y;
  const char* W = p.ws + OFF_WBR + (size_t)layer * 1024 * 2048;
  const bf16_t* G = (const bf16_t*)(p.ws + OFF_G);
  bf16_t* M = (bf16_t*)(p.ws + OFF_H);
  __syncthreads();
  gemm_stream([&](int i, GUnit& u) -> bool {
      const int uu = i / 3, s = i - uu * 3;
      int pm, pn; if (!gemm_next(uu, 64, 4, pm, pn)) return false;
      const int koff = (s == 0) ? 0 : (s == 1 ? 512 : 768);
      u.a = Y + (size_t)pm * 256 * 2048 + koff * 2; u.b = W + (size_t)pn * 256 * 2048 + koff * 2; u.nt = (s == 0) ? 8 : 4; u.pm = pm; u.pn = pn; u.s = s; return true; },
    [&](f32x4 (&acc)[2][2][4][2], const GUnit& u, int wr, int wc, int fr, int fq) {
      const int s = u.s;
#pragma unroll
      for (int ai = 0; ai < 2; ++ai) {
        u32x4 gq[4][2], oq[4][2];
#pragma unroll
        for (int m = 0; m < 4; ++m)
#pragma unroll
          for (int bj = 0; bj < 2; ++bj) {
            const int row = u.pm * 256 + ai * 128 + wr * 64 + m * 16 + fr, col = u.pn * 256 + bj * 128 + wc * 32 + fq * 8;
            gq[m][bj] = *(const u32x4*)(G + (size_t)row * 3072 + s * 1024 + col);
            oq[m][bj] = (u32x4){0u, 0u, 0u, 0u};
            if (s > 0) oq[m][bj] = *(const u32x4*)(M + (size_t)row * 1024 + col);
          }
        asm volatile("" ::: "memory");
#pragma unroll
        for (int m = 0; m < 4; ++m)
#pragma unroll
          for (int bj = 0; bj < 2; ++bj) {
            const int row = u.pm * 256 + ai * 128 + wr * 64 + m * 16 + fr, col = u.pn * 256 + bj * 128 + wc * 32 + fq * 8;
            const u32x4 g = gq[m][bj], old = oq[m][bj];
            const f32x4 v0 = acc[ai][bj][m][0], v1 = acc[ai][bj][m][1];
            u32x4 w;
            w[0] = cvtpk(bflo(old[0]) + bflo(g[0]) * v0[0], bfhi(old[0]) + bfhi(g[0]) * v0[1]);
            w[1] = cvtpk(bflo(old[1]) + bflo(g[1]) * v0[2], bfhi(old[1]) + bfhi(g[1]) * v0[3]);
            w[2] = cvtpk(bflo(old[2]) + bflo(g[2]) * v1[0], bfhi(old[2]) + bfhi(g[2]) * v1[1]);
            w[3] = cvtpk(bflo(old[3]) + bflo(g[3]) * v1[2], bfhi(old[3]) + bfhi(g[3]) * v1[3]);
            *(u32x4*)(M + (size_t)row * 1024 + col) = w;
          }
      }
    });
}

DEV void phase_out(const Params& p_in, int layer, const float* __restrict__ xin) {
  Params p = p_in; { size_t z_ = 0; asm volatile("" : "+s"(z_)); p.ws = p_in.ws + z_; }
  const char* M = p.ws + OFF_H;
  const char* W = p.ws + OFF_WOUT + (size_t)layer * 1024 * 2048;
  const float* mod = (const float*)(p.ws + OFF_MOD) + (size_t)layer * 4 * 3072 + 2048;
  float* out = p.out;
  __syncthreads();
  gemm_stream([&](int i, GUnit& u) -> bool {
      int pm, pn; if (!gemm_next(i, 64, 4, pm, pn)) return false;
      u.a = M + (size_t)pm * 256 * 2048; u.b = W + (size_t)pn * 256 * 2048; u.nt = 16; u.pm = pm; u.pn = pn; u.s = 0; return true; },
    [&](f32x4 (&acc)[2][2][4][2], const GUnit& u, int wr, int wc, int fr, int fq) {
      const int b = u.pm >> 4;
#pragma unroll
      for (int bj = 0; bj < 2; ++bj) {
        const int col = u.pn * 256 + bj * 128 + wc * 32 + fq * 8;
        const f32x4 g0 = *(const f32x4*)(mod + b * 3072 + col), g1 = *(const f32x4*)(mod + b * 3072 + col + 4);
#pragma unroll
        for (int ai = 0; ai < 2; ++ai)
#pragma unroll
          for (int m = 0; m < 4; ++m) {
            const int row = u.pm * 256 + ai * 128 + wr * 64 + m * 16 + fr;
            const f32x4 x0 = *(const f32x4*)(xin + (size_t)row * 1024 + col), x1 = *(const f32x4*)(xin + (size_t)row * 1024 + col + 4);
            *(f32x4*)(out + (size_t)row * 1024 + col) = x0 + g0 * acc[ai][bj][m][0];
            *(f32x4*)(out + (size_t)row * 1024 + col + 4) = x1 + g1 * acc[ai][bj][m][1];
          }
      }
    });
  __syncthreads();
  if (layer == 0) cvt_win_layer(p, 1);
}

#define KSWZ_A(row, colB) ((row) * 256 + ((colB) ^ (((row) & 7) << 4)))
#define KSWZ_S(row, colB) ((row) * 128 + ((colB) ^ ((((row) >> 1) & 7) << 4)))
template <int DV> DEV int v_st(int k, int c) { const int kk = (k & ~0xC) | ((k & 4) << 1) | ((k & 8) >> 1); return ((kk >> 3) * (DV / 32) + (c >> 5)) * 512 + ((kk & 7) * 32 + (c & 31)) * 2; }
DEV int v_rd_base(int lane) { return ((lane & 3) << 3) | (((lane >> 2) & 3) << 6) | (((lane >> 4) & 1) << 5) | (((lane >> 5) & 1) << 8); }
template <int OFF> DEV s16x4 tr_read(int vb) { s16x4 r; asm volatile("ds_read_b64_tr_b16 %0, %1 offset:%2" : "=&v"(r) : "v"(vb), "i"(OFF) : "memory"); return r; }
template <int OFF> DEV bf16x8 lds_rd128(int addr) { bf16x8 r; asm volatile("ds_read_b128 %0, %1 offset:%2" : "=&v"(r) : "v"(addr), "i"(OFF) : "memory"); return r; }
template <int DV, int D0> DEV void pv_one(f32x16& od, int vb, bf16x8 pa0, bf16x8 pa1, bf16x8 pa2, bf16x8 pa3) {
  constexpr int KS = (DV / 32) * 1024, HF = (DV / 32) * 512;
  const s16x4 l0 = tr_read<D0 * 512 + 0 * KS>(vb), h0 = tr_read<D0 * 512 + 0 * KS + HF>(vb), l1 = tr_read<D0 * 512 + 1 * KS>(vb), h1 = tr_read<D0 * 512 + 1 * KS + HF>(vb);
  const s16x4 l2 = tr_read<D0 * 512 + 2 * KS>(vb), h2 = tr_read<D0 * 512 + 2 * KS + HF>(vb), l3 = tr_read<D0 * 512 + 3 * KS>(vb), h3 = tr_read<D0 * 512 + 3 * KS + HF>(vb);
  asm volatile("s_waitcnt lgkmcnt(0)" ::: "memory"); __builtin_amdgcn_sched_barrier(0);
#define PK(L, H) (bf16x8){L[0], L[1], L[2], L[3], H[0], H[1], H[2], H[3]}
  od = __builtin_amdgcn_mfma_f32_32x32x16_bf16(pa0, PK(l0, h0), od, 0, 0, 0);
  od = __builtin_amdgcn_mfma_f32_32x32x16_bf16(pa1, PK(l1, h1), od, 0, 0, 0);
  od = __builtin_amdgcn_mfma_f32_32x32x16_bf16(pa2, PK(l2, h2), od, 0, 0, 0);
  od = __builtin_amdgcn_mfma_f32_32x32x16_bf16(pa3, PK(l3, h3), od, 0, 0, 0);
#undef PK
}

template <int MODE>
DEV void attn_unit(const Params& p, int layer, int u) {
  constexpr int DV = (MODE == 0) ? 128 : 64, ND = DV / 32;
  constexpr int TB = (MODE == 0) ? 16384 : 8192;
  constexpr float C = SCALE * 1.4426950408889634f;
  constexpr float THRRAW = 8.0f / SCALE;
  const int tid = ltid(), wid = __builtin_amdgcn_readfirstlane(tid >> 6), lane = tid & 63, r32 = lane & 31, hi = lane >> 5;
  char* V_lds = smem; char* K_lds = smem + 2 * TB;
  float* wsc = (float*)(smem + 131072) + wid * 64; float* li_l = wsc; float* al_l = wsc + 32;
  float* rpb_l = (float*)(smem + 131072 + 2048);

  int b = 0, h = 0, NT = 0, tfirst = 0;
  int g = 0, rr = 1, mres = 0, blk = 0, Lsub = 0;
  int r0 = 0, row_lo = 0, qrow = 0, qcol = 0, rs = 0, cs = 0;
  const bf16_t *Qp, *Kb, *Vb; int ldkv;
  int qtok;
  int coff = 0;
  if (MODE == 0) {
    const int pair = ((u & 7) << 1) | (u >> 8), qb = (u >> 3) & 31; b = pair >> 2; h = pair & 3;
    const int g4 = wid >> 1, cm = wid & 1; coff = cm * 64;
    qtok = b * SEQ + qb * 128 + g4 * 32 + r32;
    Qp = (const bf16_t*)(p.ws + OFF_AQK) + (size_t)qtok * 1024 + h * 128 + cm * 64;
    Kb = (const bf16_t*)(p.ws + OFF_AQK) + 512 + h * 128; Vb = (const bf16_t*)(p.ws + OFF_AV) + h * 128; ldkv = 0;
    NT = 64; tfirst = 0;
  } else if (MODE == 1) {
    b = u / 192; int rem = u % 192; h = rem / 48; rem %= 48; g = rem / 16; const int uu = rem % 16;
    rr = (g == 0) ? 1 : (g == 1 ? 4 : 16); Lsub = SEQ / rr; mres = uu % rr; blk = uu / rr;
    const int qn = blk * 256 + wid * 32 + r32;
    qtok = b * SEQ + qn * rr + mres;
    Qp = (const bf16_t*)(p.ws + OFF_BQ) + (size_t)qtok * 768 + g * 256 + h * 64;
    Kb = (const bf16_t*)(p.ws + OFF_BK) + g * 256 + h * 64; Vb = (const bf16_t*)(p.ws + OFF_BV) + g * 256 + h * 64; ldkv = 768;
    tfirst = (blk == 0) ? 1 : 0; int tl = (Lsub - (blk * 256 - 64)) / 64 - 1; if (tl > 5) tl = 5; NT = tl + 1;
  } else {
    b = u >> 6; h = (u >> 4) & 3; r0 = (u & 15) * 4;
    qrow = r0 + (wid >> 1); qcol = (wid & 1) * 32 + r32;
    qtok = b * SEQ + qrow * 64 + qcol;
    Qp = (const bf16_t*)(p.ws + OFF_C) + (size_t)qtok * 768 + h * 64;
    Kb = (const bf16_t*)(p.ws + OFF_C) + 256 + h * 64; Vb = (const bf16_t*)(p.ws + OFF_C) + 512 + h * 64; ldkv = 768;
    row_lo = r0 - 4; if (row_lo < 0) row_lo = 0; if (row_lo > 56) row_lo = 56;
    int rl3 = r0 + 3 - 4; if (rl3 < 0) rl3 = 0; if (rl3 > 56) rl3 = 56;
    NT = rl3 + 8 - row_lo; tfirst = 0;
    rs = qrow - 4; if (rs < 0) rs = 0; if (rs > 56) rs = 56;
    cs = qcol - 8; if (cs < 0) cs = 0; if (cs > 48) cs = 48;
    const float* rp = p.rpb + ((size_t)layer * 4 + h) * 465;
    if (tid < 465) rpb_l[tid] = rp[tid] * (1.0f / SCALE);
  }
  (void)ldkv;

  bf16x8 qr[4];
#pragma unroll
  for (int d0 = 0; d0 < 4; ++d0) qr[d0] = *(const bf16x8*)(Qp + d0 * 16 + hi * 8);

  bf16x8 st0, st1, st2, st3;
  auto key_tok = [&](int t, int i) -> int {
    if (MODE == 0) return b * SEQ + t * 64 + i;
    if (MODE == 1) return b * SEQ + (blk * 256 - 64 + 64 * t + i) * rr + mres;
    return b * SEQ + (row_lo + t) * 64 + i;
  };
  auto sload = [&](int t) {
    if (MODE == 0) {
      const int sr = tid >> 4, sc = (tid & 15) * 8;
      const size_t k0 = (size_t)key_tok(t, sr), k1 = (size_t)key_tok(t, 32 + sr);
      st0 = *(const bf16x8*)(Vb + k0 * 512 + sc); st1 = *(const bf16x8*)(Vb + k1 * 512 + sc);
      st2 = *(const bf16x8*)(Kb + k0 * 1024 + sc); st3 = *(const bf16x8*)(Kb + k1 * 1024 + sc);
    } else {
      const int sr = tid >> 3, sc = (tid & 7) * 8;
      const size_t k0 = (size_t)key_tok(t, sr);
      st0 = *(const bf16x8*)(Vb + k0 * 768 + sc); st2 = *(const bf16x8*)(Kb + k0 * 768 + sc);
    }
  };
  auto swrite = [&](int buf) {
    if (MODE == 0) {
      const int sr = tid >> 4, sc = (tid & 15) * 8;
      *(bf16x8*)(V_lds + buf * TB + v_st<128>(sr, sc)) = st0; *(bf16x8*)(V_lds + buf * TB + v_st<128>(32 + sr, sc)) = st1;
      *(bf16x8*)(K_lds + buf * TB + KSWZ_A(sr, sc * 2)) = st2; *(bf16x8*)(K_lds + buf * TB + KSWZ_A(32 + sr, sc * 2)) = st3;
    } else {
      const int sr = tid >> 3, sc = (tid & 7) * 8;
      *(bf16x8*)(V_lds + buf * TB + v_st<64>(sr, sc)) = st0;
      *(bf16x8*)(K_lds + buf * TB + KSWZ_S(sr, sc * 2)) = st2;
    }
  };

  float m_reg = -1e30f, l_reg = 0.f;
  f32x16 o[ND];
#pragma unroll
  for (int d = 0; d < ND; ++d) o[d] = f32x16{};
  const int vb0 = (int)(uintptr_t)V_lds + v_rd_base(lane);

  sload(tfirst); swrite(0);
  __syncthreads();
  if (wid >= 4) __builtin_amdgcn_s_setprio(1);
  for (int t = tfirst, it = 0; t < NT; ++t, ++it) {
    const int buf = it & 1;
    const bool more = (t + 1 < NT);
    if (more) sload(t + 1);
    bool active = true;
    if (MODE == 1) { const int tn0 = blk * 256 - 64 + 64 * t, qa = blk * 256 + wid * 32; active = (tn0 + 63 >= qa - 64) && (tn0 <= qa + 31 + 64); }
    if (MODE == 2) { const int kr = row_lo + t; active = (kr >= rs) && (kr < rs + 8); }
    if (active) {
      f32x16 p0 = f32x16{}, p1 = f32x16{};
      {
        const int kb_ = (int)(uintptr_t)K_lds + buf * TB;
        bf16x8 kf[8];
#pragma unroll
        for (int d0 = 0; d0 < 4; ++d0) { const int ka_ = kb_ + KSWZ_S(r32, (d0 * 16 + hi * 8) * 2); kf[2 * d0] = lds_rd128<0>(ka_); kf[2 * d0 + 1] = lds_rd128<4096>(ka_); }
        asm volatile("s_waitcnt lgkmcnt(0)" ::: "memory"); __builtin_amdgcn_sched_barrier(0);
#pragma unroll
        for (int d0 = 0; d0 < 4; ++d0) {
          p0 = __builtin_amdgcn_mfma_f32_32x32x16_bf16(kf[2 * d0], qr[d0], p0, 0, 0, 0);
          p1 = __builtin_amdgcn_mfma_f32_32x32x16_bf16(kf[2 * d0 + 1], qr[d0], p1, 0, 0, 0);
        }
      }
      if (MODE == 1) {
        const int tn0 = blk * 256 - 64 + 64 * t, qn = blk * 256 + wid * 32 + r32;
#pragma unroll
        for (int r = 0; r < 16; ++r) {
          const int d0k = tn0 + crow(r, hi) - qn, d1k = d0k + 32;
          if (d0k > 64 || d0k < -64) p0[r] = -INFINITY;
          if (d1k > 64 || d1k < -64) p1[r] = -INFINITY;
        }
      }
      if (MODE == 2) {
        const int kr = row_lo + t; const int rb = (kr - qrow + 7) * 31;
#pragma unroll
        for (int r = 0; r < 16; ++r) {
          const int kc0 = crow(r, hi), kc1 = kc0 + 32;
          int dc0 = kc0 - qcol + 15, dc1 = kc1 - qcol + 15;
          dc0 = dc0 < 0 ? 0 : (dc0 > 30 ? 30 : dc0); dc1 = dc1 < 0 ? 0 : (dc1 > 30 ? 30 : dc1);
          const float b0 = rpb_l[rb + dc0], b1 = rpb_l[rb + dc1];
          p0[r] = (kc0 >= cs && kc0 < cs + 16) ? p0[r] + b0 : -INFINITY;
          p1[r] = (kc1 >= cs && kc1 < cs + 16) ? p1[r] + b1 : -INFINITY;
        }
      }
      float pmax = p0[0];
#pragma unroll
      for (int r = 1; r < 16; ++r) pmax = fmaxf(pmax, p0[r]);
#pragma unroll
      for (int r = 0; r < 16; ++r) pmax = fmaxf(pmax, p1[r]);
      { auto sw = __builtin_amdgcn_permlane32_swap(__float_as_uint(pmax), __float_as_uint(pmax), false, false);
        pmax = fmaxf(__uint_as_float(sw[0]), __uint_as_float(sw[1])); }
      float mn, alpha;
      if (__all(pmax - m_reg <= THRRAW)) { mn = m_reg; alpha = 1.f; }
      else { mn = fmaxf(m_reg, pmax); alpha = __builtin_amdgcn_exp2f((m_reg - mn) * C); m_reg = mn; }
      const float mnC = -mn * C;
      float ps = 0.f;
#pragma unroll
      for (int r = 0; r < 16; ++r) { p0[r] = __builtin_amdgcn_exp2f(fmaf(p0[r], C, mnC)); ps += p0[r]; }
#pragma unroll
      for (int r = 0; r < 16; ++r) { p1[r] = __builtin_amdgcn_exp2f(fmaf(p1[r], C, mnC)); ps += p1[r]; }
      { auto sw = __builtin_amdgcn_permlane32_swap(__float_as_uint(ps), __float_as_uint(ps), false, false);
        ps = __uint_as_float(sw[0]) + __uint_as_float(sw[1]); }
      l_reg = l_reg * alpha + ps;
      bf16x8 pa0, pa1, pa2, pa3;
#define PK4(P, BASE, OUT) do { unsigned a0 = cvtpk(P[BASE + 0], P[BASE + 1]), a1 = cvtpk(P[BASE + 2], P[BASE + 3]); \
    unsigned b0_ = cvtpk(P[BASE + 4], P[BASE + 5]), b1_ = cvtpk(P[BASE + 6], P[BASE + 7]); \
    auto r0_ = __builtin_amdgcn_permlane32_swap(a0, b0_, false, false); auto r1_ = __builtin_amdgcn_permlane32_swap(a1, b1_, false, false); \
    u32x4 w_ = {r0_[0], r1_[0], r0_[1], r1_[1]}; OUT = *reinterpret_cast<bf16x8*>(&w_); } while (0)
      PK4(p0, 0, pa0); PK4(p0, 8, pa1); PK4(p1, 0, pa2); PK4(p1, 8, pa3);
#undef PK4
      if (__any(alpha < 1.f)) {
        if (hi == 0) al_l[r32] = alpha;
        asm volatile("s_waitcnt lgkmcnt(0)" ::: "memory");
        float af[16];
#pragma unroll
        for (int r = 0; r < 16; ++r) af[r] = al_l[crow(r, hi)];
#pragma unroll
        for (int d = 0; d < ND; ++d)
#pragma unroll
          for (int r = 0; r < 16; ++r) o[d][r] *= af[r];
      }
      const int vb = vb0 + buf * TB;
      pv_one<DV, 0>(o[0], vb, pa0, pa1, pa2, pa3);
      pv_one<DV, 1>(o[1], vb, pa0, pa1, pa2, pa3);
      if (DV == 128) { pv_one<DV, 2>(o[ND - 2], vb, pa0, pa1, pa2, pa3); pv_one<DV, 3>(o[ND - 1], vb, pa0, pa1, pa2, pa3); }
    }
    if (more) swrite(buf ^ 1);
    __syncthreads();
  }

  __builtin_amdgcn_s_setprio(0);
  if (hi == 0) li_l[r32] = l_reg;
  asm volatile("s_waitcnt lgkmcnt(0)" ::: "memory");
  float rli[16];
#pragma unroll
  for (int r = 0; r < 16; ++r) rli[r] = __builtin_amdgcn_rcpf(li_l[crow(r, hi)]);
  const int qtok0 = __shfl(qtok, 0);
  if (MODE == 0) {
    const int g4 = wid >> 1, cm = wid & 1;
    float* X = (float*)smem + g4 * 4096;
    const float lam = ((const float*)(p.ws + OFF_LAM))[layer];
    if (cm == 1) {
#pragma unroll
      for (int d = 0; d < ND; ++d)
#pragma unroll
        for (int r = 0; r < 16; ++r) X[crow(r, hi) * 128 + d * 32 + r32] = -lam * o[d][r] * rli[r];
    }
    __syncthreads();
    if (cm == 0) {
      float ss[16];
#pragma unroll
      for (int r = 0; r < 16; ++r) ss[r] = 0.f;
#pragma unroll
      for (int d = 0; d < ND; ++d)
#pragma unroll
        for (int r = 0; r < 16; ++r) { const float dv = o[d][r] * rli[r] + X[crow(r, hi) * 128 + d * 32 + r32]; o[d][r] = dv; ss[r] += dv * dv; }
#pragma unroll
      for (int r = 0; r < 16; ++r) {
        float s = ss[r];
        s += __shfl_xor(s, 1); s += __shfl_xor(s, 2); s += __shfl_xor(s, 4); s += __shfl_xor(s, 8); s += __shfl_xor(s, 16);
        const float li = 0.8f - 0.6f * __expf(-0.3f * (float)layer);
        ss[r] = rsqrtf(s * (1.0f / 128.0f) + RMS_EPS) * (1.0f - li);
      }
      const bf16_t* Z = (const bf16_t*)(p.ws + OFF_Z); bf16_t* Y = (bf16_t*)(p.ws + OFF_Y);
#pragma unroll
      for (int d = 0; d < ND; ++d) {
        const float gn = p.subln[layer * 128 + d * 32 + r32];
#pragma unroll
        for (int r = 0; r < 16; ++r) {
          const size_t idx = (size_t)(qtok0 + crow(r, hi)) * 1024 + h * 128 + d * 32 + r32;
          const float y = o[d][r] * ss[r] * gn * siluf(bf2f(Z[idx]));
          Y[idx] = (bf16_t)(cvtpk(y, y) & 0xffffu);
        }
      }
    }
  } else if (MODE == 1) {
    bf16_t* OB = (bf16_t*)(p.ws + OFF_BQ);
    float* LSE = (float*)(p.ws + OFF_LSE);
    const int tokw = b * SEQ + (blk * 256 + wid * 32) * rr + mres;
#pragma unroll
    for (int d = 0; d < ND; ++d)
#pragma unroll
      for (int r = 0; r < 16; ++r) {
        const size_t idx = (size_t)(tokw + crow(r, hi) * rr) * 768 + g * 256 + h * 64 + d * 32 + r32;
        const float y = o[d][r] * rli[r];
        OB[idx] = (bf16_t)(cvtpk(y, y) & 0xffffu);
      }
    if (hi == 0) LSE[((size_t)g * T + qtok) * 4 + h] = m_reg * SCALE + __logf(l_reg);
  } else {
    const bf16_t* Z = (const bf16_t*)(p.ws + OFF_Z); bf16_t* Y = (bf16_t*)(p.ws + OFF_Y);
    float* Wf = (float*)(smem + 65536) + wid * 2048;
#pragma unroll
    for (int d = 0; d < ND; ++d)
#pragma unroll
      for (int r = 0; r < 16; ++r) Wf[crow(r, hi) * 64 + d * 32 + r32] = o[d][r] * rli[r];
    asm volatile("s_waitcnt lgkmcnt(0)" ::: "memory");
    u32x4 zq[4];
#pragma unroll
    for (int it = 0; it < 4; ++it) { const int idx = it * 64 + lane; zq[it] = *(const u32x4*)(Z + (size_t)(qtok0 + (idx >> 3)) * 1024 + 768 + h * 64 + (idx & 7) * 8); }
#pragma unroll
    for (int it = 0; it < 4; ++it) {
      const int idx = it * 64 + lane, row = idx >> 3, ch = idx & 7;
      const f32x4 a = *(const f32x4*)(Wf + row * 64 + ch * 8), c4 = *(const f32x4*)(Wf + row * 64 + ch * 8 + 4);
      const size_t gi = (size_t)(qtok0 + row) * 1024 + 768 + h * 64 + ch * 8;
      const u32x4 z = zq[it];
      u32x4 w;
      w[0] = cvtpk(a[0] * siluf(bflo(z[0])), a[1] * siluf(bfhi(z[0]))); w[1] = cvtpk(a[2] * siluf(bflo(z[1])), a[3] * siluf(bfhi(z[1])));
      w[2] = cvtpk(c4[0] * siluf(bflo(z[2])), c4[1] * siluf(bfhi(z[2]))); w[3] = cvtpk(c4[2] * siluf(bflo(z[3])), c4[3] * siluf(bfhi(z[3])));
      *(u32x4*)(Y + gi) = w;
    }
  }
  __syncthreads();
}

DEV void smA_partial(f32x16& p0, f32x16& p1, float& m_reg, float& alpha) {
  constexpr float C = SCALE * 1.4426950408889634f; constexpr float THRRAW = 8.0f / SCALE;
  float pmax = p0[0];
#pragma unroll
  for (int r = 1; r < 16; ++r) pmax = fmaxf(pmax, p0[r]);
#pragma unroll
  for (int r = 0; r < 16; ++r) pmax = fmaxf(pmax, p1[r]);
  { auto sw = __builtin_amdgcn_permlane32_swap(__float_as_uint(pmax), __float_as_uint(pmax), false, false);
    pmax = fmaxf(__uint_as_float(sw[0]), __uint_as_float(sw[1])); }
  float mn;
  if (__builtin_expect(__all(pmax - m_reg <= THRRAW), 1)) { mn = m_reg; alpha = 1.f; }
  else { mn = fmaxf(m_reg, pmax); alpha = __builtin_amdgcn_exp2f((m_reg - mn) * C); m_reg = mn; }
  const float mnC = -mn * C;
#pragma unroll
  for (int r = 0; r < 16; ++r) p0[r] = fmaf(p0[r], C, mnC);
#pragma unroll
  for (int r = 0; r < 16; ++r) p1[r] = fmaf(p1[r], C, mnC);
#pragma unroll
  for (int r = 0; r < 16; ++r) p0[r] = __builtin_amdgcn_exp2f(p0[r]);
}
DEV void smA_finish(f32x16& p0, f32x16& p1, float alpha, float& l_reg, bf16x8& pa0, bf16x8& pa1, bf16x8& pa2, bf16x8& pa3) {
#pragma unroll
  for (int r = 0; r < 16; ++r) p1[r] = __builtin_amdgcn_exp2f(p1[r]);
  float ps = 0.f;
#pragma unroll
  for (int r = 0; r < 16; ++r) ps += p0[r];
#pragma unroll
  for (int r = 0; r < 16; ++r) ps += p1[r];
  { auto sw = __builtin_amdgcn_permlane32_swap(__float_as_uint(ps), __float_as_uint(ps), false, false);
    ps = __uint_as_float(sw[0]) + __uint_as_float(sw[1]); }
  l_reg = l_reg * alpha + ps;
#define PK4(P, BASE, OUT) do { unsigned a0 = cvtpk(P[BASE + 0], P[BASE + 1]), a1 = cvtpk(P[BASE + 2], P[BASE + 3]); \
    unsigned b0_ = cvtpk(P[BASE + 4], P[BASE + 5]), b1_ = cvtpk(P[BASE + 6], P[BASE + 7]); \
    auto r0_ = __builtin_amdgcn_permlane32_swap(a0, b0_, false, false); auto r1_ = __builtin_amdgcn_permlane32_swap(a1, b1_, false, false); \
    u32x4 w_ = {r0_[0], r1_[0], r0_[1], r1_[1]}; OUT = *reinterpret_cast<bf16x8*>(&w_); } while (0)
  PK4(p0, 0, pa0); PK4(p0, 8, pa1); PK4(p1, 0, pa2); PK4(p1, 8, pa3);
#undef PK4
}

#define KSWZ_A2(row, colB) ((row) * 256 + ((colB) ^ (((row) & 15) << 4)))
DEV void attn_unit_A(const Params& p, int layer, int pair, int qb) {
  constexpr int SLOT = 32768;
  const int tid = ltid(), wid = __builtin_amdgcn_readfirstlane(tid >> 6), lane = tid & 63, r32 = lane & 31, hi = lane >> 5;
  LDSC* ldsb = (LDSC*)smem;
  float* wsc = (float*)(smem + 131072) + wid * 64; float* li_l = wsc; float* al_l = wsc + 32;
  const int b = pair >> 2, h = pair & 3;
  const int g4 = wid >> 1, cm = wid & 1, coff = cm * 64;
  const int qtok = b * SEQ + qb * 128 + g4 * 32 + r32;
  const bf16_t* Qp = (const bf16_t*)(p.ws + OFF_AQK) + (size_t)qtok * 512 + h * 128 + cm * 64;
  const char* Kg = p.ws + OFF_AK + (size_t)(b * 4 + h) * SEQ * 256;
  const char* Vg = p.ws + OFF_AV + (size_t)(b * 4 + h) * SEQ * 256;
  const float* kmxp = (const float*)(p.ws + OFF_KMX) + layer * 64 + b * 16 + h * 4 + cm * 2;
  constexpr int NT = 64;
  bf16x8 qr[4];
  float qsq = 0.f;
#pragma unroll
  for (int d0 = 0; d0 < 4; ++d0) {
    const u32x4 qw = *(const u32x4*)(Qp + d0 * 16 + hi * 8);
    u32x4 qs;
#pragma unroll
    for (int k = 0; k < 4; ++k) { const float lo = bflo(qw[k]), hh = bfhi(qw[k]); qsq += lo * lo + hh * hh; qs[k] = cvtpk(lo * (SCALE * 1.4426950408889634f), hh * (SCALE * 1.4426950408889634f)); }
    qr[d0] = *reinterpret_cast<bf16x8*>(&qs);
  }
  { auto sw = __builtin_amdgcn_permlane32_swap(__float_as_uint(qsq), __float_as_uint(qsq), false, false); qsq = __uint_as_float(sw[0]) + __uint_as_float(sw[1]); }
  const float kmax2 = kmxp[0] + kmxp[1];
  const float negm_s = -(sqrtf(qsq * kmax2) * (SCALE * 1.4426950408889634f) * 1.01f + 0.01f);
  f32x16 negm;
#pragma unroll
  for (int r = 0; r < 16; ++r) negm[r] = negm_s;
  unsigned kofs[2], vofs[2];
#pragma unroll
  for (int i = 0; i < 2; ++i) {
    const int q = i * 8 + wid;
    { const int row = q * 4 + (lane >> 4), pos = lane & 15; kofs[i] = (unsigned)(row * 256 + ((pos ^ (row & 15)) << 4)); }
    { const int st = q * 2 + (lane >> 5), kk = (st >> 2) * 8 + ((lane & 31) >> 2), c = (st & 3) * 32 + (lane & 3) * 8;
      const int k = (kk & ~0xC) | ((kk & 4) << 1) | ((kk & 8) >> 1); vofs[i] = (unsigned)(k * 256 + c * 2); }
  }
  const int vb0 = (int)(uintptr_t)smem + v_rd_base(lane);
  int kro[4];
#pragma unroll
  for (int d0 = 0; d0 < 4; ++d0) kro[d0] = KSWZ_A2(r32, (coff + d0 * 16 + hi * 8) * 2);
#define ISSUE(t) do { const char* kg_ = Kg + (size_t)(t) * (64 * 256); const char* vg_ = Vg + (size_t)(t) * (64 * 256); const int so_ = ((t) & 3) * SLOT; \
    _Pragma("unroll") for (int i_ = 0; i_ < 2; ++i_) { \
      __builtin_amdgcn_global_load_lds((const unsigned*)(vg_ + vofs[i_]), (__attribute__((address_space(3))) unsigned*)(ldsb + so_ + (i_ * 8 + wid) * 1024), 16, 0, 0); \
      __builtin_amdgcn_global_load_lds((const unsigned*)(kg_ + kofs[i_]), (__attribute__((address_space(3))) unsigned*)(ldsb + so_ + 16384 + (i_ * 8 + wid) * 1024), 16, 0, 0); } } while (0)
#define SBAR() __builtin_amdgcn_sched_barrier(0)
#define WAITV(n) asm volatile("s_waitcnt vmcnt(" #n ")" ::: "memory")
#define RBAR() do { asm volatile("" ::: "memory"); __builtin_amdgcn_s_barrier(); asm volatile("" ::: "memory"); } while (0)
#define KRD1(dst, addr, OFF) asm volatile("ds_read_b128 %0, %1 offset:" #OFF : "=&v"(dst) : "v"(addr) : "memory")
#define KREAD(t) do { const int kb_ = (int)(uintptr_t)smem + ((t) & 3) * SLOT; _Pragma("unroll") for (int d0 = 0; d0 < 4; ++d0) { const int ka_ = kb_ + kro[d0]; \
    KRD1(kf[2 * d0], ka_, 16384); KRD1(kf[2 * d0 + 1], ka_, 24576); } \
    asm volatile("s_waitcnt lgkmcnt(0)" ::: "memory"); SBAR(); } while (0)
#define VR1(D0, KS, vb_) vf[((D0) * 4 + (KS)) * 2] = tr_read<(D0) * 512 + (KS) * 4096>(vb_); vf[((D0) * 4 + (KS)) * 2 + 1] = tr_read<(D0) * 512 + (KS) * 4096 + 2048>(vb_);
#define VREAD_A(t) do { const int vb_ = vb0 + ((t) & 3) * SLOT; \
    VR1(0, 0, vb_) VR1(1, 0, vb_) VR1(2, 0, vb_) VR1(3, 0, vb_) VR1(0, 1, vb_) VR1(1, 1, vb_) VR1(2, 1, vb_) VR1(3, 1, vb_) } while (0)
#define VREAD_B(t) do { const int vb_ = vb0 + ((t) & 3) * SLOT; \
    VR1(0, 2, vb_) VR1(1, 2, vb_) VR1(2, 2, vb_) VR1(3, 2, vb_) VR1(0, 3, vb_) VR1(1, 3, vb_) VR1(2, 3, vb_) VR1(3, 3, vb_) } while (0)
#define PKV(i) (bf16x8){vf[2 * (i)][0], vf[2 * (i)][1], vf[2 * (i)][2], vf[2 * (i)][3], vf[2 * (i) + 1][0], vf[2 * (i) + 1][1], vf[2 * (i) + 1][2], vf[2 * (i) + 1][3]}
#define RESC(a) do { if (__any((a) < 1.f)) { if (hi == 0) al_l[r32] = (a); asm volatile("s_waitcnt lgkmcnt(0)" ::: "memory"); \
    _Pragma("unroll") for (int r = 0; r < 16; ++r) { const float af_ = al_l[crow(r, hi)]; o[0][r] *= af_; o[1][r] *= af_; o[2][r] *= af_; o[3][r] *= af_; } } } while (0)
  float l_reg = 0.f;
  f32x16 o[4] = {f32x16{}, f32x16{}, f32x16{}, f32x16{}};
  f32x16 p0, p1; bf16x8 pa[4]; bf16x8 kf[8]; s16x4 vf[32];
  ISSUE(0); ISSUE(1);
  if (wid >= 4) __builtin_amdgcn_s_setprio(1);
  long long seg_acc = 0;
#pragma unroll 1
  for (int J = 0; J < NT / 2; ++J) {
    WAITV(0); RBAR();
    if (J + 1 < NT / 2) { ISSUE(2 * J + 2); ISSUE(2 * J + 3); }
#pragma unroll
    for (int tt = 0; tt < 2; ++tt) {
      const int j = 2 * J + tt;
      KREAD(j);
      p0 = __builtin_amdgcn_mfma_f32_32x32x16_bf16(kf[0], qr[0], negm, 0, 0, 0);
      p1 = __builtin_amdgcn_mfma_f32_32x32x16_bf16(kf[1], qr[0], negm, 0, 0, 0);
#pragma unroll
      for (int d0 = 1; d0 < 4; ++d0) {
        p0 = __builtin_amdgcn_mfma_f32_32x32x16_bf16(kf[2 * d0], qr[d0], p0, 0, 0, 0);
        p1 = __builtin_amdgcn_mfma_f32_32x32x16_bf16(kf[2 * d0 + 1], qr[d0], p1, 0, 0, 0);
      }
      SBAR(); VREAD_A(j); SBAR();
      {
#pragma unroll
        for (int r = 0; r < 16; ++r) p0[r] = __builtin_amdgcn_exp2f(p0[r]);
#pragma unroll
        for (int r = 0; r < 16; ++r) p1[r] = __builtin_amdgcn_exp2f(p1[r]);
        float ps = 0.f;
#pragma unroll
        for (int r = 0; r < 16; ++r) ps += p0[r];
#pragma unroll
        for (int r = 0; r < 16; ++r) ps += p1[r];
        l_reg += ps;
#define PK4(P, BASE, OUT) do { unsigned a0 = cvtpk(P[BASE + 0], P[BASE + 1]), a1 = cvtpk(P[BASE + 2], P[BASE + 3]); \
    unsigned b0_ = cvtpk(P[BASE + 4], P[BASE + 5]), b1_ = cvtpk(P[BASE + 6], P[BASE + 7]); \
    auto r0_ = __builtin_amdgcn_permlane32_swap(a0, b0_, false, false); auto r1_ = __builtin_amdgcn_permlane32_swap(a1, b1_, false, false); \
    u32x4 w_ = {r0_[0], r1_[0], r0_[1], r1_[1]}; OUT = *reinterpret_cast<bf16x8*>(&w_); } while (0)
        PK4(p0, 0, pa[0]); PK4(p0, 8, pa[1]); PK4(p1, 0, pa[2]); PK4(p1, 8, pa[3]);
#undef PK4
      }
      asm volatile("s_waitcnt lgkmcnt(0)" ::: "memory"); SBAR();
      VREAD_B(j);
      SBAR();
#pragma unroll
      for (int ks = 0; ks < 2; ++ks)
#pragma unroll
        for (int d0 = 0; d0 < 4; ++d0) o[d0] = __builtin_amdgcn_mfma_f32_32x32x16_bf16(pa[ks], PKV(d0 * 4 + ks), o[d0], 0, 0, 0);
      SBAR();
      asm volatile("s_waitcnt lgkmcnt(0)" ::: "memory");
      SBAR();
#pragma unroll
      for (int ks = 2; ks < 4; ++ks)
#pragma unroll
        for (int d0 = 0; d0 < 4; ++d0) o[d0] = __builtin_amdgcn_mfma_f32_32x32x16_bf16(pa[ks], PKV(d0 * 4 + ks), o[d0], 0, 0, 0);
    }
  }
  __builtin_amdgcn_s_setprio(0);
  if (PROBE_SEG && blockIdx.x == 0 && tid == 0) atomicAdd((unsigned long long*)(p.ws + OFF_KMX + 1024), (unsigned long long)seg_acc);
  { auto sw = __builtin_amdgcn_permlane32_swap(__float_as_uint(l_reg), __float_as_uint(l_reg), false, false); l_reg = __uint_as_float(sw[0]) + __uint_as_float(sw[1]); }
#undef ISSUE
#undef KREAD
#undef KRD1
#undef VREAD_A
#undef VREAD_B
#undef VR1
#undef PKV
#undef RESC
#undef WAITV
#undef RBAR
  __syncthreads();
  if (hi == 0) li_l[r32] = l_reg;
  asm volatile("s_waitcnt lgkmcnt(0)" ::: "memory");
  float rli[16];
#pragma unroll
  for (int r = 0; r < 16; ++r) rli[r] = __builtin_amdgcn_rcpf(li_l[crow(r, hi)]);
  const int qtok0 = b * SEQ + qb * 128 + g4 * 32;
  float* X = (float*)smem + g4 * 4096;
  const float lam = ((const float*)(p.ws + OFF_LAM))[layer];
  u32x4 zq[4];
  { const bf16_t* Zp = (const bf16_t*)(p.ws + OFF_Z);
#pragma unroll
    for (int it = 0; it < 4; ++it) { const int idx = it * 128 + cm * 64 + lane; zq[it] = *(const u32x4*)(Zp + (size_t)(qtok0 + (idx >> 4)) * 1024 + h * 128 + (idx & 15) * 8); } }
  {
    float* Xw = X + cm * 16384;
    const float wgt = (cm == 1) ? -lam : 1.0f;
#pragma unroll
    for (int d = 0; d < 4; ++d)
#pragma unroll
      for (int r = 0; r < 16; ++r) Xw[crow(r, hi) * 128 + d * 32 + r32] = wgt * o[d][r] * rli[r];
  }
  __syncthreads();
  {
    const float li = 0.8f - 0.6f * __expf(-0.3f * (float)layer);
    const bf16_t* Z = (const bf16_t*)(p.ws + OFF_Z); bf16_t* Y = (bf16_t*)(p.ws + OFF_Y);
#pragma unroll
    for (int it = 0; it < 4; ++it) {
      const int idx = it * 128 + cm * 64 + lane, row = idx >> 4, ch = idx & 15;
      const f32x4 a = *(const f32x4*)(X + row * 128 + ch * 8) + *(const f32x4*)(X + 16384 + row * 128 + ch * 8), c4 = *(const f32x4*)(X + row * 128 + ch * 8 + 4) + *(const f32x4*)(X + 16384 + row * 128 + ch * 8 + 4);
      float ss = a[0] * a[0] + a[1] * a[1] + a[2] * a[2] + a[3] * a[3] + c4[0] * c4[0] + c4[1] * c4[1] + c4[2] * c4[2] + c4[3] * c4[3];
      ss += __shfl_xor(ss, 1); ss += __shfl_xor(ss, 2); ss += __shfl_xor(ss, 4); ss += __shfl_xor(ss, 8);
      const float rs = rsqrtf(ss * (1.0f / 128.0f) + RMS_EPS) * (1.0f - li);
      const f32x4 g0 = *(const f32x4*)(p.subln + layer * 128 + ch * 8), g1 = *(const f32x4*)(p.subln + layer * 128 + ch * 8 + 4);
      const size_t gi = (size_t)(qtok0 + row) * 1024 + h * 128 + ch * 8;
      const u32x4 z = zq[it];
      u32x4 w;
      w[0] = cvtpk(a[0] * rs * g0[0] * siluf(bflo(z[0])), a[1] * rs * g0[1] * siluf(bfhi(z[0])));
      w[1] = cvtpk(a[2] * rs * g0[2] * siluf(bflo(z[1])), a[3] * rs * g0[3] * siluf(bfhi(z[1])));
      w[2] = cvtpk(c4[0] * rs * g1[0] * siluf(bflo(z[2])), c4[1] * rs * g1[1] * siluf(bfhi(z[2])));
      w[3] = cvtpk(c4[2] * rs * g1[2] * siluf(bflo(z[3])), c4[3] * rs * g1[3] * siluf(bfhi(z[3])));
      *(u32x4*)(Y + gi) = w;
    }
  }
  __syncthreads();
}

DEV void attn_unit_B(const Params& p, int layer, int u) {
  constexpr float C = SCALE * 1.4426950408889634f;
  constexpr float THRRAW = 8.0f / SCALE;
  constexpr int VOFF = 49152;
  const int tid = ltid(), wid = __builtin_amdgcn_readfirstlane(tid >> 6), lane = tid & 63, r32 = lane & 31, hi = lane >> 5;
  LDSC* ldsb = (LDSC*)smem;
  float* wsc = (float*)(smem + 131072) + wid * 64; float* li_l = wsc; float* al_l = wsc + 32;
  const int b = u / 192; int rem = u % 192; const int h = rem / 48; rem %= 48; const int g = rem / 16, uu = rem % 16;
  const int rr = (g == 0) ? 1 : (g == 1 ? 4 : 16), Lsub = SEQ / rr, mres = uu % rr, blk = uu / rr;
  const int qn = blk * 256 + wid * 32 + r32;
  const int qtok = b * SEQ + qn * rr + mres;
  const bf16_t* Qp = (const bf16_t*)(p.ws + OFF_BQ) + (size_t)qtok * 768 + g * 256 + h * 64;
  const char* Kb = p.ws + OFF_BK + (size_t)(g * 256 + h * 64) * 2;
  const char* Vb = p.ws + OFF_BV + (size_t)(g * 256 + h * 64) * 2;
  const int tfirst = (blk == 0) ? 1 : 0; int tl = (Lsub - (blk * 256 - 64)) / 64 - 1; if (tl > 5) tl = 5; const int NT = tl + 1;
  bf16x8 qr[4];
#pragma unroll
  for (int d0 = 0; d0 < 4; ++d0) qr[d0] = *(const bf16x8*)(Qp + d0 * 16 + hi * 8);
  {
    const int krow = 8 * wid + (lane >> 3), kchunk = (lane & 7) ^ ((krow >> 1) & 7);
    const int kk = 8 * wid + ((lane & 31) >> 2), vk = (kk & ~0xC) | ((kk & 4) << 1) | ((kk & 8) >> 1), vc = (lane >> 5) * 32 + (lane & 3) * 8;
    const int n0 = blk * 256 - 64;
    for (int t = tfirst; t < NT; ++t) {
      const size_t ktok = (size_t)(b * SEQ + (n0 + 64 * t + krow) * rr + mres), vtok = (size_t)(b * SEQ + (n0 + 64 * t + vk) * rr + mres);
      __builtin_amdgcn_global_load_lds((const unsigned*)(Kb + ktok * 1536 + kchunk * 16), (__attribute__((address_space(3))) unsigned*)(ldsb + t * 8192 + wid * 1024), 16, 0, 0);
      __builtin_amdgcn_global_load_lds((const unsigned*)(Vb + vtok * 1536 + vc * 2), (__attribute__((address_space(3))) unsigned*)(ldsb + VOFF + t * 8192 + wid * 1024), 16, 0, 0);
    }
  }
  asm volatile("s_waitcnt vmcnt(0)" ::: "memory");
  __syncthreads();
  float m_reg = -1e30f, l_reg = 0.f;
  f32x16 o[2] = {f32x16{}, f32x16{}};
  const int vb0 = (int)(uintptr_t)smem + VOFF + v_rd_base(lane);
  int t0 = wid >> 1; if (t0 < tfirst) t0 = tfirst; int t1 = (wid >> 1) + 2; if (t1 > NT - 1) t1 = NT - 1;
  if (wid >= 4) __builtin_amdgcn_s_setprio(1);
  for (int t = t0; t <= t1; ++t) {
    f32x16 p0 = f32x16{}, p1 = f32x16{};
    {
      const int kb_ = (int)(uintptr_t)smem + t * 8192;
      bf16x8 kf[8];
#pragma unroll
      for (int d0 = 0; d0 < 4; ++d0) { const int ka_ = kb_ + KSWZ_S(r32, (d0 * 16 + hi * 8) * 2); kf[2 * d0] = lds_rd128<0>(ka_); kf[2 * d0 + 1] = lds_rd128<4096>(ka_); }
      asm volatile("s_waitcnt lgkmcnt(0)" ::: "memory"); __builtin_amdgcn_sched_barrier(0);
#pragma unroll
      for (int d0 = 0; d0 < 4; ++d0) {
        p0 = __builtin_amdgcn_mfma_f32_32x32x16_bf16(kf[2 * d0], qr[d0], p0, 0, 0, 0);
        p1 = __builtin_amdgcn_mfma_f32_32x32x16_bf16(kf[2 * d0 + 1], qr[d0], p1, 0, 0, 0);
      }
    }
    { const int tn0 = blk * 256 - 64 + 64 * t;
#pragma unroll
      for (int r = 0; r < 16; ++r) {
        const int d0k = tn0 + crow(r, hi) - qn, d1k = d0k + 32;
        if (d0k > 64 || d0k < -64) p0[r] = -INFINITY;
        if (d1k > 64 || d1k < -64) p1[r] = -INFINITY;
      } }
    float pmax = p0[0];
#pragma unroll
    for (int r = 1; r < 16; ++r) pmax = fmaxf(pmax, p0[r]);
#pragma unroll
    for (int r = 0; r < 16; ++r) pmax = fmaxf(pmax, p1[r]);
    { auto sw = __builtin_amdgcn_permlane32_swap(__float_as_uint(pmax), __float_as_uint(pmax), false, false);
      pmax = fmaxf(__uint_as_float(sw[0]), __uint_as_float(sw[1])); }
    float mn, alpha;
    if (__all(pmax - m_reg <= THRRAW)) { mn = m_reg; alpha = 1.f; }
    else { mn = fmaxf(m_reg, pmax); alpha = __builtin_amdgcn_exp2f((m_reg - mn) * C); m_reg = mn; }
    const float mnC = -mn * C;
    float ps = 0.f;
#pragma unroll
    for (int r = 0; r < 16; ++r) { p0[r] = __builtin_amdgcn_exp2f(fmaf(p0[r], C, mnC)); ps += p0[r]; }
#pragma unroll
    for (int r = 0; r < 16; ++r) { p1[r] = __builtin_amdgcn_exp2f(fmaf(p1[r], C, mnC)); ps += p1[r]; }
    { auto sw = __builtin_amdgcn_permlane32_swap(__float_as_uint(ps), __float_as_uint(ps), false, false);
      ps = __uint_as_float(sw[0]) + __uint_as_float(sw[1]); }
    l_reg = l_reg * alpha + ps;
    bf16x8 pa0, pa1, pa2, pa3;
#define PK4(P, BASE, OUT) do { unsigned a0 = cvtpk(P[BASE + 0], P[BASE + 1]), a1 = cvtpk(P[BASE + 2], P[BASE + 3]); \
    unsigned b0_ = cvtpk(P[BASE + 4], P[BASE + 5]), b1_ = cvtpk(P[BASE + 6], P[BASE + 7]); \
    auto r0_ = __builtin_amdgcn_permlane32_swap(a0, b0_, false, false); auto r1_ = __builtin_amdgcn_permlane32_swap(a1, b1_, false, false); \
    u32x4 w_ = {r0_[0], r1_[0], r0_[1], r1_[1]}; OUT = *reinterpret_cast<bf16x8*>(&w_); } while (0)
    PK4(p0, 0, pa0); PK4(p0, 8, pa1); PK4(p1, 0, pa2); PK4(p1, 8, pa3);
#undef PK4
    if (__any(alpha < 1.f)) {
      if (hi == 0) al_l[r32] = alpha;
      asm volatile("s_waitcnt lgkmcnt(0)" ::: "memory");
#pragma unroll
      for (int r = 0; r < 16; ++r) { const float af = al_l[crow(r, hi)]; o[0][r] *= af; o[1][r] *= af; }
    }
    const int vb = vb0 + t * 8192;
    pv_one<64, 0>(o[0], vb, pa0, pa1, pa2, pa3);
    pv_one<64, 1>(o[1], vb, pa0, pa1, pa2, pa3);
  }
  __builtin_amdgcn_s_setprio(0);
  if (hi == 0) li_l[r32] = l_reg;
  asm volatile("s_waitcnt lgkmcnt(0)" ::: "memory");
  float rli[16];
#pragma unroll
  for (int r = 0; r < 16; ++r) rli[r] = __builtin_amdgcn_rcpf(li_l[crow(r, hi)]);
  bf16_t* OB = (bf16_t*)(p.ws + OFF_BQ);
  float* LSE = (float*)(p.ws + OFF_LSE);
  const int tokw = b * SEQ + (blk * 256 + wid * 32) * rr + mres;
  bf16_t* W = (bf16_t*)(smem + 98304) + wid * 2048;
#pragma unroll
  for (int d = 0; d < 2; ++d)
#pragma unroll
    for (int r = 0; r < 16; ++r) { const float y = o[d][r] * rli[r]; W[crow(r, hi) * 64 + d * 32 + r32] = (bf16_t)(cvtpk(y, y) & 0xffffu); }
  asm volatile("s_waitcnt lgkmcnt(0)" ::: "memory");
#pragma unroll
  for (int it = 0; it < 4; ++it) {
    const int idx = it * 64 + lane, row = idx >> 3, ch = idx & 7;
    const u32x4 w = *(const u32x4*)(W + row * 64 + ch * 8);
    *(u32x4*)(OB + (size_t)(tokw + row * rr) * 768 + g * 256 + h * 64 + ch * 8) = w;
  }
  if (hi == 0) LSE[((size_t)g * T + qtok) * 4 + h] = m_reg * SCALE + __logf(l_reg);
  __syncthreads();
}

DEV void phase_attn_A(const Params& p, int layer, int qsel) {
  for (int u = blockIdx.x; u < 512; u += gridDim.x) attn_unit_A(p, layer, ((u & 7) << 1) | ((u >> 8) & 1), (u >> 3) & 31);
}

DEV void phase_attn(const Params& p_in, int layer) {
  Params p = p_in; { size_t z_ = 0; asm volatile("" : "+s"(z_)); p.ws = p_in.ws + z_; }
  if (PROBE_DBL == 4) { for (int u = blockIdx.x; u < 256; u += gridDim.x) attn_unit<2>(p, layer, u); }
  phase_attn_A(p, layer, layer);
  if (PROBE_DBL == 1) phase_attn_A(p, layer, 2 + layer);
  for (int u = blockIdx.x; u < 768; u += gridDim.x) attn_unit_B(p, layer, u);
  for (int u = blockIdx.x; u < 256; u += gridDim.x) attn_unit<2>(p, layer, u);
}

__global__ void __launch_bounds__(512, 1) mk_forward(Params p) {
  cg::grid_group grid = cg::this_grid();
  unsigned* bar = (unsigned*)(p.ws + OFF_BAR);
  volatile LAS unsigned* st = (volatile LAS unsigned*)(LAS unsigned*)(smem + 131072 + 3968);
  if (threadIdx.x == 0) { st[0] = 0u; st[1] = 0u; }
  if (p.ws == nullptr) grid.sync();
  __syncthreads();
  XcdBarrier xb = xcd_barrier_post(bar, st);
  phase0(p);
  if (PROBE_DBL == 3) phase0(p);
  xcd_barrier(xb);
#pragma unroll 1
  for (int layer = 0; layer < 2; ++layer) {
    const float* xin = layer == 0 ? p.x : p.out;
    phase_norm(p, layer, xin);
    if (PROBE_DBL == 7) phase_norm(p, layer, xin);
    xcd_barrier(xb);
    phase_inproj(p, layer);
    if (PROBE_DBL == 2) phase_inproj(p, layer);
    xcd_barrier(xb);
    phase_attn(p, layer);
    xcd_barrier(xb);
    phase_gates(p);
    if (PROBE_DBL == 5) phase_gates(p);
    xcd_barrier(xb);
    phase_merge(p, layer);
    if (PROBE_DBL == 6) { xcd_barrier(xb); phase_merge(p, layer); }
    xcd_barrier(xb);
    phase_out(p, layer, xin);
    xcd_barrier(xb);
  }
  phase_final(p);
  if (PROBE_SEG && blockIdx.x == 0 && threadIdx.x == 0) {
    const unsigned long long cyc = __hip_atomic_load((unsigned long long*)(p.ws + OFF_KMX + 1024), __ATOMIC_RELAXED, __HIP_MEMORY_SCOPE_AGENT);
    const unsigned long long ticks = cyc / 40;
    const unsigned long long s0 = wall_clock64();
    while (wall_clock64() - s0 < ticks) __builtin_amdgcn_s_sleep(8);
  }
}

extern "C" void kernel_launch(void* const* d_in, const int* in_sizes, int n_in, void* d_out, int out_size, void* d_ws, size_t ws_size, hipStream_t stream) {
  static int grid_blocks = 0;
  if (ws_size < WS_NEED) { fprintf(stderr, "kernel_launch: workspace too small: %zu < %zu\n", ws_size, WS_NEED); return; }
  if (!grid_blocks) {
    int dev = 0, cus = 0, per_cu = 0;
    hipGetDevice(&dev);
    hipDeviceGetAttribute(&cus, hipDeviceAttributeMultiprocessorCount, dev);
    if (hipFuncSetAttribute((const void*)mk_forward, hipFuncAttributeMaxDynamicSharedMemorySize, LDS_BYTES) != hipSuccess) { fprintf(stderr, "kernel_launch: LDS attribute failed\n"); return; }
    hipOccupancyMaxActiveBlocksPerMultiprocessor(&per_cu, mk_forward, 512, LDS_BYTES);
    if (per_cu < 1) { fprintf(stderr, "kernel_launch: occupancy 0\n"); return; }
    grid_blocks = cus;
  }
  Params p{};
  p.x = (const float*)d_in[0]; p.c = (const float*)d_in[1]; p.pos = (const int*)d_in[2]; p.norm_gain = (const float*)d_in[3];
  p.w_ada = (const float*)d_in[4]; p.b_ada = (const float*)d_in[5]; p.w_in = (const float*)d_in[6]; p.diff_lambda = (const float*)d_in[7];
  p.subln = (const float*)d_in[8]; p.rpb = (const float*)d_in[9]; p.w_branch = (const float*)d_in[10]; p.w_out = (const float*)d_in[11];
  p.final_gain = (const float*)d_in[12]; p.out = (float*)d_out; p.ws = (char*)d_ws;
  void* args[] = {&p};
  if (hipMemsetAsync((char*)d_ws + OFF_BAR, 0, WS_NEED - OFF_BAR, stream) != hipSuccess) { fprintf(stderr, "kernel_launch: memset failed\n"); return; }
  hipError_t e = hipLaunchCooperativeKernel((void*)mk_forward, dim3(grid_blocks), dim3(512), args, LDS_BYTES, stream);
  if (e != hipSuccess) fprintf(stderr, "cooperative launch failed: %s (grid %d)\n", hipGetErrorString(e), grid_blocks);
}
```

```cpp
#include <hip/hip_runtime.h>
#include <hip/hip_cooperative_groups.h>
#include <cstdio>
#include <cstdint>
namespace cg = cooperative_groups;

#ifndef INPROJ_SKEW_TICKS
#define INPROJ_SKEW_TICKS 1500ull
#endif
#ifndef PROBE_SEG
#define PROBE_SEG 0
#endif
#ifndef PROBE_DBL
#define PROBE_DBL 0
#endif
#ifndef MK_MULTI
#define MK_MULTI 0
#endif

typedef unsigned short bf16_t;
typedef short bf16x8 __attribute__((ext_vector_type(8)));
typedef short s16x4 __attribute__((ext_vector_type(4)));
typedef float f32x4 __attribute__((ext_vector_type(4)));
typedef float f32x2 __attribute__((ext_vector_type(2)));
typedef float f32x16 __attribute__((ext_vector_type(16)));
typedef unsigned u32x4 __attribute__((ext_vector_type(4)));
typedef unsigned u32x2 __attribute__((ext_vector_type(2)));
#define DEV __device__ __forceinline__

constexpr int T = 16384, SEQ = 4096, DM = 1024, NB = 4;
constexpr int IN_COLS = 8704;
constexpr float RMS_EPS = 1e-6f;
constexpr float SCALE = 0.125f;

constexpr size_t SZ_T1024 = (size_t)T * 1024 * 2;
constexpr size_t OFF_AQK = 0;
constexpr size_t OFF_AK = OFF_AQK + (size_t)T * 512 * 2;
constexpr size_t OFF_AV = OFF_AQK + SZ_T1024;
constexpr size_t OFF_BK = OFF_AV + (size_t)T * 512 * 2;
constexpr size_t OFF_BV = OFF_BK + (size_t)T * 768 * 2;
constexpr size_t OFF_C = OFF_BV + (size_t)T * 768 * 2;
constexpr size_t OFF_BQ = OFF_C + (size_t)T * 768 * 2;
constexpr size_t OFF_Z = OFF_BQ + (size_t)T * 768 * 2;
constexpr size_t OFF_H = OFF_Z + SZ_T1024;
constexpr size_t OFF_Y = OFF_H + SZ_T1024;
constexpr size_t OFF_WIN = OFF_Y + SZ_T1024;
constexpr size_t OFF_WBR = OFF_WIN + (size_t)IN_COLS * 1024 * 2;
constexpr size_t OFF_WOUT = OFF_WBR + (size_t)2 * 1024 * 1024 * 2;
constexpr size_t OFF_LSE = OFF_WOUT + (size_t)2 * 1024 * 1024 * 2;
constexpr size_t OFF_ROPE = OFF_LSE + (size_t)3 * T * 4 * 4;
constexpr size_t OFF_MOD = OFF_ROPE + (size_t)T * 8 * 8;
constexpr size_t OFF_LAM = OFF_MOD + (size_t)2 * 4 * 3072 * 4;
constexpr size_t OFF_BAR = OFF_LAM + 256;
constexpr size_t OFF_CNT = OFF_BAR + 3456 * 4;
constexpr size_t OFF_KMX = OFF_CNT + 256 * 4;
constexpr size_t WS_NEED = OFF_KMX + 128 * 4 + 8192;
constexpr size_t OFF_G = OFF_AQK;

constexpr int LDS_BYTES = 131072 + 4096;

struct Params {
  const float* x; const float* c; const int* pos; const float* norm_gain; const float* w_ada; const float* b_ada; const float* w_in;
  const float* diff_lambda; const float* subln; const float* rpb; const float* w_branch; const float* w_out; const float* final_gain;
  float* out; char* ws;
};

extern __shared__ __attribute__((aligned(16))) char smem[];

DEV unsigned cvtpk(float lo, float hi) { unsigned r; asm volatile("v_cvt_pk_bf16_f32 %0, %1, %2" : "=v"(r) : "v"(lo), "v"(hi)); return r; }
DEV unsigned cvtpk_t(float lo, float hi) { unsigned r; asm volatile("s_nop 1\n\tv_cvt_pk_bf16_f32 %0, %1, %2" : "=v"(r) : "v"(lo), "v"(hi)); return r; }
DEV float bflo(unsigned w) { return __uint_as_float(w << 16); }
DEV float bfhi(unsigned w) { return __uint_as_float(w & 0xffff0000u); }
DEV float bf2f(bf16_t v) { return __uint_as_float(((unsigned)v) << 16); }
DEV float sigmoidf(float x) { return __builtin_amdgcn_rcpf(1.0f + __expf(-x)); }
DEV float sig2(float t) { return __builtin_amdgcn_rcpf(1.0f + __builtin_amdgcn_exp2f(t)); }
DEV float siluf(float x) { return x * __builtin_amdgcn_rcpf(1.0f + __expf(-x)); }
DEV int perm32(int rho) { const int n = rho >> 4, i = rho & 15; return 8 * (i >> 2) + 4 * n + (i & 3); }
DEV int ltid() { int t = threadIdx.x; asm volatile("" : "+v"(t)); return t; }
DEV int lbid() { int t = blockIdx.x; asm volatile("" : "+s"(t)); return t; }
DEV int crow(int r, int hi) { return (r & 3) + 8 * (r >> 2) + 4 * hi; }

#define XB_TMO      128
#define XB_XCNT(j)  (256  + 64 * (j))
#define XB_XSUB(j)  (1280 + 64 * (j))
#define XB_XGEN(j)  (2304 + 64 * (j))
#define XB_TOP      3328
#define XB_TOPGEN   3392
#define XCD_BAR_WORDS 3456
#define XB_SPIN_CAP (1u << 18)
#define LAS __attribute__((address_space(3)))
DEV unsigned xb_ld(unsigned* p) { return __hip_atomic_load(p, __ATOMIC_RELAXED, __HIP_MEMORY_SCOPE_AGENT); }
DEV unsigned xb_add(unsigned* p, unsigned v) { return __hip_atomic_fetch_add(p, v, __ATOMIC_RELAXED, __HIP_MEMORY_SCOPE_AGENT); }
DEV unsigned xb_xcc_id() { return (unsigned)__builtin_amdgcn_s_getreg((3 << 11) | 20) & 0xFu; }
#define XB_SPIN(cond, bar) do { unsigned _sp = 0; while (cond) { __builtin_amdgcn_s_sleep(1); \
    if ((++_sp & 255u) == 0u) { if (xb_ld(&(bar)[XB_TMO])) break; if (_sp > XB_SPIN_CAP) { atomicAdd(&(bar)[XB_TMO], 1u); break; } } } } while (0)
struct XcdBarrier { unsigned* bar; unsigned x; volatile LAS unsigned* st; };
DEV XcdBarrier xcd_barrier_post(unsigned* bar, volatile LAS unsigned* st) {
  XcdBarrier b; b.bar = bar; b.x = xb_xcc_id(); b.st = st;
  if (threadIdx.x == 0) (void)xb_add(&bar[XB_XCNT(b.x)], 1u);
  return b;
}
DEV void xcd_barrier_complete(unsigned* bar, unsigned x, unsigned& nloc, unsigned& nx) {
  const unsigned G = gridDim.x * gridDim.y * gridDim.z;
  unsigned sum, cnt, mine, sp = 0u;
  for (;;) {
    sum = 0u; cnt = 0u; mine = 0u;
#pragma unroll
    for (unsigned j = 0; j < 16; ++j) { const unsigned c = xb_ld(&bar[XB_XCNT(j)]); sum += c; cnt += (c > 0u) ? 1u : 0u; mine = (j == x) ? c : mine; }
    if (sum == G) break;
    __builtin_amdgcn_s_sleep(1);
    if ((++sp & 255u) == 0u) { if (xb_ld(&bar[XB_TMO])) break; if (sp > XB_SPIN_CAP) { atomicAdd(&bar[XB_TMO], 1u); break; } }
  }
  nloc = mine > 0u ? mine : 1u; nx = cnt > 0u ? cnt : 1u;
}
DEV void xcd_barrier(const XcdBarrier& b) {
  asm volatile("s_waitcnt vmcnt(0)" ::: "memory");
  __syncthreads();
  if (threadIdx.x == 0) {
    size_t bz_ = 0; unsigned bx = b.x;
    asm volatile("" : "+s"(bz_), "+s"(bx));
    unsigned* bar = b.bar + bz_;
    __builtin_amdgcn_s_waitcnt(0);
    unsigned nloc = b.st[0], nx = b.st[1];
    if (nloc == 0u) { xcd_barrier_complete(bar, bx, nloc, nx); b.st[0] = nloc; b.st[1] = nx; }
    const unsigned old = xb_add(&bar[XB_XSUB(bx)], 1u);
    const unsigned gen = old / nloc;
    if (old + 1u == (gen + 1u) * nloc) {
      __builtin_amdgcn_fence(__ATOMIC_RELEASE, "agent");
      asm volatile("s_waitcnt vmcnt(0)" ::: "memory");
      const unsigned og = xb_add(&bar[XB_TOP], 1u);
      const unsigned tg = og / nx;
      if (og + 1u == (tg + 1u) * nx) xb_add(&bar[XB_TOPGEN], 1u);
      else XB_SPIN(xb_ld(&bar[XB_TOPGEN]) == tg, bar);
      __builtin_amdgcn_fence(__ATOMIC_ACQUIRE, "agent");
      xb_add(&bar[XB_XGEN(bx)], 1u);
      asm volatile("s_waitcnt vmcnt(0)" ::: "memory");
    } else {
      XB_SPIN(xb_ld(&bar[XB_XGEN(bx)]) == gen, bar);
      __builtin_amdgcn_fence(__ATOMIC_ACQUIRE, "agent");
      asm volatile("s_waitcnt vmcnt(0)" ::: "memory");
    }
  }
  __syncthreads();
}

DEV int win_src_col(int j) {
  const int c = (j & ~31) + perm32(j & 31);
  int orig; bool rope;
  if (c < 1024) { orig = c; rope = true; }
  else if (c < 1536) { orig = c; rope = false; }
  else if (c < 2304) { orig = 2304 + (c - 1536); rope = true; }
  else if (c < 3072) { orig = 3072 + (c - 2304); rope = false; }
  else if (c < 3840) { orig = 3840 + (c - 3072); rope = false; }
  else if (c < 4608) { orig = 1536 + (c - 3840); rope = true; }
  else { orig = c; rope = false; }
  if (rope) { int p = orig & 63; if (p < 16) { const int i = p >> 1; p = (p & 1) ? i + 8 : i; orig = (orig & ~63) + p; } }
  return orig;
}

struct CvtTile { const float* src; int ld; bf16_t* dst; int j0, k0, o0; bool win; };
DEV void cvt_decode(const Params& p, int layer, int t, CvtTile& c) {
  if (t < 2176) { const int kt = t & 15, nt = t >> 4; c.src = p.w_in + (size_t)layer * 1024 * IN_COLS; c.ld = IN_COLS; c.dst = (bf16_t*)(p.ws + OFF_WIN); c.j0 = nt * 64; c.k0 = kt * 64; c.o0 = win_src_col(c.j0) & ~63; c.win = true; }
  else { const int tt0 = t - 2176, mat = tt0 >> 8, tt = tt0 & 255, kt = tt & 15, nt = tt >> 4, l = mat & 1;
    c.src = (mat < 2 ? p.w_branch : p.w_out) + (size_t)l * 1024 * 1024; c.ld = 1024; c.dst = (bf16_t*)(p.ws + (mat < 2 ? OFF_WBR : OFF_WOUT)) + (size_t)l * 1024 * 1024; c.j0 = nt * 64; c.k0 = kt * 64; c.o0 = c.j0; c.win = false; }
}
DEV void cvt_range(const Params& p, int layer, int tbeg, int tend) {
  float* l = (float*)smem;
  const int tid = ltid();
  int t = tbeg + blockIdx.x;
  if (t >= tend) return;
  CvtTile c; cvt_decode(p, layer, t, c);
  f32x4 v0, v1;
  { const int kr = tid >> 4, c4 = (tid & 15) * 4;
    v0 = *(const f32x4*)(c.src + (size_t)(c.k0 + kr) * c.ld + c.o0 + c4); v1 = *(const f32x4*)(c.src + (size_t)(c.k0 + 32 + kr) * c.ld + c.o0 + c4); }
  for (;;) {
    { const int kr = tid >> 4, c4 = (tid & 15) * 4;
      l[kr * 65 + c4 + 0] = v0[0]; l[kr * 65 + c4 + 1] = v0[1]; l[kr * 65 + c4 + 2] = v0[2]; l[kr * 65 + c4 + 3] = v0[3];
      l[(kr + 32) * 65 + c4 + 0] = v1[0]; l[(kr + 32) * 65 + c4 + 1] = v1[1]; l[(kr + 32) * 65 + c4 + 2] = v1[2]; l[(kr + 32) * 65 + c4 + 3] = v1[3]; }
    __syncthreads();
    const int tn = t + gridDim.x; CvtTile cn;
    if (tn < tend) { cvt_decode(p, layer, tn, cn); const int kr = tid >> 4, c4 = (tid & 15) * 4;
      v0 = *(const f32x4*)(cn.src + (size_t)(cn.k0 + kr) * cn.ld + cn.o0 + c4); v1 = *(const f32x4*)(cn.src + (size_t)(cn.k0 + 32 + kr) * cn.ld + cn.o0 + c4); }
    const int jj = tid >> 3, kc = (tid & 7) * 8, j = c.j0 + jj;
    const int oc = (c.win ? win_src_col(j) : ((j & ~31) + perm32(j & 31))) - c.o0;
    const float ws_ = (c.win && j >= 5632) ? -1.4426950408889634f : 1.0f;
    u32x4 w;
    w[0] = cvtpk(l[(kc + 0) * 65 + oc] * ws_, l[(kc + 1) * 65 + oc] * ws_);
    w[1] = cvtpk(l[(kc + 2) * 65 + oc] * ws_, l[(kc + 3) * 65 + oc] * ws_);
    w[2] = cvtpk(l[(kc + 4) * 65 + oc] * ws_, l[(kc + 5) * 65 + oc] * ws_);
    w[3] = cvtpk(l[(kc + 6) * 65 + oc] * ws_, l[(kc + 7) * 65 + oc] * ws_);
    *(u32x4*)(c.dst + (size_t)j * 1024 + c.k0 + kc) = w;
    __syncthreads();
    if (tn >= tend) break;
    t = tn; c = cn;
  }
}
DEV void cvt_win_layer(const Params& p, int layer) { cvt_range(p, layer, 0, 2176); }

DEV void phase0(const Params& p_in) {
  Params p = p_in; { size_t z_ = 0; asm volatile("" : "+s"(z_)); p.ws = p_in.ws + z_; }
  const int tid = ltid();
  cvt_range(p, 0, 0, 3200);
  float* mod = (float*)(p.ws + OFF_MOD);
  if (blockIdx.x < 192) {
    float* cact = (float*)smem; float* l4 = (float*)(smem + 16384);
    for (int i = tid; i < 4096; i += 512) cact[i] = siluf(p.c[i]);
    __syncthreads();
    for (int it = blockIdx.x; it < 192; it += gridDim.x) {
      const int l = it / 96, j0 = (it % 96) * 32, w = tid >> 6, lane = tid & 63, cl = lane & 31, kh = w * 2 + (lane >> 5);
      const float* wa = p.w_ada + (size_t)l * 1024 * 3072 + j0 + cl;
      float a0 = 0.f, a1 = 0.f, a2 = 0.f, a3 = 0.f;
      for (int k = kh * 64; k < kh * 64 + 64; k += 16) {
        float wv[16];
#pragma unroll
        for (int q = 0; q < 16; ++q) wv[q] = wa[(size_t)(k + q) * 3072];
#pragma unroll
        for (int q = 0; q < 16; ++q) { a0 += cact[k + q] * wv[q]; a1 += cact[1024 + k + q] * wv[q]; a2 += cact[2048 + k + q] * wv[q]; a3 += cact[3072 + k + q] * wv[q]; }
      }
      l4[(kh * 4 + 0) * 32 + cl] = a0; l4[(kh * 4 + 1) * 32 + cl] = a1; l4[(kh * 4 + 2) * 32 + cl] = a2; l4[(kh * 4 + 3) * 32 + cl] = a3;
      __syncthreads();
      if (tid < 128) {
        const int b = tid >> 5, c2 = tid & 31; float s = 0.f;
        for (int q = 0; q < 16; ++q) s += l4[(q * 4 + b) * 32 + c2];
        mod[((size_t)l * 4 + b) * 3072 + j0 + c2] = s + p.b_ada[l * 3072 + j0 + c2];
      }
      __syncthreads();
    }
  }
  f32x2* rope = (f32x2*)(p.ws + OFF_ROPE);
  for (int i = blockIdx.x * 512 + tid; i < T * 8; i += gridDim.x * 512) {
    const int tok = i >> 3, fi = i & 7;
    float inv;
    switch (fi) { case 0: inv = 1.0f; break; case 1: inv = 0.1939227432012558f; break; case 2: inv = 0.03760603070259094f; break; case 3: inv = 0.007292664609849453f; break;
                  case 4: inv = 0.0014142135623842478f; break; case 5: inv = 0.00027424818836152554f; break; case 6: inv = 5.318296098266728e-05f; break; default: inv = 1.0313386155758053e-05f; break; }
    const float angf = (float)p.pos[tok] * inv;
    const double a = (double)angf;
    const double q = rint(a * 0.63661977236758134308);
    double r = fma(-q, 1.57079632679489655800, a); r = fma(-q, 6.12323399573676603587e-17, r);
    const int n = ((int)q) & 3;
    const double r2 = r * r;
    const double sn = r + r * r2 * (-1.0 / 6 + r2 * (1.0 / 120 + r2 * (-1.0 / 5040 + r2 * (1.0 / 362880 - r2 * (1.0 / 39916800)))));
    const double cs = 1.0 + r2 * (-0.5 + r2 * (1.0 / 24 + r2 * (-1.0 / 720 + r2 * (1.0 / 40320 + r2 * (-1.0 / 3628800 + r2 * (1.0 / 479001600))))));
    double co, si;
    if (n == 0) { co = cs; si = sn; } else if (n == 1) { co = -sn; si = cs; } else if (n == 2) { co = -cs; si = -sn; } else { co = sn; si = -cs; }
    rope[i] = (f32x2){(float)co, (float)si};
  }
  if (blockIdx.x == 0 && tid < 2) {
    const float* dl = p.diff_lambda + tid * 256;
    float s1 = 0.f, s2 = 0.f;
    for (int i = 0; i < 64; ++i) { s1 += dl[i] * dl[64 + i]; s2 += dl[128 + i] * dl[192 + i]; }
    const float li = 0.8f - 0.6f * expf(-0.3f * (float)tid);
    ((float*)(p.ws + OFF_LAM))[tid] = expf(s1) - expf(s2) + li;
  }
}

DEV void phase_norm(const Params& p_in, int layer, const float* __restrict__ xin) {
  Params p = p_in; { size_t z_ = 0; asm volatile("" : "+s"(z_)); p.ws = p_in.ws + z_; }
  const int tid_ = ltid(); const int wid = tid_ >> 6, lane = tid_ & 63;
  const float* mod = (const float*)(p.ws + OFF_MOD) + (size_t)layer * 4 * 3072;
  const float* gain = p.norm_gain + layer * 1024;
  bf16_t* H = (bf16_t*)(p.ws + OFF_H);
  for (int row = blockIdx.x * 8 + wid; row < T; row += gridDim.x * 16) {
    const int rowB = row + gridDim.x * 8; const bool hasB = rowB < T;
    const float* xr = xin + (size_t)row * 1024; const float* xrB = xin + (size_t)(hasB ? rowB : row) * 1024;
    f32x4 v[4], vB[4]; float ss = 0.f, ssB = 0.f;
#pragma unroll
    for (int i = 0; i < 4; ++i) { v[i] = *(const f32x4*)(xr + i * 256 + lane * 4); vB[i] = *(const f32x4*)(xrB + i * 256 + lane * 4); }
#pragma unroll
    for (int i = 0; i < 4; ++i) { ss += v[i][0] * v[i][0] + v[i][1] * v[i][1] + v[i][2] * v[i][2] + v[i][3] * v[i][3]; ssB += vB[i][0] * vB[i][0] + vB[i][1] * vB[i][1] + vB[i][2] * vB[i][2] + vB[i][3] * vB[i][3]; }
#pragma unroll
    for (int o = 32; o > 0; o >>= 1) { ss += __shfl_xor(ss, o); ssB += __shfl_xor(ssB, o); }
    const float rstd = rsqrtf(ss * (1.0f / 1024.0f) + RMS_EPS), rstdB = rsqrtf(ssB * (1.0f / 1024.0f) + RMS_EPS);
    const int b = row >> 12, bB = (hasB ? rowB : row) >> 12;
#pragma unroll
    for (int i = 0; i < 4; ++i) {
      const int c = i * 256 + lane * 4;
      const f32x4 g = *(const f32x4*)(gain + c);
      { const f32x4 sh = *(const f32x4*)(mod + b * 3072 + c), sc = *(const f32x4*)(mod + b * 3072 + 1024 + c);
        float h0 = v[i][0] * rstd * g[0] * (1.f + sc[0]) + sh[0], h1 = v[i][1] * rstd * g[1] * (1.f + sc[1]) + sh[1];
        float h2 = v[i][2] * rstd * g[2] * (1.f + sc[2]) + sh[2], h3 = v[i][3] * rstd * g[3] * (1.f + sc[3]) + sh[3];
        u32x2 w; w[0] = cvtpk(h0, h1); w[1] = cvtpk(h2, h3);
        *(u32x2*)(H + (size_t)row * 1024 + c) = w; }
      if (hasB) { const f32x4 sh = *(const f32x4*)(mod + bB * 3072 + c), sc = *(const f32x4*)(mod + bB * 3072 + 1024 + c);
        float h0 = vB[i][0] * rstdB * g[0] * (1.f + sc[0]) + sh[0], h1 = vB[i][1] * rstdB * g[1] * (1.f + sc[1]) + sh[1];
        float h2 = vB[i][2] * rstdB * g[2] * (1.f + sc[2]) + sh[2], h3 = vB[i][3] * rstdB * g[3] * (1.f + sc[3]) + sh[3];
        u32x2 w; w[0] = cvtpk(h0, h1); w[1] = cvtpk(h2, h3);
        *(u32x2*)(H + (size_t)rowB * 1024 + c) = w; }
    }
  }
}

DEV void phase_final(const Params& p_in) {
  Params p = p_in; { size_t z_ = 0; asm volatile("" : "+s"(z_)); p.ws = p_in.ws + z_; }
  const int tid_ = ltid(); const int wid = tid_ >> 6, lane = tid_ & 63;
  for (int row = blockIdx.x * 8 + wid; row < T; row += gridDim.x * 8) {
    float* xr = p.out + (size_t)row * 1024;
    f32x4 v[4]; float ss = 0.f;
#pragma unroll
    for (int i = 0; i < 4; ++i) { v[i] = *(const f32x4*)(xr + i * 256 + lane * 4); ss += v[i][0] * v[i][0] + v[i][1] * v[i][1] + v[i][2] * v[i][2] + v[i][3] * v[i][3]; }
#pragma unroll
    for (int o = 32; o > 0; o >>= 1) ss += __shfl_xor(ss, o);
    const float rstd = rsqrtf(ss * (1.0f / 1024.0f) + RMS_EPS);
#pragma unroll
    for (int i = 0; i < 4; ++i) {
      const int c = i * 256 + lane * 4;
      const f32x4 g = *(const f32x4*)(p.final_gain + c);
      f32x4 o; o[0] = v[i][0] * rstd * g[0]; o[1] = v[i][1] * rstd * g[1]; o[2] = v[i][2] * rstd * g[2]; o[3] = v[i][3] * rstd * g[3];
      *(f32x4*)(xr + c) = o;
    }
  }
}

constexpr int HALF = 128, BK = 64, HT = HALF * BK;
DEV int lds_byte(int r, int c) { const int st = (r >> 4) * 2 + (c >> 5), rr = r & 15, cc = c & 31, ob = rr * 64 + cc * 2; return st * 1024 + (ob ^ (((ob >> 9) & 1) << 5)); }
DEV void stage_rc(int b, int& R, int& C) { const int st = b / 1024, sb = b % 1024, swz = sb ^ (((sb >> 9) & 1) << 5); R = (st >> 1) * 16 + swz / 64; C = (st & 1) * 32 + (swz % 64) / 2; }

DEV bool gemm_next(int i, int nM, int nN, int& pm, int& pn) {
  const int nwg = nM * nN; const long L = (long)i * gridDim.x + blockIdx.x; if (L >= nwg) return false;
  int wgid = (int)L; { const int q = nwg / 8, r = nwg % 8, xcd = wgid % 8, off = wgid / 8; wgid = (xcd < r ? xcd * (q + 1) : r * (q + 1) + (xcd - r) * q) + off; }
  const int nig = 8 * nN, gid = wgid / nig, fm = gid * 8, gsz = (nM - fm) < 8 ? (nM - fm) : 8;
  pm = fm + ((wgid % nig) % gsz); pn = (wgid % nig) / gsz; return true;
}

struct GUnit { const char* a; const char* b; int nt, pm, pn, s; };
typedef __attribute__((address_space(3))) unsigned char LDSC;
template <class Next, class Epi>
DEV void gemm_stream(Next&& next, Epi&& epi) {
  LDSC* lds = (LDSC*)smem;
  const int tid = ltid(), wid = __builtin_amdgcn_readfirstlane(tid >> 6), lane = tid & 63, wr = wid >> 2, wc = wid & 3, fr = lane & 15, fq = lane >> 4;
  unsigned voff[2];
#pragma unroll
  for (int i = 0; i < 2; ++i) { int R, C; stage_rc(tid * 16 + i * 8192, R, C); voff[i] = (unsigned)(R * 1024 + C) * 2u; }
  constexpr size_t kstep = 128, hstep = (size_t)128 * 1024 * 2;
  constexpr int HTB = 128 * 64 * 2;
  const unsigned ldsw = (unsigned)wid * 1024u;
  const int aoff = lds_byte(wr * 64 + fr, fq * 8), boff = lds_byte(wc * 32 + fr, fq * 8);
#define G_SA(b, h) (((b) * 2 + (h)) * HTB)
#define G_SB(b, h) ((4 + (b) * 2 + (h)) * HTB)
#define G_STAGE(bufoff, gbase) do { _Pragma("unroll") for (int _i = 0; _i < 2; ++_i) \
    __builtin_amdgcn_global_load_lds((const unsigned*)((const char*)(gbase) + voff[_i]), (__attribute__((address_space(3))) unsigned*)(lds + (bufoff) + ldsw + _i * 8192), 16, 0, 0); } while (0)
#define G_LDA(dst, b, h) do { _Pragma("unroll") for (int m = 0; m < 4; ++m) _Pragma("unroll") for (int k = 0; k < 2; ++k) dst[m][k] = *(const __attribute__((address_space(3))) bf16x8*)(lds + G_SA(b, h) + aoff + m * 2048 + k * 1024); } while (0)
#define G_LDB(dst, b, h) do { _Pragma("unroll") for (int n = 0; n < 2; ++n) _Pragma("unroll") for (int k = 0; k < 2; ++k) dst[n][k] = *(const __attribute__((address_space(3))) bf16x8*)(lds + G_SB(b, h) + boff + n * 2048 + k * 1024); } while (0)
#define G_MMA(ai, bj, At, Bf) do { __builtin_amdgcn_s_setprio(1); _Pragma("unroll") for (int m = 0; m < 4; ++m) _Pragma("unroll") for (int n = 0; n < 2; ++n) _Pragma("unroll") for (int k = 0; k < 2; ++k) \
    acc[ai][bj][m][n] = __builtin_amdgcn_mfma_f32_16x16x32_bf16(Bf[n][k], At[m][k], acc[ai][bj][m][n], 0, 0, 0); __builtin_amdgcn_s_setprio(0); } while (0)
#define G_WAIT_V(n) asm volatile("s_waitcnt vmcnt(" #n ")" ::: "memory")
#define G_WAIT_L(n) asm volatile("s_waitcnt lgkmcnt(" #n ")" ::: "memory")
#define G_BAR __builtin_amdgcn_s_barrier()
#define G_SCHED __builtin_amdgcn_sched_barrier(0)
  GUnit cur, nxt; int ui = 0;
  if (!next(0, cur)) return;
  f32x4 acc[2][2][4][2];
#pragma unroll
  for (int a = 0; a < 2; ++a)
#pragma unroll
    for (int b = 0; b < 2; ++b)
#pragma unroll
      for (int m = 0; m < 4; ++m)
#pragma unroll
        for (int n = 0; n < 2; ++n) acc[a][b][m][n] = (f32x4){0.f, 0.f, 0.f, 0.f};
  bf16x8 At[4][2], B0[2][2], B1[2][2];
  const char* cA = cur.a; const char* cB = cur.b;
  G_STAGE(G_SB(0, 0), cB); G_STAGE(G_SA(0, 0), cA); G_STAGE(G_SB(0, 1), cB + hstep); G_STAGE(G_SA(0, 1), cA + hstep);
  if (wr == 1) G_BAR;
  G_WAIT_V(4); G_BAR;
  G_STAGE(G_SB(1, 0), cB + kstep); G_STAGE(G_SA(1, 0), cA + kstep); G_STAGE(G_SB(1, 1), cB + hstep + kstep);
  G_WAIT_V(6); G_BAR;
  for (;;) {
    const bool has_next = next(ui + 1, nxt);
    const char* nA = has_next ? nxt.a : cA; const char* nB = has_next ? nxt.b : cB;
    const int nt = cur.nt;
    for (int t = 0; t < nt; t += 2) {
      const bool last = (t == nt - 2);
      const char* a1 = cA + (size_t)(t + 1) * kstep;
      const char* a2 = last ? nA : cA + (size_t)(t + 2) * kstep; const char* b2 = last ? nB : cB + (size_t)(t + 2) * kstep;
      const char* a3 = a2 + kstep; const char* b3 = b2 + kstep;
      G_LDB(B0, 0, 0); G_SCHED; G_LDA(At, 0, 0); G_STAGE(G_SA(1, 1), a1 + hstep);
      G_WAIT_L(8); G_BAR; G_WAIT_L(0); G_MMA(0, 0, At, B0); G_BAR; G_SCHED;
      G_LDB(B1, 0, 1); G_STAGE(G_SB(0, 0), b2);
      G_BAR; G_WAIT_L(0); G_MMA(0, 1, At, B1); G_BAR;
      G_LDA(At, 0, 1); G_STAGE(G_SA(0, 0), a2);
      G_BAR; G_WAIT_L(0); G_MMA(1, 0, At, B0); G_BAR; G_SCHED;
      G_STAGE(G_SB(0, 1), b2 + hstep);
      G_WAIT_V(6); G_BAR; G_MMA(1, 1, At, B1); G_BAR;
      G_LDB(B0, 1, 0); G_SCHED; G_LDA(At, 1, 0); G_STAGE(G_SA(0, 1), a2 + hstep);
      G_WAIT_L(8); G_BAR; G_WAIT_L(0); G_MMA(0, 0, At, B0); G_BAR; G_SCHED;
      G_LDB(B1, 1, 1); G_STAGE(G_SB(1, 0), b3);
      G_BAR; G_WAIT_L(0); G_MMA(0, 1, At, B1); G_BAR;
      G_LDA(At, 1, 1); G_STAGE(G_SA(1, 0), a3);
      G_BAR; G_WAIT_L(0); G_MMA(1, 0, At, B0); G_BAR; G_SCHED;
      G_STAGE(G_SB(1, 1), b3 + hstep);
      G_WAIT_V(6); G_BAR; G_MMA(1, 1, At, B1); G_BAR;
    }
    epi(acc, cur, wr, wc, fr, fq);
    if (!has_next) break;
#pragma unroll
    for (int a = 0; a < 2; ++a)
#pragma unroll
      for (int b = 0; b < 2; ++b)
#pragma unroll
        for (int m = 0; m < 4; ++m)
#pragma unroll
          for (int n = 0; n < 2; ++n) acc[a][b][m][n] = (f32x4){0.f, 0.f, 0.f, 0.f};
    cur = nxt; cA = nA; cB = nB; ++ui;
  }
  G_WAIT_V(0);
  if (wr == 0) G_BAR;
  G_BAR;
#undef G_SA
#undef G_SB
#undef G_STAGE
#undef G_LDA
#undef G_LDB
#undef G_MMA
}

DEV void phase_inproj(const Params& p_in, int layer) {
  Params p = p_in; { size_t z_ = 0; asm volatile("" : "+s"(z_)); p.ws = p_in.ws + z_; }
  const char* H = p.ws + OFF_H;
  const char* W = p.ws + OFF_WIN;
  const f32x4* rope = (const f32x4*)(p.ws + OFF_ROPE);
  char* ws = p.ws;
  if (5 * (int)gridDim.x + (int)blockIdx.x >= 1408) { __builtin_amdgcn_s_sleep(127); __builtin_amdgcn_s_sleep(127); __builtin_amdgcn_s_sleep(127); __builtin_amdgcn_s_sleep(127); }
  __syncthreads();
  gemm_stream([&](int i, GUnit& u) -> bool {
      int pm, pn; if (!gemm_next(i, 64, 22, pm, pn)) return false;
      u.a = H + (size_t)pm * 256 * 2048; u.b = W + (size_t)pn * 256 * 2048; u.nt = 16; u.pm = pm; u.pn = pn; u.s = 0; return true; },
    [&](f32x4 (&acc)[2][2][4][2], const GUnit& u, int wr, int wc, int fr, int fq) {
      const int c0 = u.pn * 256;
      size_t base; int ld, lc; bool rp;
      const int akv = (c0 >= 512 && c0 < 1536) ? 1 : 0;
      if (c0 < 512) { base = OFF_AQK; ld = 512; lc = c0; rp = true; }
      else if (c0 < 1024) { base = OFF_AK; ld = 128; lc = 0; rp = true; }
      else if (c0 < 1536) { base = OFF_AV; ld = 128; lc = 0; rp = false; }
      else if (c0 < 2304) { base = OFF_BK; ld = 768; lc = c0 - 1536; rp = true; }
      else if (c0 < 3072) { base = OFF_BV; ld = 768; lc = c0 - 2304; rp = false; }
      else if (c0 < 3840) { base = OFF_C; ld = 768; lc = c0 - 3072; rp = false; }
      else if (c0 < 4608) { base = OFF_BQ; ld = 768; lc = c0 - 3840; rp = true; }
      else { base = OFF_Z; ld = 1024; lc = c0 - 4608; rp = false; }
      bf16_t* dst = (bf16_t*)(ws + base);
      const bool dorope = rp && ((wc & 1) == 0) && (fq < 2);
      const bool isk = (c0 >= 512 && c0 < 1024);
      const int head0 = ((c0 >> 8) & 1) * 2;
      float kmx0 = 0.f, kmx1 = 0.f;
      const bool ropewave = rp && ((wc & 1) == 0);
#pragma unroll
      for (int ai = 0; ai < 2; ++ai) {
        f32x4 csA[4], csB[4];
        if (ropewave) {
#pragma unroll
          for (int m = 0; m < 4; ++m) { const size_t ri = (size_t)(u.pm * 256 + ai * 128 + wr * 64 + m * 16 + fr) * 4 + (fq & 1) * 2; csA[m] = rope[ri]; csB[m] = rope[ri + 1]; }
          asm volatile("" ::: "memory");
        }
#pragma unroll
        for (int m = 0; m < 4; ++m) {
          const int row = u.pm * 256 + ai * 128 + wr * 64 + m * 16 + fr;
          f32x4 cs0 = {1.f, 0.f, 1.f, 0.f}, cs1 = {1.f, 0.f, 1.f, 0.f};
          if (dorope) { cs0 = csA[m]; cs1 = csB[m]; }
#pragma unroll
          for (int bj = 0; bj < 2; ++bj) {
            f32x4 v0 = acc[ai][bj][m][0], v1 = acc[ai][bj][m][1];
            if (dorope) {
              f32x4 a, b;
              a[0] = v0[0] * cs0[0] - v0[1] * cs0[1]; a[1] = v0[1] * cs0[0] + v0[0] * cs0[1];
              a[2] = v0[2] * cs0[2] - v0[3] * cs0[3]; a[3] = v0[3] * cs0[2] + v0[2] * cs0[3];
              b[0] = v1[0] * cs1[0] - v1[1] * cs1[1]; b[1] = v1[1] * cs1[0] + v1[0] * cs1[1];
              b[2] = v1[2] * cs1[2] - v1[3] * cs1[3]; b[3] = v1[3] * cs1[2] + v1[2] * cs1[3];
              v0 = a; v1 = b;
            }
            u32x4 w; w[0] = cvtpk(v0[0], v0[1]); w[1] = cvtpk(v0[2], v0[3]); w[2] = cvtpk(v1[0], v1[1]); w[3] = cvtpk(v1[2], v1[3]);
            if (akv) *(u32x4*)(dst + ((size_t)(((row >> 12) * 4 + head0 + bj) * SEQ + (row & 4095))) * 128 + wc * 32 + fq * 8) = w;
            else *(u32x4*)(dst + (size_t)row * ld + lc + bj * 128 + wc * 32 + fq * 8) = w;
            if (isk) {
              float s = v0[0] * v0[0] + v0[1] * v0[1] + v0[2] * v0[2] + v0[3] * v0[3] + v1[0] * v1[0] + v1[1] * v1[1] + v1[2] * v1[2] + v1[3] * v1[3];
              s += __shfl_xor(s, 16); s += __shfl_xor(s, 32);
              if (bj == 0) kmx0 = fmaxf(kmx0, s); else kmx1 = fmaxf(kmx1, s);
            }
          }
        }
      }
      if (isk) {
#pragma unroll
        for (int o_ = 1; o_ < 16; o_ <<= 1) { kmx0 = fmaxf(kmx0, __shfl_xor(kmx0, o_)); kmx1 = fmaxf(kmx1, __shfl_xor(kmx1, o_)); }
        if ((threadIdx.x & 63) == 0) {
          unsigned* kmx = (unsigned*)(ws + OFF_KMX) + layer * 64 + (u.pm >> 4) * 16 + (wc >> 1) * 2 + (wc & 1);
          atomicMax(kmx + (head0 + 0) * 4, __float_as_uint(kmx0));
          atomicMax(kmx + (head0 + 1) * 4, __float_as_uint(kmx1));
        }
      }
    });
}

DEV void phase_gates(const Params& p_in) {
  Params p = p_in; { size_t z_ = 0; asm volatile("" : "+s"(z_)); p.ws = p_in.ws + z_; }
  {
    const bf16_t* OB = (const bf16_t*)(p.ws + OFF_BQ);
    const float* LSE = (const float*)(p.ws + OFF_LSE);
    const bf16_t* Z = (const bf16_t*)(p.ws + OFF_Z);
    bf16_t* Y = (bf16_t*)(p.ws + OFF_Y);
    const int i0 = blockIdx.x * 512 + ltid(), istep = gridDim.x * 512;
    for (int ib = i0; ib < T * 32; ib += 4 * istep) {
      float l0[4], l1[4], l2[4]; u32x4 a[4], b[4], c[4], z[4];
#pragma unroll
      for (int k = 0; k < 4; ++k) {
        const int i = ib + k * istep;
        if (i < T * 32) {
          const int tok = i >> 5, hs = (i >> 3) & 3, dc = (i & 7) * 8;
          l0[k] = LSE[((size_t)0 * T + tok) * 4 + hs]; l1[k] = LSE[((size_t)1 * T + tok) * 4 + hs]; l2[k] = LSE[((size_t)2 * T + tok) * 4 + hs];
          a[k] = *(const u32x4*)(OB + (size_t)tok * 768 + 0 * 256 + hs * 64 + dc);
          b[k] = *(const u32x4*)(OB + (size_t)tok * 768 + 1 * 256 + hs * 64 + dc);
          c[k] = *(const u32x4*)(OB + (size_t)tok * 768 + 2 * 256 + hs * 64 + dc);
          z[k] = *(const u32x4*)(Z + (size_t)tok * 1024 + 512 + hs * 64 + dc);
        }
      }
#pragma unroll
      for (int k = 0; k < 4; ++k) {
        const int i = ib + k * istep;
        if (i < T * 32) {
          const int tok = i >> 5, hs = (i >> 3) & 3, dc = (i & 7) * 8;
          const float mx = fmaxf(l0[k], fmaxf(l1[k], l2[k]));
          float e0 = __expf(l0[k] - mx), e1 = __expf(l1[k] - mx), e2 = __expf(l2[k] - mx);
          const float inv = __builtin_amdgcn_rcpf(e0 + e1 + e2); e0 *= inv; e1 *= inv; e2 *= inv;
          u32x4 w;
#pragma unroll
          for (int q = 0; q < 4; ++q) {
            const float lo = (e0 * bflo(a[k][q]) + e1 * bflo(b[k][q]) + e2 * bflo(c[k][q])) * siluf(bflo(z[k][q]));
            const float hi = (e0 * bfhi(a[k][q]) + e1 * bfhi(b[k][q]) + e2 * bfhi(c[k][q])) * siluf(bfhi(z[k][q]));
            w[q] = cvtpk(lo, hi);
          }
          *(u32x4*)(Y + (size_t)tok * 1024 + 512 + hs * 64 + dc) = w;
        }
      }
    }
  }
  const char* H = p.ws + OFF_H;
  const char* W = p.ws + OFF_WIN + (size_t)5632 * 2048;
  bf16_t* G = (bf16_t*)(p.ws + OFF_G);
  __syncthreads();
  gemm_stream([&](int i, GUnit& u) -> bool {
      int pm, pn; if (!gemm_next(i, 64, 12, pm, pn)) return false;
      u.a = H + (size_t)pm * 256 * 2048; u.b = W + (size_t)pn * 256 * 2048; u.nt = 16; u.pm = pm; u.pn = pn; u.s = 0; return true; },
    [&](f32x4 (&acc)[2][2][4][2], const GUnit& u, int wr, int wc, int fr, int fq) {
#pragma unroll
      for (int ai = 0; ai < 2; ++ai)
#pragma unroll
        for (int m = 0; m < 4; ++m) {
          const int row = u.pm * 256 + ai * 128 + wr * 64 + m * 16 + fr;
#pragma unroll
          for (int bj = 0; bj < 2; ++bj) {
            const f32x4 v0 = acc[ai][bj][m][0], v1 = acc[ai][bj][m][1];
            u32x4 w; w[0] = cvtpk_t(sig2(v0[0]), sig2(v0[1])); w[1] = cvtpk_t(sig2(v0[2]), sig2(v0[3]));
            w[2] = cvtpk_t(sig2(v1[0]), sig2(v1[1])); w[3] = cvtpk_t(sig2(v1[2]), sig2(v1[3]));
            *(u32x4*)(G + (size_t)row * 3072 + u.pn * 256 + bj * 128 + wc * 32 + fq * 8) = w;
          }
        }
    });
}

DEV void phase_merge(const Params& p_in, int layer) {
  Params p = p_in; { size_t z_ = 0; asm volatile("" : "+s"(z_)); p.ws = p_in.ws + z_; }
  const char* Y = p.ws + OFF_Y;
  const char* W = p.ws + OFF_WBR + (size_t)layer * 1024 * 2048;
  const bf16_t* G = (const bf16_t*)(p.ws + OFF_G);
  bf16_t* M = (bf16_t*)(p.ws + OFF_H);
  __syncthreads();
  gemm_stream([&](int i, GUnit& u) -> bool {
      const int uu = i / 3, s = i - uu * 3;
      int pm, pn; if (!gemm_next(uu, 64, 4, pm, pn)) return false;
      const int koff = (s == 0) ? 0 : (s == 1 ? 512 : 768);
      u.a = Y + (size_t)pm * 256 * 2048 + koff * 2; u.b = W + (size_t)pn * 256 * 2048 + koff * 2; u.nt = (s == 0) ? 8 : 4; u.pm = pm; u.pn = pn; u.s = s; return true; },
    [&](f32x4 (&acc)[2][2][4][2], const GUnit& u, int wr, int wc, int fr, int fq) {
      const int s = u.s;
#pragma unroll
      for (int ai = 0; ai < 2; ++ai) {
        u32x4 gq[4][2], oq[4][2];
#pragma unroll
        for (int m = 0; m < 4; ++m)
#pragma unroll
          for (int bj = 0; bj < 2; ++bj) {
            const int row = u.pm * 256 + ai * 128 + wr * 64 + m * 16 + fr, col = u.pn * 256 + bj * 128 + wc * 32 + fq * 8;
            gq[m][bj] = *(const u32x4*)(G + (size_t)row * 3072 + s * 1024 + col);
            oq[m][bj] = (u32x4){0u, 0u, 0u, 0u};
            if (s > 0) oq[m][bj] = *(const u32x4*)(M + (size_t)row * 1024 + col);
          }
        asm volatile("" ::: "memory");
#pragma unroll
        for (int m = 0; m < 4; ++m)
#pragma unroll
          for (int bj = 0; bj < 2; ++bj) {
            const int row = u.pm * 256 + ai * 128 + wr * 64 + m * 16 + fr, col = u.pn * 256 + bj * 128 + wc * 32 + fq * 8;
            const u32x4 g = gq[m][bj], old = oq[m][bj];
            const f32x4 v0 = acc[ai][bj][m][0], v1 = acc[ai][bj][m][1];
            u32x4 w;
            w[0] = cvtpk(bflo(old[0]) + bflo(g[0]) * v0[0], bfhi(old[0]) + bfhi(g[0]) * v0[1]);
            w[1] = cvtpk(bflo(old[1]) + bflo(g[1]) * v0[2], bfhi(old[1]) + bfhi(g[1]) * v0[3]);
            w[2] = cvtpk(bflo(old[2]) + bflo(g[2]) * v1[0], bfhi(old[2]) + bfhi(g[2]) * v1[1]);
            w[3] = cvtpk(bflo(old[3]) + bflo(g[3]) * v1[2], bfhi(old[3]) + bfhi(g[3]) * v1[3]);
            *(u32x4*)(M + (size_t)row * 1024 + col) = w;
          }
      }
    });
}

DEV void phase_out(const Params& p_in, int layer, const float* __restrict__ xin) {
  Params p = p_in; { size_t z_ = 0; asm volatile("" : "+s"(z_)); p.ws = p_in.ws + z_; }
  const char* M = p.ws + OFF_H;
  const char* W = p.ws + OFF_WOUT + (size_t)layer * 1024 * 2048;
  const float* mod = (const float*)(p.ws + OFF_MOD) + (size_t)layer * 4 * 3072 + 2048;
  float* out = p.out;
  __syncthreads();
  gemm_stream([&](int i, GUnit& u) -> bool {
      int pm, pn; if (!gemm_next(i, 64, 4, pm, pn)) return false;
      u.a = M + (size_t)pm * 256 * 2048; u.b = W + (size_t)pn * 256 * 2048; u.nt = 16; u.pm = pm; u.pn = pn; u.s = 0; return true; },
    [&](f32x4 (&acc)[2][2][4][2], const GUnit& u, int wr, int wc, int fr, int fq) {
      const int b = u.pm >> 4;
#pragma unroll
      for (int bj = 0; bj < 2; ++bj) {
        const int col = u.pn * 256 + bj * 128 + wc * 32 + fq * 8;
        const f32x4 g0 = *(const f32x4*)(mod + b * 3072 + col), g1 = *(const f32x4*)(mod + b * 3072 + col + 4);
#pragma unroll
        for (int ai = 0; ai < 2; ++ai)
#pragma unroll
          for (int m = 0; m < 4; ++m) {
            const int row = u.pm * 256 + ai * 128 + wr * 64 + m * 16 + fr;
            const f32x4 x0 = *(const f32x4*)(xin + (size_t)row * 1024 + col), x1 = *(const f32x4*)(xin + (size_t)row * 1024 + col + 4);
            *(f32x4*)(out + (size_t)row * 1024 + col) = x0 + g0 * acc[ai][bj][m][0];
            *(f32x4*)(out + (size_t)row * 1024 + col + 4) = x1 + g1 * acc[ai][bj][m][1];
          }
      }
    });
  __syncthreads();
  if (layer == 0) cvt_win_layer(p, 1);
}

#define KSWZ_A(row, colB) ((row) * 256 + ((colB) ^ (((row) & 7) << 4)))
#define KSWZ_S(row, colB) ((row) * 128 + ((colB) ^ ((((row) >> 1) & 7) << 4)))
template <int DV> DEV int v_st(int k, int c) { const int kk = (k & ~0xC) | ((k & 4) << 1) | ((k & 8) >> 1); return ((kk >> 3) * (DV / 32) + (c >> 5)) * 512 + ((kk & 7) * 32 + (c & 31)) * 2; }
DEV int v_rd_base(int lane) { return ((lane & 3) << 3) | (((lane >> 2) & 3) << 6) | (((lane >> 4) & 1) << 5) | (((lane >> 5) & 1) << 8); }
template <int OFF> DEV s16x4 tr_read(int vb) { s16x4 r; asm volatile("ds_read_b64_tr_b16 %0, %1 offset:%2" : "=&v"(r) : "v"(vb), "i"(OFF) : "memory"); return r; }
template <int OFF> DEV bf16x8 lds_rd128(int addr) { bf16x8 r; asm volatile("ds_read_b128 %0, %1 offset:%2" : "=&v"(r) : "v"(addr), "i"(OFF) : "memory"); return r; }
template <int DV, int D0> DEV void pv_one(f32x16& od, int vb, bf16x8 pa0, bf16x8 pa1, bf16x8 pa2, bf16x8 pa3) {
  constexpr int KS = (DV / 32) * 1024, HF = (DV / 32) * 512;
  const s16x4 l0 = tr_read<D0 * 512 + 0 * KS>(vb), h0 = tr_read<D0 * 512 + 0 * KS + HF>(vb), l1 = tr_read<D0 * 512 + 1 * KS>(vb), h1 = tr_read<D0 * 512 + 1 * KS + HF>(vb);
  const s16x4 l2 = tr_read<D0 * 512 + 2 * KS>(vb), h2 = tr_read<D0 * 512 + 2 * KS + HF>(vb), l3 = tr_read<D0 * 512 + 3 * KS>(vb), h3 = tr_read<D0 * 512 + 3 * KS + HF>(vb);
  asm volatile("s_waitcnt lgkmcnt(0)" ::: "memory"); __builtin_amdgcn_sched_barrier(0);
#define PK(L, H) (bf16x8){L[0], L[1], L[2], L[3], H[0], H[1], H[2], H[3]}
  od = __builtin_amdgcn_mfma_f32_32x32x16_bf16(pa0, PK(l0, h0), od, 0, 0, 0);
  od = __builtin_amdgcn_mfma_f32_32x32x16_bf16(pa1, PK(l1, h1), od, 0, 0, 0);
  od = __builtin_amdgcn_mfma_f32_32x32x16_bf16(pa2, PK(l2, h2), od, 0, 0, 0);
  od = __builtin_amdgcn_mfma_f32_32x32x16_bf16(pa3, PK(l3, h3), od, 0, 0, 0);
#undef PK
}
DEV void pv_two64(f32x16& oa, f32x16& ob, int vb, bf16x8 pa0, bf16x8 pa1, bf16x8 pa2, bf16x8 pa3) {
  constexpr int KS = 2048, HF = 1024;
  const s16x4 al0 = tr_read<0 * KS>(vb), ah0 = tr_read<0 * KS + HF>(vb), al1 = tr_read<1 * KS>(vb), ah1 = tr_read<1 * KS + HF>(vb);
  const s16x4 al2 = tr_read<2 * KS>(vb), ah2 = tr_read<2 * KS + HF>(vb), al3 = tr_read<3 * KS>(vb), ah3 = tr_read<3 * KS + HF>(vb);
  const s16x4 bl0 = tr_read<512 + 0 * KS>(vb), bh0 = tr_read<512 + 0 * KS + HF>(vb), bl1 = tr_read<512 + 1 * KS>(vb), bh1 = tr_read<512 + 1 * KS + HF>(vb);
  const s16x4 bl2 = tr_read<512 + 2 * KS>(vb), bh2 = tr_read<512 + 2 * KS + HF>(vb), bl3 = tr_read<512 + 3 * KS>(vb), bh3 = tr_read<512 + 3 * KS + HF>(vb);
  asm volatile("s_waitcnt lgkmcnt(0)" ::: "memory"); __builtin_amdgcn_sched_barrier(0);
#define PK(L, H) (bf16x8){L[0], L[1], L[2], L[3], H[0], H[1], H[2], H[3]}
  oa = __builtin_amdgcn_mfma_f32_32x32x16_bf16(pa0, PK(al0, ah0), oa, 0, 0, 0);
  ob = __builtin_amdgcn_mfma_f32_32x32x16_bf16(pa0, PK(bl0, bh0), ob, 0, 0, 0);
  oa = __builtin_amdgcn_mfma_f32_32x32x16_bf16(pa1, PK(al1, ah1), oa, 0, 0, 0);
  ob = __builtin_amdgcn_mfma_f32_32x32x16_bf16(pa1, PK(bl1, bh1), ob, 0, 0, 0);
  oa = __builtin_amdgcn_mfma_f32_32x32x16_bf16(pa2, PK(al2, ah2), oa, 0, 0, 0);
  ob = __builtin_amdgcn_mfma_f32_32x32x16_bf16(pa2, PK(bl2, bh2), ob, 0, 0, 0);
  oa = __builtin_amdgcn_mfma_f32_32x32x16_bf16(pa3, PK(al3, ah3), oa, 0, 0, 0);
  ob = __builtin_amdgcn_mfma_f32_32x32x16_bf16(pa3, PK(bl3, bh3), ob, 0, 0, 0);
#undef PK
}

template <int MODE>
DEV void attn_unit(const Params& p, int layer, int u) {
  constexpr int DV = (MODE == 0) ? 128 : 64, ND = DV / 32;
  constexpr int TB = (MODE == 0) ? 16384 : 8192;
  constexpr float C = SCALE * 1.4426950408889634f;
  constexpr float THRRAW = 8.0f / SCALE;
  const int tid = ltid(), wid = __builtin_amdgcn_readfirstlane(tid >> 6), lane = tid & 63, r32 = lane & 31, hi = lane >> 5;
  char* V_lds = smem; char* K_lds = smem + 2 * TB;
  float* wsc = (float*)(smem + 131072) + wid * 64; float* li_l = wsc; float* al_l = wsc + 32;
  float* rpb_l = (float*)(smem + 131072 + 2048);

  int b = 0, h = 0, NT = 0, tfirst = 0;
  int g = 0, rr = 1, mres = 0, blk = 0, Lsub = 0;
  int r0 = 0, row_lo = 0, qrow = 0, qcol = 0, rs = 0, cs = 0;
  const bf16_t *Qp, *Kb, *Vb; int ldkv;
  int qtok;
  int coff = 0;
  if (MODE == 0) {
    const int pair = ((u & 7) << 1) | (u >> 8), qb = (u >> 3) & 31; b = pair >> 2; h = pair & 3;
    const int g4 = wid >> 1, cm = wid & 1; coff = cm * 64;
    qtok = b * SEQ + qb * 128 + g4 * 32 + r32;
    Qp = (const bf16_t*)(p.ws + OFF_AQK) + (size_t)qtok * 1024 + h * 128 + cm * 64;
    Kb = (const bf16_t*)(p.ws + OFF_AQK) + 512 + h * 128; Vb = (const bf16_t*)(p.ws + OFF_AV) + h * 128; ldkv = 0;
    NT = 64; tfirst = 0;
  } else if (MODE == 1) {
    b = u / 192; int rem = u % 192; h = rem / 48; rem %= 48; g = rem / 16; const int uu = rem % 16;
    rr = (g == 0) ? 1 : (g == 1 ? 4 : 16); Lsub = SEQ / rr; mres = uu % rr; blk = uu / rr;
    const int qn = blk * 256 + wid * 32 + r32;
    qtok = b * SEQ + qn * rr + mres;
    Qp = (const bf16_t*)(p.ws + OFF_BQ) + (size_t)qtok * 768 + g * 256 + h * 64;
    Kb = (const bf16_t*)(p.ws + OFF_BK) + g * 256 + h * 64; Vb = (const bf16_t*)(p.ws + OFF_BV) + g * 256 + h * 64; ldkv = 768;
    tfirst = (blk == 0) ? 1 : 0; int tl = (Lsub - (blk * 256 - 64)) / 64 - 1; if (tl > 5) tl = 5; NT = tl + 1;
  } else {
    b = u >> 6; h = (u >> 4) & 3; r0 = (u & 15) * 4;
    qrow = r0 + (wid >> 1); qcol = (wid & 1) * 32 + r32;
    qtok = b * SEQ + qrow * 64 + qcol;
    Qp = (const bf16_t*)(p.ws + OFF_C) + (size_t)qtok * 768 + h * 64;
    Kb = (const bf16_t*)(p.ws + OFF_C) + 256 + h * 64; Vb = (const bf16_t*)(p.ws + OFF_C) + 512 + h * 64; ldkv = 768;
    row_lo = r0 - 4; if (row_lo < 0) row_lo = 0; if (row_lo > 56) row_lo = 56;
    int rl3 = r0 + 3 - 4; if (rl3 < 0) rl3 = 0; if (rl3 > 56) rl3 = 56;
    NT = rl3 + 8 - row_lo; tfirst = 0;
    rs = qrow - 4; if (rs < 0) rs = 0; if (rs > 56) rs = 56;
    cs = qcol - 8; if (cs < 0) cs = 0; if (cs > 48) cs = 48;
    const float* rp = p.rpb + ((size_t)layer * 4 + h) * 465;
    if (tid < 465) rpb_l[tid] = rp[tid] * (1.0f / SCALE);
  }
  (void)ldkv;

  bf16x8 qr[4];
#pragma unroll
  for (int d0 = 0; d0 < 4; ++d0) qr[d0] = *(const bf16x8*)(Qp + d0 * 16 + hi * 8);

  bf16x8 st0, st1, st2, st3;
  auto key_tok = [&](int t, int i) -> int {
    if (MODE == 0) return b * SEQ + t * 64 + i;
    if (MODE == 1) return b * SEQ + (blk * 256 - 64 + 64 * t + i) * rr + mres;
    return b * SEQ + (row_lo + t) * 64 + i;
  };
  auto sload = [&](int t) {
    if (MODE == 0) {
      const int sr = tid >> 4, sc = (tid & 15) * 8;
      const size_t k0 = (size_t)key_tok(t, sr), k1 = (size_t)key_tok(t, 32 + sr);
      st0 = *(const bf16x8*)(Vb + k0 * 512 + sc); st1 = *(const bf16x8*)(Vb + k1 * 512 + sc);
      st2 = *(const bf16x8*)(Kb + k0 * 1024 + sc); st3 = *(const bf16x8*)(Kb + k1 * 1024 + sc);
    } else {
      const int sr = tid >> 3, sc = (tid & 7) * 8;
      const size_t k0 = (size_t)key_tok(t, sr);
      st0 = *(const bf16x8*)(Vb + k0 * 768 + sc); st2 = *(const bf16x8*)(Kb + k0 * 768 + sc);
    }
  };
  auto swrite = [&](int buf) {
    if (MODE == 0) {
      const int sr = tid >> 4, sc = (tid & 15) * 8;
      *(bf16x8*)(V_lds + buf * TB + v_st<128>(sr, sc)) = st0; *(bf16x8*)(V_lds + buf * TB + v_st<128>(32 + sr, sc)) = st1;
      *(bf16x8*)(K_lds + buf * TB + KSWZ_A(sr, sc * 2)) = st2; *(bf16x8*)(K_lds + buf * TB + KSWZ_A(32 + sr, sc * 2)) = st3;
    } else {
      const int sr = tid >> 3, sc = (tid & 7) * 8;
      *(bf16x8*)(V_lds + buf * TB + v_st<64>(sr, sc)) = st0;
      *(bf16x8*)(K_lds + buf * TB + KSWZ_S(sr, sc * 2)) = st2;
    }
  };

  float m_reg = -1e30f, l_reg = 0.f;
  f32x16 o[ND];
#pragma unroll
  for (int d = 0; d < ND; ++d) o[d] = f32x16{};
  const int vb0 = (int)(uintptr_t)V_lds + v_rd_base(lane);

  sload(tfirst); swrite(0);
  __syncthreads();
  if (wid >= 4) __builtin_amdgcn_s_setprio(1);
  for (int t = tfirst, it = 0; t < NT; ++t, ++it) {
    const int buf = it & 1;
    const bool more = (t + 1 < NT);
    if (more) sload(t + 1);
    bool active = true;
    if (MODE == 1) { const int tn0 = blk * 256 - 64 + 64 * t, qa = blk * 256 + wid * 32; active = (tn0 + 63 >= qa - 64) && (tn0 <= qa + 31 + 64); }
    if (MODE == 2) { const int kr = row_lo + t; active = (kr >= rs) && (kr < rs + 8); }
    if (active) {
      f32x16 p0 = f32x16{}, p1 = f32x16{};
      {
        const int kb_ = (int)(uintptr_t)K_lds + buf * TB;
        bf16x8 kf[8];
#pragma unroll
        for (int d0 = 0; d0 < 4; ++d0) { const int ka_ = kb_ + KSWZ_S(r32, (d0 * 16 + hi * 8) * 2); kf[2 * d0] = lds_rd128<0>(ka_); kf[2 * d0 + 1] = lds_rd128<4096>(ka_); }
        asm volatile("s_waitcnt lgkmcnt(0)" ::: "memory"); __builtin_amdgcn_sched_barrier(0);
#pragma unroll
        for (int d0 = 0; d0 < 4; ++d0) {
          p0 = __builtin_amdgcn_mfma_f32_32x32x16_bf16(kf[2 * d0], qr[d0], p0, 0, 0, 0);
          p1 = __builtin_amdgcn_mfma_f32_32x32x16_bf16(kf[2 * d0 + 1], qr[d0], p1, 0, 0, 0);
        }
      }
      if (MODE == 1) {
        const int tn0 = blk * 256 - 64 + 64 * t, qn = blk * 256 + wid * 32 + r32;
#pragma unroll
        for (int r = 0; r < 16; ++r) {
          const int d0k = tn0 + crow(r, hi) - qn, d1k = d0k + 32;
          if (d0k > 64 || d0k < -64) p0[r] = -INFINITY;
          if (d1k > 64 || d1k < -64) p1[r] = -INFINITY;
        }
      }
      if (MODE == 2) {
        const int kr = row_lo + t; const int rb = (kr - qrow + 7) * 31;
#pragma unroll
        for (int r = 0; r < 16; ++r) {
          const int kc0 = crow(r, hi), kc1 = kc0 + 32;
          int dc0 = kc0 - qcol + 15, dc1 = kc1 - qcol + 15;
          dc0 = dc0 < 0 ? 0 : (dc0 > 30 ? 30 : dc0); dc1 = dc1 < 0 ? 0 : (dc1 > 30 ? 30 : dc1);
          const float b0 = rpb_l[rb + dc0], b1 = rpb_l[rb + dc1];
          p0[r] = (kc0 >= cs && kc0 < cs + 16) ? p0[r] + b0 : -INFINITY;
          p1[r] = (kc1 >= cs && kc1 < cs + 16) ? p1[r] + b1 : -INFINITY;
        }
      }
      float pmax = p0[0];
#pragma unroll
      for (int r = 1; r < 16; ++r) pmax = fmaxf(pmax, p0[r]);
#pragma unroll
      for (int r = 0; r < 16; ++r) pmax = fmaxf(pmax, p1[r]);
      { auto sw = __builtin_amdgcn_permlane32_swap(__float_as_uint(pmax), __float_as_uint(pmax), false, false);
        pmax = fmaxf(__uint_as_float(sw[0]), __uint_as_float(sw[1])); }
      float mn, alpha;
      if (__all(pmax - m_reg <= THRRAW)) { mn = m_reg; alpha = 1.f; }
      else { mn = fmaxf(m_reg, pmax); alpha = __builtin_amdgcn_exp2f((m_reg - mn) * C); m_reg = mn; }
      const float mnC = -mn * C;
      float ps = 0.f;
#pragma unroll
      for (int r = 0; r < 16; ++r) { p0[r] = __builtin_amdgcn_exp2f(fmaf(p0[r], C, mnC)); ps += p0[r]; }
#pragma unroll
      for (int r = 0; r < 16; ++r) { p1[r] = __builtin_amdgcn_exp2f(fmaf(p1[r], C, mnC)); ps += p1[r]; }
      { auto sw = __builtin_amdgcn_permlane32_swap(__float_as_uint(ps), __float_as_uint(ps), false, false);
        ps = __uint_as_float(sw[0]) + __uint_as_float(sw[1]); }
      l_reg = l_reg * alpha + ps;
      bf16x8 pa0, pa1, pa2, pa3;
#define PK4(P, BASE, OUT) do { unsigned a0 = cvtpk(P[BASE + 0], P[BASE + 1]), a1 = cvtpk(P[BASE + 2], P[BASE + 3]); \
    unsigned b0_ = cvtpk(P[BASE + 4], P[BASE + 5]), b1_ = cvtpk(P[BASE + 6], P[BASE + 7]); \
    auto r0_ = __builtin_amdgcn_permlane32_swap(a0, b0_, false, false); auto r1_ = __builtin_amdgcn_permlane32_swap(a1, b1_, false, false); \
    u32x4 w_ = {r0_[0], r1_[0], r0_[1], r1_[1]}; OUT = *reinterpret_cast<bf16x8*>(&w_); } while (0)
      PK4(p0, 0, pa0); PK4(p0, 8, pa1); PK4(p1, 0, pa2); PK4(p1, 8, pa3);
#undef PK4
      if (__any(alpha < 1.f)) {
        if (hi == 0) al_l[r32] = alpha;
        asm volatile("s_waitcnt lgkmcnt(0)" ::: "memory");
        float af[16];
#pragma unroll
        for (int r = 0; r < 16; ++r) af[r] = al_l[crow(r, hi)];
#pragma unroll
        for (int d = 0; d < ND; ++d)
#pragma unroll
          for (int r = 0; r < 16; ++r) o[d][r] *= af[r];
      }
      const int vb = vb0 + buf * TB;
      if (DV == 64) pv_two64(o[0], o[1], vb, pa0, pa1, pa2, pa3);
      else { pv_one<DV, 0>(o[0], vb, pa0, pa1, pa2, pa3); pv_one<DV, 1>(o[1], vb, pa0, pa1, pa2, pa3); pv_one<DV, 2>(o[ND - 2], vb, pa0, pa1, pa2, pa3); pv_one<DV, 3>(o[ND - 1], vb, pa0, pa1, pa2, pa3); }
    }
    if (more) swrite(buf ^ 1);
    __syncthreads();
  }

  __builtin_amdgcn_s_setprio(0);
  if (hi == 0) li_l[r32] = l_reg;
  asm volatile("s_waitcnt lgkmcnt(0)" ::: "memory");
  float rli[16];
#pragma unroll
  for (int r = 0; r < 16; ++r) rli[r] = __builtin_amdgcn_rcpf(li_l[crow(r, hi)]);
  const int qtok0 = __shfl(qtok, 0);
  if (MODE == 0) {
    const int g4 = wid >> 1, cm = wid & 1;
    float* X = (float*)smem + g4 * 4096;
    const float lam = ((const float*)(p.ws + OFF_LAM))[layer];
    if (cm == 1) {
#pragma unroll
      for (int d = 0; d < ND; ++d)
#pragma unroll
        for (int r = 0; r < 16; ++r) X[crow(r, hi) * 128 + d * 32 + r32] = -lam * o[d][r] * rli[r];
    }
    __syncthreads();
    if (cm == 0) {
      float ss[16];
#pragma unroll
      for (int r = 0; r < 16; ++r) ss[r] = 0.f;
#pragma unroll
      for (int d = 0; d < ND; ++d)
#pragma unroll
        for (int r = 0; r < 16; ++r) { const float dv = o[d][r] * rli[r] + X[crow(r, hi) * 128 + d * 32 + r32]; o[d][r] = dv; ss[r] += dv * dv; }
#pragma unroll
      for (int r = 0; r < 16; ++r) {
        float s = ss[r];
        s += __shfl_xor(s, 1); s += __shfl_xor(s, 2); s += __shfl_xor(s, 4); s += __shfl_xor(s, 8); s += __shfl_xor(s, 16);
        const float li = 0.8f - 0.6f * __expf(-0.3f * (float)layer);
        ss[r] = rsqrtf(s * (1.0f / 128.0f) + RMS_EPS) * (1.0f - li);
      }
      const bf16_t* Z = (const bf16_t*)(p.ws + OFF_Z); bf16_t* Y = (bf16_t*)(p.ws + OFF_Y);
#pragma unroll
      for (int d = 0; d < ND; ++d) {
        const float gn = p.subln[layer * 128 + d * 32 + r32];
#pragma unroll
        for (int r = 0; r < 16; ++r) {
          const size_t idx = (size_t)(qtok0 + crow(r, hi)) * 1024 + h * 128 + d * 32 + r32;
          const float y = o[d][r] * ss[r] * gn * siluf(bf2f(Z[idx]));
          Y[idx] = (bf16_t)(cvtpk(y, y) & 0xffffu);
        }
      }
    }
  } else if (MODE == 1) {
    bf16_t* OB = (bf16_t*)(p.ws + OFF_BQ);
    float* LSE = (float*)(p.ws + OFF_LSE);
    const int tokw = b * SEQ + (blk * 256 + wid * 32) * rr + mres;
#pragma unroll
    for (int d = 0; d < ND; ++d)
#pragma unroll
      for (int r = 0; r < 16; ++r) {
        const size_t idx = (size_t)(tokw + crow(r, hi) * rr) * 768 + g * 256 + h * 64 + d * 32 + r32;
        const float y = o[d][r] * rli[r];
        OB[idx] = (bf16_t)(cvtpk(y, y) & 0xffffu);
      }
    if (hi == 0) LSE[((size_t)g * T + qtok) * 4 + h] = m_reg * SCALE + __logf(l_reg);
  } else {
    const bf16_t* Z = (const bf16_t*)(p.ws + OFF_Z); bf16_t* Y = (bf16_t*)(p.ws + OFF_Y);
    float* Wf = (float*)(smem + 65536) + wid * 2048;
#pragma unroll
    for (int d = 0; d < ND; ++d)
#pragma unroll
      for (int r = 0; r < 16; ++r) Wf[crow(r, hi) * 64 + d * 32 + r32] = o[d][r] * rli[r];
    asm volatile("s_waitcnt lgkmcnt(0)" ::: "memory");
    u32x4 zq[4];
#pragma unroll
    for (int it = 0; it < 4; ++it) { const int idx = it * 64 + lane; zq[it] = *(const u32x4*)(Z + (size_t)(qtok0 + (idx >> 3)) * 1024 + 768 + h * 64 + (idx & 7) * 8); }
#pragma unroll
    for (int it = 0; it < 4; ++it) {
      const int idx = it * 64 + lane, row = idx >> 3, ch = idx & 7;
      const f32x4 a = *(const f32x4*)(Wf + row * 64 + ch * 8), c4 = *(const f32x4*)(Wf + row * 64 + ch * 8 + 4);
      const size_t gi = (size_t)(qtok0 + row) * 1024 + 768 + h * 64 + ch * 8;
      const u32x4 z = zq[it];
      u32x4 w;
      w[0] = cvtpk(a[0] * siluf(bflo(z[0])), a[1] * siluf(bfhi(z[0]))); w[1] = cvtpk(a[2] * siluf(bflo(z[1])), a[3] * siluf(bfhi(z[1])));
      w[2] = cvtpk(c4[0] * siluf(bflo(z[2])), c4[1] * siluf(bfhi(z[2]))); w[3] = cvtpk(c4[2] * siluf(bflo(z[3])), c4[3] * siluf(bfhi(z[3])));
      *(u32x4*)(Y + gi) = w;
    }
  }
  __syncthreads();
}

DEV void smA_partial(f32x16& p0, f32x16& p1, float& m_reg, float& alpha) {
  constexpr float C = SCALE * 1.4426950408889634f; constexpr float THRRAW = 8.0f / SCALE;
  float pmax = p0[0];
#pragma unroll
  for (int r = 1; r < 16; ++r) pmax = fmaxf(pmax, p0[r]);
#pragma unroll
  for (int r = 0; r < 16; ++r) pmax = fmaxf(pmax, p1[r]);
  { auto sw = __builtin_amdgcn_permlane32_swap(__float_as_uint(pmax), __float_as_uint(pmax), false, false);
    pmax = fmaxf(__uint_as_float(sw[0]), __uint_as_float(sw[1])); }
  float mn;
  if (__builtin_expect(__all(pmax - m_reg <= THRRAW), 1)) { mn = m_reg; alpha = 1.f; }
  else { mn = fmaxf(m_reg, pmax); alpha = __builtin_amdgcn_exp2f((m_reg - mn) * C); m_reg = mn; }
  const float mnC = -mn * C;
#pragma unroll
  for (int r = 0; r < 16; ++r) p0[r] = fmaf(p0[r], C, mnC);
#pragma unroll
  for (int r = 0; r < 16; ++r) p1[r] = fmaf(p1[r], C, mnC);
#pragma unroll
  for (int r = 0; r < 16; ++r) p0[r] = __builtin_amdgcn_exp2f(p0[r]);
}
DEV void smA_finish(f32x16& p0, f32x16& p1, float alpha, float& l_reg, bf16x8& pa0, bf16x8& pa1, bf16x8& pa2, bf16x8& pa3) {
#pragma unroll
  for (int r = 0; r < 16; ++r) p1[r] = __builtin_amdgcn_exp2f(p1[r]);
  float ps = 0.f;
#pragma unroll
  for (int r = 0; r < 16; ++r) ps += p0[r];
#pragma unroll
  for (int r = 0; r < 16; ++r) ps += p1[r];
  { auto sw = __builtin_amdgcn_permlane32_swap(__float_as_uint(ps), __float_as_uint(ps), false, false);
    ps = __uint_as_float(sw[0]) + __uint_as_float(sw[1]); }
  l_reg = l_reg * alpha + ps;
#define PK4(P, BASE, OUT) do { unsigned a0 = cvtpk(P[BASE + 0], P[BASE + 1]), a1 = cvtpk(P[BASE + 2], P[BASE + 3]); \
    unsigned b0_ = cvtpk(P[BASE + 4], P[BASE + 5]), b1_ = cvtpk(P[BASE + 6], P[BASE + 7]); \
    auto r0_ = __builtin_amdgcn_permlane32_swap(a0, b0_, false, false); auto r1_ = __builtin_amdgcn_permlane32_swap(a1, b1_, false, false); \
    u32x4 w_ = {r0_[0], r1_[0], r0_[1], r1_[1]}; OUT = *reinterpret_cast<bf16x8*>(&w_); } while (0)
  PK4(p0, 0, pa0); PK4(p0, 8, pa1); PK4(p1, 0, pa2); PK4(p1, 8, pa3);
#undef PK4
}

#define KSWZ_A2(row, colB) ((row) * 256 + ((colB) ^ (((row) & 15) << 4)))
DEV void attn_unit_A(const Params& p, int layer, int pair, int qb) {
  constexpr int SLOT = 32768;
  const int tid = ltid(), wid = __builtin_amdgcn_readfirstlane(tid >> 6), lane = tid & 63, r32 = lane & 31, hi = lane >> 5;
  LDSC* ldsb = (LDSC*)smem;
  float* wsc = (float*)(smem + 131072) + wid * 64; float* li_l = wsc; float* al_l = wsc + 32;
  const int b = pair >> 2, h = pair & 3;
  const int g4 = wid >> 1, cm = wid & 1, coff = cm * 64;
  const int qtok = b * SEQ + qb * 128 + g4 * 32 + r32;
  const bf16_t* Qp = (const bf16_t*)(p.ws + OFF_AQK) + (size_t)qtok * 512 + h * 128 + cm * 64;
  const char* Kg = p.ws + OFF_AK + (size_t)(b * 4 + h) * SEQ * 256;
  const char* Vg = p.ws + OFF_AV + (size_t)(b * 4 + h) * SEQ * 256;
  const float* kmxp = (const float*)(p.ws + OFF_KMX) + layer * 64 + b * 16 + h * 4 + cm * 2;
  constexpr int NT = 64;
  bf16x8 qr[4];
  float qsq = 0.f;
#pragma unroll
  for (int d0 = 0; d0 < 4; ++d0) {
    const u32x4 qw = *(const u32x4*)(Qp + d0 * 16 + hi * 8);
    u32x4 qs;
#pragma unroll
    for (int k = 0; k < 4; ++k) { const float lo = bflo(qw[k]), hh = bfhi(qw[k]); qsq += lo * lo + hh * hh; qs[k] = cvtpk(lo * (SCALE * 1.4426950408889634f), hh * (SCALE * 1.4426950408889634f)); }
    qr[d0] = *reinterpret_cast<bf16x8*>(&qs);
  }
  { auto sw = __builtin_amdgcn_permlane32_swap(__float_as_uint(qsq), __float_as_uint(qsq), false, false); qsq = __uint_as_float(sw[0]) + __uint_as_float(sw[1]); }
  const float kmax2 = kmxp[0] + kmxp[1];
  const float negm_s = -(sqrtf(qsq * kmax2) * (SCALE * 1.4426950408889634f) * 1.01f + 0.01f);
  f32x16 negm;
#pragma unroll
  for (int r = 0; r < 16; ++r) negm[r] = negm_s;
  unsigned kofs[2], vofs[2];
#pragma unroll
  for (int i = 0; i < 2; ++i) {
    const int q = i * 8 + wid;
    { const int row = q * 4 + (lane >> 4), pos = lane & 15; kofs[i] = (unsigned)(row * 256 + ((pos ^ (row & 15)) << 4)); }
    { const int st = q * 2 + (lane >> 5), kk = (st >> 2) * 8 + ((lane & 31) >> 2), c = (st & 3) * 32 + (lane & 3) * 8;
      const int k = (kk & ~0xC) | ((kk & 4) << 1) | ((kk & 8) >> 1); vofs[i] = (unsigned)(k * 256 + c * 2); }
  }
  const int vb0 = (int)(uintptr_t)smem + v_rd_base(lane);
  int kro[4];
#pragma unroll
  for (int d0 = 0; d0 < 4; ++d0) kro[d0] = KSWZ_A2(r32, (coff + d0 * 16 + hi * 8) * 2);
#define ISSUE(t) do { const char* kg_ = Kg + (size_t)(t) * (64 * 256); const char* vg_ = Vg + (size_t)(t) * (64 * 256); const int so_ = ((t) & 3) * SLOT; \
    _Pragma("unroll") for (int i_ = 0; i_ < 2; ++i_) { \
      __builtin_amdgcn_global_load_lds((const unsigned*)(vg_ + vofs[i_]), (__attribute__((address_space(3))) unsigned*)(ldsb + so_ + (i_ * 8 + wid) * 1024), 16, 0, 0); \
      __builtin_amdgcn_global_load_lds((const unsigned*)(kg_ + kofs[i_]), (__attribute__((address_space(3))) unsigned*)(ldsb + so_ + 16384 + (i_ * 8 + wid) * 1024), 16, 0, 0); } } while (0)
#define SBAR() __builtin_amdgcn_sched_barrier(0)
#define WAITV(n) asm volatile("s_waitcnt vmcnt(" #n ")" ::: "memory")
#define RBAR() do { asm volatile("" ::: "memory"); __builtin_amdgcn_s_barrier(); asm volatile("" ::: "memory"); } while (0)
#define KRD1(dst, addr, OFF) asm volatile("ds_read_b128 %0, %1 offset:" #OFF : "=&v"(dst) : "v"(addr) : "memory")
#define KREAD(t) do { const int kb_ = (int)(uintptr_t)smem + ((t) & 3) * SLOT; _Pragma("unroll") for (int d0 = 0; d0 < 4; ++d0) { const int ka_ = kb_ + kro[d0]; \
    KRD1(kf[2 * d0], ka_, 16384); KRD1(kf[2 * d0 + 1], ka_, 24576); } \
    asm volatile("s_waitcnt lgkmcnt(0)" ::: "memory"); SBAR(); } while (0)
#define VR1(D0, KS, vb_) vf[((D0) * 4 + (KS)) * 2] = tr_read<(D0) * 512 + (KS) * 4096>(vb_); vf[((D0) * 4 + (KS)) * 2 + 1] = tr_read<(D0) * 512 + (KS) * 4096 + 2048>(vb_);
#define VREAD_A(t) do { const int vb_ = vb0 + ((t) & 3) * SLOT; \
    VR1(0, 0, vb_) VR1(1, 0, vb_) VR1(2, 0, vb_) VR1(3, 0, vb_) VR1(0, 1, vb_) VR1(1, 1, vb_) VR1(2, 1, vb_) VR1(3, 1, vb_) } while (0)
#define VREAD_B(t) do { const int vb_ = vb0 + ((t) & 3) * SLOT; \
    VR1(0, 2, vb_) VR1(1, 2, vb_) VR1(2, 2, vb_) VR1(3, 2, vb_) VR1(0, 3, vb_) VR1(1, 3, vb_) VR1(2, 3, vb_) VR1(3, 3, vb_) } while (0)
#define PKV(i) (bf16x8){vf[2 * (i)][0], vf[2 * (i)][1], vf[2 * (i)][2], vf[2 * (i)][3], vf[2 * (i) + 1][0], vf[2 * (i) + 1][1], vf[2 * (i) + 1][2], vf[2 * (i) + 1][3]}
#define RESC(a) do { if (__any((a) < 1.f)) { if (hi == 0) al_l[r32] = (a); asm volatile("s_waitcnt lgkmcnt(0)" ::: "memory"); \
    _Pragma("unroll") for (int r = 0; r < 16; ++r) { const float af_ = al_l[crow(r, hi)]; o[0][r] *= af_; o[1][r] *= af_; o[2][r] *= af_; o[3][r] *= af_; } } } while (0)
  float l_reg = 0.f;
  f32x16 o[4] = {f32x16{}, f32x16{}, f32x16{}, f32x16{}};
  f32x16 p0, p1; bf16x8 pa[4]; bf16x8 kf[8]; s16x4 vf[32];
  ISSUE(0); ISSUE(1);
  if (wid >= 4) __builtin_amdgcn_s_setprio(1);
  long long seg_acc = 0;
#pragma unroll 1
  for (int J = 0; J < NT / 2; ++J) {
    WAITV(0); RBAR();
    if (J + 1 < NT / 2) { ISSUE(2 * J + 2); ISSUE(2 * J + 3); }
#pragma unroll
    for (int tt = 0; tt < 2; ++tt) {
      const int j = 2 * J + tt;
      KREAD(j);
      p0 = __builtin_amdgcn_mfma_f32_32x32x16_bf16(kf[0], qr[0], negm, 0, 0, 0);
      p1 = __builtin_amdgcn_mfma_f32_32x32x16_bf16(kf[1], qr[0], negm, 0, 0, 0);
#pragma unroll
      for (int d0 = 1; d0 < 4; ++d0) {
        p0 = __builtin_amdgcn_mfma_f32_32x32x16_bf16(kf[2 * d0], qr[d0], p0, 0, 0, 0);
        p1 = __builtin_amdgcn_mfma_f32_32x32x16_bf16(kf[2 * d0 + 1], qr[d0], p1, 0, 0, 0);
      }
      SBAR(); VREAD_A(j); SBAR();
      {
#pragma unroll
        for (int r = 0; r < 16; ++r) p0[r] = __builtin_amdgcn_exp2f(p0[r]);
#pragma unroll
        for (int r = 0; r < 16; ++r) p1[r] = __builtin_amdgcn_exp2f(p1[r]);
        float ps = 0.f;
#pragma unroll
        for (int r = 0; r < 16; ++r) ps += p0[r];
#pragma unroll
        for (int r = 0; r < 16; ++r) ps += p1[r];
        l_reg += ps;
#define PK4(P, BASE, OUT) do { unsigned a0 = cvtpk(P[BASE + 0], P[BASE + 1]), a1 = cvtpk(P[BASE + 2], P[BASE + 3]); \
    unsigned b0_ = cvtpk(P[BASE + 4], P[BASE + 5]), b1_ = cvtpk(P[BASE + 6], P[BASE + 7]); \
    auto r0_ = __builtin_amdgcn_permlane32_swap(a0, b0_, false, false); auto r1_ = __builtin_amdgcn_permlane32_swap(a1, b1_, false, false); \
    u32x4 w_ = {r0_[0], r1_[0], r0_[1], r1_[1]}; OUT = *reinterpret_cast<bf16x8*>(&w_); } while (0)
        PK4(p0, 0, pa[0]); PK4(p0, 8, pa[1]); PK4(p1, 0, pa[2]); PK4(p1, 8, pa[3]);
#undef PK4
      }
      asm volatile("s_waitcnt lgkmcnt(0)" ::: "memory"); SBAR();
      VREAD_B(j);
      SBAR();
#pragma unroll
      for (int ks = 0; ks < 2; ++ks)
#pragma unroll
        for (int d0 = 0; d0 < 4; ++d0) o[d0] = __builtin_amdgcn_mfma_f32_32x32x16_bf16(pa[ks], PKV(d0 * 4 + ks), o[d0], 0, 0, 0);
      SBAR();
      asm volatile("s_waitcnt lgkmcnt(0)" ::: "memory");
      SBAR();
#pragma unroll
      for (int ks = 2; ks < 4; ++ks)
#pragma unroll
        for (int d0 = 0; d0 < 4; ++d0) o[d0] = __builtin_amdgcn_mfma_f32_32x32x16_bf16(pa[ks], PKV(d0 * 4 + ks), o[d0], 0, 0, 0);
    }
  }
  __builtin_amdgcn_s_setprio(0);
  if (PROBE_SEG && blockIdx.x == 0 && tid == 0) atomicAdd((unsigned long long*)(p.ws + OFF_KMX + 1024), (unsigned long long)seg_acc);
  { auto sw = __builtin_amdgcn_permlane32_swap(__float_as_uint(l_reg), __float_as_uint(l_reg), false, false); l_reg = __uint_as_float(sw[0]) + __uint_as_float(sw[1]); }
#undef ISSUE
#undef KREAD
#undef KRD1
#undef VREAD_A
#undef VREAD_B
#undef VR1
#undef PKV
#undef RESC
#undef WAITV
#undef RBAR
  __syncthreads();
  if (hi == 0) li_l[r32] = l_reg;
  asm volatile("s_waitcnt lgkmcnt(0)" ::: "memory");
  float rli[16];
#pragma unroll
  for (int r = 0; r < 16; ++r) rli[r] = __builtin_amdgcn_rcpf(li_l[crow(r, hi)]);
  const int qtok0 = b * SEQ + qb * 128 + g4 * 32;
  float* X = (float*)smem + g4 * 4096;
  const float lam = ((const float*)(p.ws + OFF_LAM))[layer];
  u32x4 zq[4];
  { const bf16_t* Zp = (const bf16_t*)(p.ws + OFF_Z);
#pragma unroll
    for (int it = 0; it < 4; ++it) { const int idx = it * 128 + cm * 64 + lane; zq[it] = *(const u32x4*)(Zp + (size_t)(qtok0 + (idx >> 4)) * 1024 + h * 128 + (idx & 15) * 8); } }
  {
    float* Xw = X + cm * 16384;
    const float wgt = (cm == 1) ? -lam : 1.0f;
#pragma unroll
    for (int d = 0; d < 4; ++d)
#pragma unroll
      for (int r = 0; r < 16; ++r) Xw[crow(r, hi) * 128 + d * 32 + r32] = wgt * o[d][r] * rli[r];
  }
  __syncthreads();
  {
    const float li = 0.8f - 0.6f * __expf(-0.3f * (float)layer);
    const bf16_t* Z = (const bf16_t*)(p.ws + OFF_Z); bf16_t* Y = (bf16_t*)(p.ws + OFF_Y);
#pragma unroll
    for (int it = 0; it < 4; ++it) {
      const int idx = it * 128 + cm * 64 + lane, row = idx >> 4, ch = idx & 15;
      const f32x4 a = *(const f32x4*)(X + row * 128 + ch * 8) + *(const f32x4*)(X + 16384 + row * 128 + ch * 8), c4 = *(const f32x4*)(X + row * 128 + ch * 8 + 4) + *(const f32x4*)(X + 16384 + row * 128 + ch * 8 + 4);
      float ss = a[0] * a[0] + a[1] * a[1] + a[2] * a[2] + a[3] * a[3] + c4[0] * c4[0] + c4[1] * c4[1] + c4[2] * c4[2] + c4[3] * c4[3];
      ss += __shfl_xor(ss, 1); ss += __shfl_xor(ss, 2); ss += __shfl_xor(ss, 4); ss += __shfl_xor(ss, 8);
      const float rs = rsqrtf(ss * (1.0f / 128.0f) + RMS_EPS) * (1.0f - li);
      const f32x4 g0 = *(const f32x4*)(p.subln + layer * 128 + ch * 8), g1 = *(const f32x4*)(p.subln + layer * 128 + ch * 8 + 4);
      const size_t gi = (size_t)(qtok0 + row) * 1024 + h * 128 + ch * 8;
      const u32x4 z = zq[it];
      u32x4 w;
      w[0] = cvtpk(a[0] * rs * g0[0] * siluf(bflo(z[0])), a[1] * rs * g0[1] * siluf(bfhi(z[0])));
      w[1] = cvtpk(a[2] * rs * g0[2] * siluf(bflo(z[1])), a[3] * rs * g0[3] * siluf(bfhi(z[1])));
      w[2] = cvtpk(c4[0] * rs * g1[0] * siluf(bflo(z[2])), c4[1] * rs * g1[1] * siluf(bfhi(z[2])));
      w[3] = cvtpk(c4[2] * rs * g1[2] * siluf(bflo(z[3])), c4[3] * rs * g1[3] * siluf(bfhi(z[3])));
      *(u32x4*)(Y + gi) = w;
    }
  }
  __syncthreads();
}

DEV void attn_unit_B(const Params& p, int layer, int u) {
  constexpr float C = SCALE * 1.4426950408889634f;
  constexpr float THRRAW = 8.0f / SCALE;
  constexpr int VOFF = 49152;
  const int tid = ltid(), wid = __builtin_amdgcn_readfirstlane(tid >> 6), lane = tid & 63, r32 = lane & 31, hi = lane >> 5;
  LDSC* ldsb = (LDSC*)smem;
  float* wsc = (float*)(smem + 131072) + wid * 64; float* li_l = wsc; float* al_l = wsc + 32;
  const int b = u / 192; int rem = u % 192; const int h = rem / 48; rem %= 48; const int g = rem / 16, uu = rem % 16;
  const int rr = (g == 0) ? 1 : (g == 1 ? 4 : 16), Lsub = SEQ / rr, mres = uu % rr, blk = uu / rr;
  const int qn = blk * 256 + wid * 32 + r32;
  const int qtok = b * SEQ + qn * rr + mres;
  const bf16_t* Qp = (const bf16_t*)(p.ws + OFF_BQ) + (size_t)qtok * 768 + g * 256 + h * 64;
  const char* Kb = p.ws + OFF_BK + (size_t)(g * 256 + h * 64) * 2;
  const char* Vb = p.ws + OFF_BV + (size_t)(g * 256 + h * 64) * 2;
  const int tfirst = (blk == 0) ? 1 : 0; int tl = (Lsub - (blk * 256 - 64)) / 64 - 1; if (tl > 5) tl = 5; const int NT = tl + 1;
  bf16x8 qr[4];
#pragma unroll
  for (int d0 = 0; d0 < 4; ++d0) qr[d0] = *(const bf16x8*)(Qp + d0 * 16 + hi * 8);
  {
    const int krow = 8 * wid + (lane >> 3), kchunk = (lane & 7) ^ ((krow >> 1) & 7);
    const int kk = 8 * wid + ((lane & 31) >> 2), vk = (kk & ~0xC) | ((kk & 4) << 1) | ((kk & 8) >> 1), vc = (lane >> 5) * 32 + (lane & 3) * 8;
    const int n0 = blk * 256 - 64;
    for (int t = tfirst; t < NT; ++t) {
      const size_t ktok = (size_t)(b * SEQ + (n0 + 64 * t + krow) * rr + mres), vtok = (size_t)(b * SEQ + (n0 + 64 * t + vk) * rr + mres);
      __builtin_amdgcn_global_load_lds((const unsigned*)(Kb + ktok * 1536 + kchunk * 16), (__attribute__((address_space(3))) unsigned*)(ldsb + t * 8192 + wid * 1024), 16, 0, 0);
      __builtin_amdgcn_global_load_lds((const unsigned*)(Vb + vtok * 1536 + vc * 2), (__attribute__((address_space(3))) unsigned*)(ldsb + VOFF + t * 8192 + wid * 1024), 16, 0, 0);
    }
  }
  asm volatile("s_waitcnt vmcnt(0)" ::: "memory");
  __syncthreads();
  float m_reg = -1e30f, l_reg = 0.f;
  f32x16 o[2] = {f32x16{}, f32x16{}};
  const int vb0 = (int)(uintptr_t)smem + VOFF + v_rd_base(lane);
  int t0 = wid >> 1; if (t0 < tfirst) t0 = tfirst; int t1 = (wid >> 1) + 2; if (t1 > NT - 1) t1 = NT - 1;
  if (wid >= 4) __builtin_amdgcn_s_setprio(1);
  for (int t = t0; t <= t1; ++t) {
    f32x16 p0 = f32x16{}, p1 = f32x16{};
    {
      const int kb_ = (int)(uintptr_t)smem + t * 8192;
      bf16x8 kf[8];
#pragma unroll
      for (int d0 = 0; d0 < 4; ++d0) { const int ka_ = kb_ + KSWZ_S(r32, (d0 * 16 + hi * 8) * 2); kf[2 * d0] = lds_rd128<0>(ka_); kf[2 * d0 + 1] = lds_rd128<4096>(ka_); }
      asm volatile("s_waitcnt lgkmcnt(0)" ::: "memory"); __builtin_amdgcn_sched_barrier(0);
#pragma unroll
      for (int d0 = 0; d0 < 4; ++d0) {
        p0 = __builtin_amdgcn_mfma_f32_32x32x16_bf16(kf[2 * d0], qr[d0], p0, 0, 0, 0);
        p1 = __builtin_amdgcn_mfma_f32_32x32x16_bf16(kf[2 * d0 + 1], qr[d0], p1, 0, 0, 0);
      }
    }
    { const int tn0 = blk * 256 - 64 + 64 * t;
#pragma unroll
      for (int r = 0; r < 16; ++r) {
        const int d0k = tn0 + crow(r, hi) - qn, d1k = d0k + 32;
        if (d0k > 64 || d0k < -64) p0[r] = -INFINITY;
        if (d1k > 64 || d1k < -64) p1[r] = -INFINITY;
      } }
    float pmax = p0[0];
#pragma unroll
    for (int r = 1; r < 16; ++r) pmax = fmaxf(pmax, p0[r]);
#pragma unroll
    for (int r = 0; r < 16; ++r) pmax = fmaxf(pmax, p1[r]);
    { auto sw = __builtin_amdgcn_permlane32_swap(__float_as_uint(pmax), __float_as_uint(pmax), false, false);
      pmax = fmaxf(__uint_as_float(sw[0]), __uint_as_float(sw[1])); }
    float mn, alpha;
    if (__all(pmax - m_reg <= THRRAW)) { mn = m_reg; alpha = 1.f; }
    else { mn = fmaxf(m_reg, pmax); alpha = __builtin_amdgcn_exp2f((m_reg - mn) * C); m_reg = mn; }
    const float mnC = -mn * C;
    float ps = 0.f;
#pragma unroll
    for (int r = 0; r < 16; ++r) { p0[r] = __builtin_amdgcn_exp2f(fmaf(p0[r], C, mnC)); ps += p0[r]; }
#pragma unroll
    for (int r = 0; r < 16; ++r) { p1[r] = __builtin_amdgcn_exp2f(fmaf(p1[r], C, mnC)); ps += p1[r]; }
    { auto sw = __builtin_amdgcn_permlane32_swap(__float_as_uint(ps), __float_as_uint(ps), false, false);
      ps = __uint_as_float(sw[0]) + __uint_as_float(sw[1]); }
    l_reg = l_reg * alpha + ps;
    bf16x8 pa0, pa1, pa2, pa3;
#define PK4(P, BASE, OUT) do { unsigned a0 = cvtpk(P[BASE + 0], P[BASE + 1]), a1 = cvtpk(P[BASE + 2], P[BASE + 3]); \
    unsigned b0_ = cvtpk(P[BASE + 4], P[BASE + 5]), b1_ = cvtpk(P[BASE + 6], P[BASE + 7]); \
    auto r0_ = __builtin_amdgcn_permlane32_swap(a0, b0_, false, false); auto r1_ = __builtin_amdgcn_permlane32_swap(a1, b1_, false, false); \
    u32x4 w_ = {r0_[0], r1_[0], r0_[1], r1_[1]}; OUT = *reinterpret_cast<bf16x8*>(&w_); } while (0)
    PK4(p0, 0, pa0); PK4(p0, 8, pa1); PK4(p1, 0, pa2); PK4(p1, 8, pa3);
#undef PK4
    if (__any(alpha < 1.f)) {
      if (hi == 0) al_l[r32] = alpha;
      asm volatile("s_waitcnt lgkmcnt(0)" ::: "memory");
#pragma unroll
      for (int r = 0; r < 16; ++r) { const float af = al_l[crow(r, hi)]; o[0][r] *= af; o[1][r] *= af; }
    }
    const int vb = vb0 + t * 8192;
    pv_two64(o[0], o[1], vb, pa0, pa1, pa2, pa3);
  }
  __builtin_amdgcn_s_setprio(0);
  if (hi == 0) li_l[r32] = l_reg;
  asm volatile("s_waitcnt lgkmcnt(0)" ::: "memory");
  float rli[16];
#pragma unroll
  for (int r = 0; r < 16; ++r) rli[r] = __builtin_amdgcn_rcpf(li_l[crow(r, hi)]);
  bf16_t* OB = (bf16_t*)(p.ws + OFF_BQ);
  float* LSE = (float*)(p.ws + OFF_LSE);
  const int tokw = b * SEQ + (blk * 256 + wid * 32) * rr + mres;
  bf16_t* W = (bf16_t*)(smem + 98304) + wid * 2048;
#pragma unroll
  for (int d = 0; d < 2; ++d)
#pragma unroll
    for (int r = 0; r < 16; ++r) { const float y = o[d][r] * rli[r]; W[crow(r, hi) * 64 + d * 32 + r32] = (bf16_t)(cvtpk(y, y) & 0xffffu); }
  asm volatile("s_waitcnt lgkmcnt(0)" ::: "memory");
#pragma unroll
  for (int it = 0; it < 4; ++it) {
    const int idx = it * 64 + lane, row = idx >> 3, ch = idx & 7;
    const u32x4 w = *(const u32x4*)(W + row * 64 + ch * 8);
    *(u32x4*)(OB + (size_t)(tokw + row * rr) * 768 + g * 256 + h * 64 + ch * 8) = w;
  }
  if (hi == 0) LSE[((size_t)g * T + qtok) * 4 + h] = m_reg * SCALE + __logf(l_reg);
  __syncthreads();
}

DEV void phase_attn_A(const Params& p, int layer, int qsel) {
  for (int u = blockIdx.x; u < 512; u += gridDim.x) attn_unit_A(p, layer, ((u & 7) << 1) | ((u >> 8) & 1), (u >> 3) & 31);
}

DEV void phase_attn(const Params& p_in, int layer) {
  Params p = p_in; { size_t z_ = 0; asm volatile("" : "+s"(z_)); p.ws = p_in.ws + z_; }
  if (PROBE_DBL == 4) { for (int u = blockIdx.x; u < 256; u += gridDim.x) attn_unit<2>(p, layer, u); }
  phase_attn_A(p, layer, layer);
  if (PROBE_DBL == 1) phase_attn_A(p, layer, 2 + layer);
  for (int u = blockIdx.x; u < 768; u += gridDim.x) attn_unit_B(p, layer, u);
  for (int u = blockIdx.x; u < 256; u += gridDim.x) attn_unit<2>(p, layer, u);
}

__global__ void __launch_bounds__(512, 1) mk_forward(Params p) {
  cg::grid_group grid = cg::this_grid();
  unsigned* bar = (unsigned*)(p.ws + OFF_BAR);
  volatile LAS unsigned* st = (volatile LAS unsigned*)(LAS unsigned*)(smem + 131072 + 3968);
  if (threadIdx.x == 0) { st[0] = 0u; st[1] = 0u; }
  if (p.ws == nullptr) grid.sync();
  __syncthreads();
  XcdBarrier xb = xcd_barrier_post(bar, st);
  phase0(p);
  if (PROBE_DBL == 3) phase0(p);
  xcd_barrier(xb);
#pragma unroll 1
  for (int layer = 0; layer < 2; ++layer) {
    const float* xin = layer == 0 ? p.x : p.out;
    phase_norm(p, layer, xin);
    if (PROBE_DBL == 7) phase_norm(p, layer, xin);
    xcd_barrier(xb);
    phase_inproj(p, layer);
    if (PROBE_DBL == 2) phase_inproj(p, layer);
    xcd_barrier(xb);
    phase_attn(p, layer);
    xcd_barrier(xb);
    phase_gates(p);
    if (PROBE_DBL == 5) phase_gates(p);
    xcd_barrier(xb);
    phase_merge(p, layer);
    if (PROBE_DBL == 6) { xcd_barrier(xb); phase_merge(p, layer); }
    xcd_barrier(xb);
    phase_out(p, layer, xin);
    xcd_barrier(xb);
  }
  phase_final(p);
  if (PROBE_SEG && blockIdx.x == 0 && threadIdx.x == 0) {
    const unsigned long long cyc = __hip_atomic_load((unsigned long long*)(p.ws + OFF_KMX + 1024), __ATOMIC_RELAXED, __HIP_MEMORY_SCOPE_AGENT);
    const unsigned long long ticks = cyc / 40;
    const unsigned long long s0 = wall_clock64();
    while (wall_clock64() - s0 < ticks) __builtin_amdgcn_s_sleep(8);
  }
}

extern "C" void kernel_launch(void* const* d_in, const int* in_sizes, int n_in, void* d_out, int out_size, void* d_ws, size_t ws_size, hipStream_t stream) {
  static int grid_blocks = 0;
  if (ws_size < WS_NEED) { fprintf(stderr, "kernel_launch: workspace too small: %zu < %zu\n", ws_size, WS_NEED); return; }
  if (!grid_blocks) {
    int dev = 0, cus = 0, per_cu = 0;
    hipGetDevice(&dev);
    hipDeviceGetAttribute(&cus, hipDeviceAttributeMultiprocessorCount, dev);
    if (hipFuncSetAttribute((const void*)mk_forward, hipFuncAttributeMaxDynamicSharedMemorySize, LDS_BYTES) != hipSuccess) { fprintf(stderr, "kernel_launch: LDS attribute failed\n"); return; }
    hipOccupancyMaxActiveBlocksPerMultiprocessor(&per_cu, mk_forward, 512, LDS_BYTES);
    if (per_cu < 1) { fprintf(stderr, "kernel_launch: occupancy 0\n"); return; }
    grid_blocks = cus;
  }
  Params p{};
  p.x = (const float*)d_in[0]; p.c = (const float*)d_in[1]; p.pos = (const int*)d_in[2]; p.norm_gain = (const float*)d_in[3];
  p.w_ada = (const float*)d_in[4]; p.b_ada = (const float*)d_in[5]; p.w_in = (const float*)d_in[6]; p.diff_lambda = (const float*)d_in[7];
  p.subln = (const float*)d_in[8]; p.rpb = (const float*)d_in[9]; p.w_branch = (const float*)d_in[10]; p.w_out = (const float*)d_in[11];
  p.final_gain = (const float*)d_in[12]; p.out = (float*)d_out; p.ws = (char*)d_ws;
  void* args[] = {&p};
  if (hipMemsetAsync((char*)d_ws + OFF_BAR, 0, WS_NEED - OFF_BAR, stream) != hipSuccess) { fprintf(stderr, "kernel_launch: memset failed\n"); return; }
  hipError_t e = hipLaunchCooperativeKernel((void*)mk_forward, dim3(grid_blocks), dim3(512), args, LDS_BYTES, stream);
  if (e != hipSuccess) fprintf(stderr, "cooperative launch failed: %s (grid %d)\n", hipGetErrorString(e), grid_blocks);
}
```
